# Optimizing an MI355X kernel written in HIP

```python
import jax, jax.numpy as jnp
from jax import lax
import numpy as np

D_MODEL = 2048
BATCH = 2
SEQ = 4096
DEPTH = 4

N_MIXERS = 2
N_SB_LAYERS = (DEPTH + 1) // 2
N_GM_LAYERS = DEPTH // 2
SB_HEADS = 16
SB_HEAD_DIM = D_MODEL // SB_HEADS
Q_BLOCK = 128
GM_CHUNK = 128
GM_FFN = 6 * D_MODEL
GM_HALF = GM_FFN // 2
GM_GROUPS = 16
GM_GROUP_DIM = GM_HALF // GM_GROUPS
N_GROUPS = 4
EXPERTS_PER_GROUP = 8
TOP_K = 2
D_EXPERT = 512
LN_EPS = 1e-5
DEEPNORM_ALPHA = (2.0 * DEPTH) ** 0.25
DEEPNORM_BETA = (8.0 * DEPTH) ** -0.25

kernel_name = "hybrid_stickbreak_gmlp_hmoe_deepnorm"


def layer_norm(x, g, b):
    xf = x.astype(jnp.float32)
    mu = jnp.mean(xf, axis=-1, keepdims=True)
    var = jnp.mean(jnp.square(xf - mu), axis=-1, keepdims=True)
    y = (xf - mu) * lax.rsqrt(var + LN_EPS) * g.astype(jnp.float32) + b.astype(jnp.float32)
    return y.astype(x.dtype)


def stick_breaking_attention(x, w_qkv, w_o):
    B, S, _ = x.shape
    qkv = x @ w_qkv
    q, k, v = jnp.split(qkv, 3, axis=-1)
    to_heads = lambda a: a.reshape(B, S, SB_HEADS, SB_HEAD_DIM).transpose(0, 2, 1, 3)
    q, k, v = to_heads(q), to_heads(k), to_heads(v)
    n_blk = S // Q_BLOCK
    q_blocks = q.reshape(B, SB_HEADS, n_blk, Q_BLOCK, SB_HEAD_DIM).transpose(2, 0, 1, 3, 4)
    key_pos = jnp.arange(S)
    scale = SB_HEAD_DIM ** -0.5

    def one_block(args):
        q_blk, blk_idx = args
        q_pos = blk_idx * Q_BLOCK + jnp.arange(Q_BLOCK)
        z = jnp.einsum('bhqd,bhkd->bhqk', q_blk, k).astype(jnp.float32) * scale
        causal = key_pos[None, :] < q_pos[:, None]
        log_beta = jax.nn.log_sigmoid(z)
        log_one_minus = jnp.where(causal, jax.nn.log_sigmoid(-z), 0.0)
        log_rest = lax.cumsum(log_one_minus, axis=log_one_minus.ndim - 1, reverse=True) - log_one_minus
        att = jnp.where(causal, jnp.exp(log_beta + log_rest), 0.0)
        return jnp.einsum('bhqk,bhkd->bhqd', att.astype(v.dtype), v)

    o = lax.map(one_block, (q_blocks, jnp.arange(n_blk)))
    o = o.transpose(1, 0, 3, 2, 4).reshape(B, S, D_MODEL)
    return o @ w_o


def chunked_spatial_gating(x, w_in, v_ln_g, v_ln_b, w_spatial, b_spatial, w_out):
    B, S, _ = x.shape
    z = jax.nn.gelu(x @ w_in)
    u, v = jnp.split(z, 2, axis=-1)
    v = layer_norm(v, v_ln_g, v_ln_b)
    n_ch = S // GM_CHUNK
    v = v.reshape(B, n_ch, GM_CHUNK, GM_GROUPS, GM_GROUP_DIM)
    tri = jnp.tril(jnp.ones((GM_CHUNK, GM_CHUNK), dtype=bool))
    w_s = jnp.where(tri[None], w_spatial, 0.0)
    s = jnp.einsum('gts,bcsgd->bctgd', w_s.astype(v.dtype), v) + b_spatial.T[:, :, None]
    s = s.reshape(B, S, GM_HALF)
    return (u * s) @ w_out


def hierarchical_moe(x, w_group_router, b_group_router, w_expert_router, b_expert_router,
                     w_gate, w_up, w_down):
    B, S, D = x.shape
    t = x.reshape(-1, D)
    group_logits = (t @ w_group_router).astype(jnp.float32) + b_group_router.astype(jnp.float32)
    group_probs = jax.nn.softmax(group_logits, axis=-1)
    g_sel = jnp.argmax(group_logits, axis=-1)
    p_group = jnp.take_along_axis(group_probs, g_sel[:, None], axis=-1)
    inner_all = jnp.einsum('nd,gde->nge', t, w_expert_router).astype(jnp.float32) \
        + b_expert_router.astype(jnp.float32)
    inner = jnp.take_along_axis(inner_all, g_sel[:, None, None], axis=1)[:, 0]
    top_vals, top_idx = lax.top_k(inner, TOP_K)
    top_w = jax.nn.softmax(top_vals, axis=-1)
    gate_inner = jnp.sum(jax.nn.one_hot(top_idx, EXPERTS_PER_GROUP, dtype=jnp.float32)
                         * top_w[..., None], axis=1)
    gate_group = jax.nn.one_hot(g_sel, N_GROUPS, dtype=jnp.float32) * p_group
    gates = (gate_group[:, :, None] * gate_inner[:, None, :]).astype(t.dtype)
    y = jnp.zeros_like(t)
    for gi in range(N_GROUPS):
        h = jax.nn.silu(jnp.einsum('nd,edf->nef', t, w_gate[gi])) \
            * jnp.einsum('nd,edf->nef', t, w_up[gi])
        h = h * gates[:, gi, :, None]
        y = y + jnp.einsum('nef,efd->nd', h, w_down[gi])
    return y.reshape(B, S, D)


def setup_inputs(seed: int = 0) -> dict:
    key = jax.random.key(seed)
    ks = jax.random.split(key, 24)
    nrm = lambda k, shape, s: jax.random.normal(k, shape, jnp.float32) * s
    D, E, G, F = D_MODEL, EXPERTS_PER_GROUP, N_GROUPS, D_EXPERT
    x = nrm(ks[0], (BATCH, SEQ, D), 1.0)
    qkv_scale = jnp.concatenate([jnp.ones((2 * D,), jnp.float32),
                                 jnp.full((D,), DEEPNORM_BETA, jnp.float32)])
    sb_w_qkv = nrm(ks[1], (N_SB_LAYERS, D, 3 * D), D ** -0.5) * qkv_scale
    sb_w_o = nrm(ks[2], (N_SB_LAYERS, D, D), D ** -0.5 * DEEPNORM_BETA)
    gm_w_in = nrm(ks[3], (N_GM_LAYERS, D, GM_FFN), D ** -0.5)
    gm_v_ln_g = 1.0 + nrm(ks[4], (N_GM_LAYERS, GM_HALF), 0.02)
    gm_v_ln_b = nrm(ks[5], (N_GM_LAYERS, GM_HALF), 0.02)
    gm_w_spatial = nrm(ks[6], (N_GM_LAYERS, GM_GROUPS, GM_CHUNK, GM_CHUNK), 0.5 * GM_CHUNK ** -0.5)
    gm_b_spatial = 1.0 + nrm(ks[7], (N_GM_LAYERS, GM_GROUPS, GM_CHUNK), 0.02)
    gm_w_out = nrm(ks[8], (N_GM_LAYERS, GM_HALF, D), GM_HALF ** -0.5 * DEEPNORM_BETA)
    mix_ln_g = 1.0 + nrm(ks[9], (DEPTH, D), 0.02)
    mix_ln_b = nrm(ks[10], (DEPTH, D), 0.02)
    moe_w_group_router = nrm(ks[11], (DEPTH, D, G), D ** -0.5)
    moe_b_group_router = nrm(ks[12], (DEPTH, G), 0.01)
    moe_w_expert_router = nrm(ks[13], (DEPTH, G, D, E), D ** -0.5)
    moe_b_expert_router = nrm(ks[14], (DEPTH, G, E), 0.01)
    moe_w_gate = nrm(ks[15], (DEPTH, G, E, D, F), D ** -0.5)
    moe_w_up = nrm(ks[16], (DEPTH, G, E, D, F), D ** -0.5)
    moe_w_down = nrm(ks[17], (DEPTH, G, E, F, D), F ** -0.5 * DEEPNORM_BETA)
    ffn_ln_g = 1.0 + nrm(ks[18], (DEPTH, D), 0.02)
    ffn_ln_b = nrm(ks[19], (DEPTH, D), 0.02)
    return {"x": x, "sb_w_qkv": sb_w_qkv, "sb_w_o": sb_w_o,
            "gm_w_in": gm_w_in, "gm_v_ln_g": gm_v_ln_g, "gm_v_ln_b": gm_v_ln_b,
            "gm_w_spatial": gm_w_spatial, "gm_b_spatial": gm_b_spatial, "gm_w_out": gm_w_out,
            "mix_ln_g": mix_ln_g, "mix_ln_b": mix_ln_b,
            "moe_w_group_router": moe_w_group_router, "moe_b_group_router": moe_b_group_router,
            "moe_w_expert_router": moe_w_expert_router, "moe_b_expert_router": moe_b_expert_router,
            "moe_w_gate": moe_w_gate, "moe_w_up": moe_w_up, "moe_w_down": moe_w_down,
            "ffn_ln_g": ffn_ln_g, "ffn_ln_b": ffn_ln_b}


def reference(x, sb_w_qkv, sb_w_o, gm_w_in, gm_v_ln_g, gm_v_ln_b, gm_w_spatial, gm_b_spatial,
              gm_w_out, mix_ln_g, mix_ln_b, moe_w_group_router, moe_b_group_router,
              moe_w_expert_router, moe_b_expert_router, moe_w_gate, moe_w_up, moe_w_down,
              ffn_ln_g, ffn_ln_b):
    for i in range(DEPTH):
        j = i // N_MIXERS
        if i % N_MIXERS == 0:
            h = stick_breaking_attention(x, sb_w_qkv[j], sb_w_o[j])
        else:
            h = chunked_spatial_gating(x, gm_w_in[j], gm_v_ln_g[j], gm_v_ln_b[j],
                                       gm_w_spatial[j], gm_b_spatial[j], gm_w_out[j])
        x = layer_norm(DEEPNORM_ALPHA * x + h, mix_ln_g[i], mix_ln_b[i])
        f = hierarchical_moe(x, moe_w_group_router[i], moe_b_group_router[i],
                             moe_w_expert_router[i], moe_b_expert_router[i],
                             moe_w_gate[i], moe_w_up[i], moe_w_down[i])
        x = layer_norm(DEEPNORM_ALPHA * x + f, ffn_ln_g[i], ffn_ln_b[i])
    return x
```

```cpp
#include <hip/hip_runtime.h>
#include <cstdint>
#include <cstdio>

#ifndef MK_PER_PHASE
#define MK_PER_PHASE 0
#endif
#ifndef FAST_DENSE
#define FAST_DENSE 1
#endif
#ifndef REP_DENSE
#define REP_DENSE 1
#endif
#ifndef REP_PRO
#define REP_PRO 1
#endif
#ifndef REP_MOE
#define REP_MOE 1
#endif
#ifndef REP_MIX
#define REP_MIX 1
#endif
#ifndef PROBE_GU
#define PROBE_GU 0
#endif
#ifndef PROBE_DN
#define PROBE_DN 0
#endif
#ifndef DBG_KEEP_CONV
#define DBG_KEEP_CONV 0
#endif
#ifndef RES_BF16
#define RES_BF16 1
#endif
#ifndef MOE_PAIRS
#define MOE_PAIRS 1
#endif
#ifndef MOE_MERGE
#define MOE_MERGE 1
#endif
#ifndef MOE_DIRECT
#define MOE_DIRECT 1
#endif
#ifndef FUSE_STATS
#define FUSE_STATS 1
#endif
#ifndef FUSE_ROUTER
#define FUSE_ROUTER 1
#endif
#ifndef FAST_ATTN
#define FAST_ATTN 1
#endif
#ifndef FAST_SPATIAL
#define FAST_SPATIAL 1
#endif
#ifndef FAST_MOE
#define FAST_MOE 1
#endif

#define GAS __attribute__((address_space(1)))
#define LAS __attribute__((address_space(3)))
typedef unsigned short bf16;
typedef float f32x4 __attribute__((ext_vector_type(4)));
typedef float f32x2 __attribute__((ext_vector_type(2)));
typedef short bf16x8 __attribute__((ext_vector_type(8)));
typedef short s16x4 __attribute__((ext_vector_type(4)));
typedef unsigned u32x4 __attribute__((ext_vector_type(4)));
typedef unsigned u32x2 __attribute__((ext_vector_type(2)));
typedef GAS unsigned gu32;
#define RLX_AGENT __ATOMIC_RELAXED, __HIP_MEMORY_SCOPE_AGENT

constexpr int NB = 2, SEQ = 4096, M = NB * SEQ, D = 2048, NH = 16, HD = 128;
constexpr int GF = 12288, GH = 6144, GG = 16, GD = 384, CH = 128;
constexpr int NGRP = 4, NEXP = 8, NX = 32, FE = 512, DEPTH = 4;
constexpr float LN_EPS = 1e-5f;
constexpr float ALPHA = 1.6817928305074290f;
constexpr float QSCALE = 0.08838834764831845f * 1.4426950408889634f;
constexpr int NWAVES = 8, NTHREADS = NWAVES * 64;

constexpr size_t MiB = 1u << 20;
constexpr size_t WS_CTL = 0, CTL_ZERO_BYTES = 1 * MiB;
constexpr size_t WS_WR = 1 * MiB;
constexpr size_t WS_WQKV = 2 * MiB;
constexpr size_t WS_WO = 50 * MiB;
constexpr size_t WS_WIN = 66 * MiB;
constexpr size_t WS_WOUT = 162 * MiB;
constexpr size_t WS_WGU = 210 * MiB;
constexpr size_t WS_WD = 722 * MiB;
constexpr size_t WS_X = 978 * MiB;
constexpr size_t WS_XB = 1042 * MiB;
constexpr size_t WS_Q = 1074 * MiB, WS_K = 1106 * MiB, WS_V = 1138 * MiB, WS_O = 1170 * MiB;
constexpr size_t WS_Z = 1202 * MiB;
constexpr size_t WS_GATED = 1394 * MiB;
constexpr size_t WS_HMIX = 1490 * MiB;
constexpr size_t WS_HP = 1522 * MiB;
constexpr size_t WS_YP = 1546 * MiB;
constexpr size_t WS_LIST = 1642 * MiB;
constexpr size_t WS_TOK = 1643 * MiB;
constexpr size_t WS_STAT = 1644 * MiB;
constexpr size_t WS_WSPB = 1645 * MiB;
constexpr size_t WS_PART = 1646 * MiB;
constexpr size_t WS_END = 1654 * MiB;
constexpr int CNT_STRIDE = 64, DONE_STRIDE = 32;
constexpr int CW_TMO = 0, CW_CODE = 1, CW_CNT = 8192  , CW_DONE = 32768  , CW_QDN = 2048  , CW_BAR = 4096, CW_PFLAG = 131072  ;

constexpr int RING_OFF = 0, RING_BYTES = 131072;
constexpr int TAB_OFF = RING_BYTES;
constexpr int TOFF_OFF = TAB_OFF + 2048, MAXGU = 8;
constexpr int TB_BASE = 192, TB_CNT = 232, TB_NP = 318, TB_PAIR = 320;
constexpr int MOE_TSH = MOE_DIRECT ? 7 : 8, MOE_TR = 1 << MOE_TSH;
constexpr int LDSCTL_OFF = RING_BYTES + 12288, MISC_OFF = LDSCTL_OFF + 320;
constexpr int LDS_BYTES = 147456;

__device__ __forceinline__ unsigned cvt_pk_bf16(float lo, float hi) { unsigned r; asm("v_cvt_pk_bf16_f32 %0, %1, %2" : "=v"(r) : "v"(lo), "v"(hi)); return r; }
__device__ __forceinline__ float bf_lo(unsigned u) { return __uint_as_float(u << 16); }
__device__ __forceinline__ float bf_hi(unsigned u) { return __uint_as_float(u & 0xffff0000u); }
__device__ __forceinline__ float bf2f(bf16 b) { return __uint_as_float((unsigned)b << 16); }
__device__ __forceinline__ float wave_sum(float v) {
#pragma unroll
    for (int o = 1; o < 64; o <<= 1) v += __shfl_xor(v, o);
    return v;
}
__device__ __forceinline__ float fast_exp2(float x) { return __builtin_amdgcn_exp2f(x); }
__device__ __forceinline__ float fast_rcp(float x) { return __builtin_amdgcn_rcpf(x); }
__device__ __forceinline__ float gelu_tanh(float x) {
    const float u = 0.7978845608028654f * (x + 0.044715f * x * x * x);
    const float t = fminf(fmaxf(-2.0f * 1.4426950408889634f * u, -120.f), 120.f);
    return x * fast_rcp(1.0f + fast_exp2(t));
}
__device__ __forceinline__ float silu(float x) {
    const float t = fminf(fmaxf(-1.4426950408889634f * x, -120.f), 120.f);
    return x * fast_rcp(1.0f + fast_exp2(t));
}

#define XB_TMO      128
#define XB_XCNT(j)  (256  + 64 * (j))
#define XB_XSUB(j)  (1280 + 64 * (j))
#define XB_XGEN(j)  (2304 + 64 * (j))
#define XB_TOP      3328
#define XB_TOPGEN   3392
#define XCD_BAR_WORDS 3456
#define XB_SPIN_CAP (1u << 22)

__device__ __forceinline__ unsigned xb_ld(unsigned* p)              { return __hip_atomic_load(p, __ATOMIC_RELAXED, __HIP_MEMORY_SCOPE_AGENT); }
__device__ __forceinline__ unsigned xb_add(unsigned* p, unsigned v) { return __hip_atomic_fetch_add(p, v, __ATOMIC_RELAXED, __HIP_MEMORY_SCOPE_AGENT); }
__device__ __forceinline__ unsigned xb_xcc_id() { return (unsigned)__builtin_amdgcn_s_getreg((3 << 11) | 20) & 0xFu; }
#define XB_SPIN(cond, bar) do { unsigned _sp = 0; while (cond) { __builtin_amdgcn_s_sleep(1); \
    if ((++_sp & 255u) == 0u) { if (xb_ld(&(bar)[XB_TMO])) break; if (_sp > XB_SPIN_CAP) { atomicAdd(&(bar)[XB_TMO], 1u); break; } } } } while (0)

struct XcdBarrier { unsigned* bar; unsigned x; volatile LAS unsigned* st; };

__device__ __forceinline__ XcdBarrier xcd_barrier_post(unsigned* bar, volatile LAS unsigned* st) {
    XcdBarrier b; b.bar = bar; b.x = xb_xcc_id(); b.st = st;
    if (threadIdx.x == 0) (void)xb_add(&bar[XB_XCNT(b.x)], 1u);
    return b;
}
__device__ __forceinline__ void xcd_barrier_complete(unsigned* bar, unsigned x, unsigned& nloc, unsigned& nx) {
    const unsigned G = gridDim.x * gridDim.y * gridDim.z;
    unsigned sum, cnt, mine, sp = 0u;
    for (;;) {
        sum = 0u; cnt = 0u; mine = 0u;
#pragma unroll
        for (unsigned j = 0; j < 16; ++j) { const unsigned c = xb_ld(&bar[XB_XCNT(j)]); sum += c; cnt += (c > 0u) ? 1u : 0u; mine = (j == x) ? c : mine; }
        if (sum == G) break;
        __builtin_amdgcn_s_sleep(1);
        if ((++sp & 255u) == 0u) { if (xb_ld(&bar[XB_TMO])) break; if (sp > XB_SPIN_CAP) { atomicAdd(&bar[XB_TMO], 1u); break; } }
    }
    nloc = mine > 0u ? mine : 1u; nx = cnt > 0u ? cnt : 1u;
}
__device__ __forceinline__ void xcd_barrier(const XcdBarrier& b) {
    asm volatile("s_waitcnt vmcnt(0)" ::: "memory");
    __syncthreads();
    if (threadIdx.x == 0) {
        unsigned* bar = b.bar;
        __builtin_amdgcn_s_waitcnt(0);
        unsigned nloc = b.st[0], nx = b.st[1];
        if (nloc == 0u) { xcd_barrier_complete(bar, b.x, nloc, nx); b.st[0] = nloc; b.st[1] = nx; }
        const unsigned old = xb_add(&bar[XB_XSUB(b.x)], 1u);
        const unsigned gen = old / nloc;
        if (old + 1u == (gen + 1u) * nloc) {
            __builtin_amdgcn_fence(__ATOMIC_RELEASE, "agent");
            asm volatile("s_waitcnt vmcnt(0)" ::: "memory");
            const unsigned og = xb_add(&bar[XB_TOP], 1u);
            const unsigned tg = og / nx;
            if (og + 1u == (tg + 1u) * nx) xb_add(&bar[XB_TOPGEN], 1u);
            else XB_SPIN(xb_ld(&bar[XB_TOPGEN]) == tg, bar);
            __builtin_amdgcn_fence(__ATOMIC_ACQUIRE, "agent");
            xb_add(&bar[XB_XGEN(b.x)], 1u);
            asm volatile("s_waitcnt vmcnt(0)" ::: "memory");
        } else {
            XB_SPIN(xb_ld(&bar[XB_XGEN(b.x)]) == gen, bar);
            __builtin_amdgcn_fence(__ATOMIC_ACQUIRE, "agent");
            asm volatile("s_waitcnt vmcnt(0)" ::: "memory");
        }
    }
    __syncthreads();
}

namespace pg8 {
constexpr int BM = 256, BK = 64, HALF = 128, HTB = HALF * BK * 2, STAGE_BYTES = 8 * HTB, NXCD = 8, WGM = 8;
__host__ __device__ __forceinline__ int lds_byte(int r, int c) { const int st = (r >> 4) * 2 + (c >> 5), rr = r & 15, cc = c & 31, ob = rr * 64 + cc * 2; return st * 1024 + (ob ^ (((ob >> 9) & 1) << 5)); }
__host__ __device__ __forceinline__ void stage_rc(int b, int& R, int& C) { const int st = b / 1024, sb = b % 1024, swz = sb ^ (((sb >> 9) & 1) << 5); R = (st >> 1) * 16 + swz / 64; C = (st & 1) * 32 + (swz % 64) / 2; }
__host__ __device__ __forceinline__ int perm32(int rho) { const int n = rho >> 4, i = rho & 15; return 8 * (i >> 2) + 4 * n + (i & 3); }

struct Unit { int pm, pn, e; };

struct DenseOrder {
    static constexpr bool GATHER = false;
    const bf16* A; const bf16* Bt; int K; int nM, nN, nwg, G, c;
    __device__ void init(const bf16* A_, const bf16* Bt_, int M_, int N_, int K_, int G_, int c_) { A = A_; Bt = Bt_; K = K_; nM = M_ / BM; nN = N_ / BM; nwg = nM * nN; G = G_; c = c_; }
    __device__ bool next(int i, Unit& u) const {
        const long L = (long)i * G + c; if (L >= nwg) return false;
        int wgid = (int)L; { const int q = nwg / NXCD, r = nwg % NXCD, xcd = wgid % NXCD, off = wgid / NXCD; wgid = (xcd < r ? xcd * (q + 1) : r * (q + 1) + (xcd - r) * q) + off; }
        const int nig = WGM * nN, gid = wgid / nig, fm = gid * WGM, gsz = (nM - fm) < WGM ? (nM - fm) : WGM;
        u.pm = fm + ((wgid % nig) % gsz); u.pn = (wgid % nig) / gsz; u.e = 0; return true;
    }
    __device__ __forceinline__ const char* abase(const Unit& u) const { return (const char*)A + (size_t)u.pm * BM * K * 2; }
    __device__ __forceinline__ const char* bbase(const Unit& u) const { return (const char*)Bt + (size_t)u.pn * BM * K * 2; }
    __device__ __forceinline__ unsigned aoff(int, int) const { return 0u; }
};
template <bool GATHER_, int NPN>
struct MoeOrder {
    static constexpr bool GATHER = GATHER_;
    const bf16* A; const bf16* W; int K; size_t wstride; int T, G, vcu; const LAS int* tab; const LAS unsigned* toff;
    __device__ bool next(int i, Unit& u) const {
        const int idx = i * G + vcu; if (idx >= T * NPN || (GATHER && i >= MAXGU)) return false;
        u.pm = idx / NPN; u.pn = idx % NPN; u.e = tab[u.pm]; return true;
    }
    __device__ __forceinline__ const char* abase(const Unit& u) const { return GATHER ? (const char*)A : (const char*)A + (size_t)u.pm * BM * K * 2; }
    __device__ __forceinline__ const char* bbase(const Unit& u) const { return (const char*)W + ((size_t)u.e * wstride + (size_t)u.pn * BM * K) * 2; }
    __device__ __forceinline__ unsigned aoff(int ui, int r) const { return toff[ui * 256 + r]; }
};

__device__ __forceinline__ f32x2 gelu_tanh2(f32x2 v) {
    const f32x2 u = (v * v * 0.044715f + 1.0f) * v * (-2.0f * 0.7978845608028654f * 1.4426950408889634f);
    f32x2 e; e.x = __builtin_amdgcn_exp2f(u.x); e.y = __builtin_amdgcn_exp2f(u.y);
    const f32x2 d = e + 1.0f; f32x2 r; r.x = __builtin_amdgcn_rcpf(d.x); r.y = __builtin_amdgcn_rcpf(d.y);
    return v * r;
}
template <int ACT  > struct EpiBf16 {
    bf16* O; int ldc; int split_cols; size_t split_stride; f32x2* part; int part_pn0;
    __device__ __forceinline__ void operator()(const f32x4 (&acc)[2][2][4][2], const Unit& u, int wr, int wc, int fr, int fq) const {
        const int row0 = u.pm * BM + wr * 64 + fr; int colt = u.pn * BM; bf16* base = O;
        if (split_cols) { const int t = colt / split_cols; base += (size_t)t * split_stride; colt -= t * split_cols; }
        const int col0 = colt + wc * 32 + 8 * fq;
#pragma unroll
        for (int ai = 0; ai < 2; ++ai)
#pragma unroll
            for (int m = 0; m < 4; ++m) { bf16* rowp = base + (size_t)(row0 + ai * HALF + m * 16) * ldc + col0; float ps = 0.f, pq = 0.f;
#pragma unroll
                for (int bj = 0; bj < 2; ++bj) { f32x4 v0 = acc[ai][bj][m][0], v1 = acc[ai][bj][m][1];
                    if (ACT == 2) { const f32x2 a = gelu_tanh2((f32x2){v0[0], v0[1]}), b = gelu_tanh2((f32x2){v0[2], v0[3]}), c = gelu_tanh2((f32x2){v1[0], v1[1]}), d = gelu_tanh2((f32x2){v1[2], v1[3]});
                        v0 = (f32x4){a.x, a.y, b.x, b.y}; v1 = (f32x4){c.x, c.y, d.x, d.y}; }
                    u32x4 w; w.x = cvt_pk_bf16(v0[0], v0[1]); w.y = cvt_pk_bf16(v0[2], v0[3]); w.z = cvt_pk_bf16(v1[0], v1[1]); w.w = cvt_pk_bf16(v1[2], v1[3]);
                    *(u32x4*)(rowp + bj * HALF) = w;
                    if (ACT == 2) { ps += (bf_lo(w.x) + bf_hi(w.x)) + (bf_lo(w.y) + bf_hi(w.y)) + (bf_lo(w.z) + bf_hi(w.z)) + (bf_lo(w.w) + bf_hi(w.w));
                        pq += (bf_lo(w.x) * bf_lo(w.x) + bf_hi(w.x) * bf_hi(w.x)) + (bf_lo(w.y) * bf_lo(w.y) + bf_hi(w.y) * bf_hi(w.y)) + (bf_lo(w.z) * bf_lo(w.z) + bf_hi(w.z) * bf_hi(w.z)) + (bf_lo(w.w) * bf_lo(w.w) + bf_hi(w.w) * bf_hi(w.w)); } }
                if (ACT == 2 && part && u.pn >= part_pn0) {
                    ps += __shfl_xor(ps, 16); ps += __shfl_xor(ps, 32); pq += __shfl_xor(pq, 16); pq += __shfl_xor(pq, 32);
                    if (fq == 0) part[(size_t)(row0 + ai * HALF + m * 16) * 96 + (u.pn - part_pn0) * 4 + wc] = (f32x2){ps, pq}; } }
    }
};
struct EpiSwiglu {
    bf16* H;
    __device__ __forceinline__ void operator()(const f32x4 (&acc)[2][2][4][2], const Unit& u, int wr, int wc, int fr, int fq) const {
        const int row0 = u.pm * BM + wr * 64 + fr, col0 = u.pn * HALF + wc * 32 + 8 * fq;
#pragma unroll
        for (int ai = 0; ai < 2; ++ai)
#pragma unroll
            for (int m = 0; m < 4; ++m) {
                f32x4 h[2];
#pragma unroll
                for (int n = 0; n < 2; ++n) { const f32x4 g = acc[ai][0][m][n], up = acc[ai][1][m][n];
                    f32x4 e; e.x = __builtin_amdgcn_exp2f(g.x * -1.4426950408889634f); e.y = __builtin_amdgcn_exp2f(g.y * -1.4426950408889634f); e.z = __builtin_amdgcn_exp2f(g.z * -1.4426950408889634f); e.w = __builtin_amdgcn_exp2f(g.w * -1.4426950408889634f);
                    e = e + 1.0f; f32x4 r; r.x = __builtin_amdgcn_rcpf(e.x); r.y = __builtin_amdgcn_rcpf(e.y); r.z = __builtin_amdgcn_rcpf(e.z); r.w = __builtin_amdgcn_rcpf(e.w);
                    h[n] = g * r * up; }
                u32x4 w; w.x = cvt_pk_bf16(h[0][0], h[0][1]); w.y = cvt_pk_bf16(h[0][2], h[0][3]); w.z = cvt_pk_bf16(h[1][0], h[1][1]); w.w = cvt_pk_bf16(h[1][2], h[1][3]);
                *(u32x4*)(H + (size_t)(row0 + ai * HALF + m * 16) * FE + col0) = w;
            }
    }
};

template <class Epi, class Sched, bool ALIGN_EPI>
__device__ __forceinline__ void gemm_phase(LAS unsigned char* lds, const int K, const Sched& S, const Epi& E) {
    int tid_ = threadIdx.x; asm volatile("" : "+v"(tid_));
    const int tid = tid_, wid = __builtin_amdgcn_readfirstlane(tid >> 6), lane = tid & 63, wr = wid >> 2, wc = wid & 3, fr = lane & 15, fq = lane >> 4;
    const int nt = K / BK;
    int RA[2], CA[2]; unsigned voffB[2];
#pragma unroll
    for (int i = 0; i < 2; ++i) { int R, C; stage_rc(tid * 16 + i * 8192, R, C); const int Rb = (R & ~31) + perm32(R & 31); RA[i] = R; CA[i] = C; voffB[i] = (unsigned)(Rb * K + C) * 2u; }
    const size_t kstep = (size_t)(BK * 2);
    const size_t hstep = (size_t)HALF * K * 2;
    const unsigned ldsw = (unsigned)wid * 1024u;
    const int aoff = lds_byte(wr * 64 + fr, fq * 8), boff = lds_byte(wc * 32 + fr, fq * 8);
#define PG8_SA(b, h) (((b) * 2 + (h)) * HTB)
#define PG8_SB(b, h) ((4 + (b) * 2 + (h)) * HTB)
#define PG8_STAGE(bufoff, gbase, voff) do { _Pragma("unroll") for (int _i = 0; _i < 2; ++_i) \
        __builtin_amdgcn_global_load_lds((const unsigned*)((const char*)(gbase) + (voff)[_i]), (LAS unsigned*)(lds + (bufoff) + ldsw + _i * 8192), 16, 0, 0); } while (0)
#define PG8_LDA(dst, b, h) do { _Pragma("unroll") for (int m = 0; m < 4; ++m) _Pragma("unroll") for (int k = 0; k < 2; ++k) dst[m][k] = *(const LAS bf16x8*)(lds + PG8_SA(b, h) + aoff + m * 2048 + k * 1024); } while (0)
#define PG8_LDB(dst, b, h) do { _Pragma("unroll") for (int n = 0; n < 2; ++n) _Pragma("unroll") for (int k = 0; k < 2; ++k) dst[n][k] = *(const LAS bf16x8*)(lds + PG8_SB(b, h) + boff + n * 2048 + k * 1024); } while (0)
#define PG8_MMA(ai, bj, At, Bt) do { __builtin_amdgcn_s_setprio(1); _Pragma("unroll") for (int m = 0; m < 4; ++m) _Pragma("unroll") for (int n = 0; n < 2; ++n) _Pragma("unroll") for (int k = 0; k < 2; ++k) \
        acc[ai][bj][m][n] = __builtin_amdgcn_mfma_f32_16x16x32_bf16(Bt[n][k], At[m][k], acc[ai][bj][m][n], 0, 0, 0); __builtin_amdgcn_s_setprio(0); } while (0)
#define PG8_WAIT_V(n) asm volatile("s_waitcnt vmcnt(" #n ")" ::: "memory")
#define PG8_WAIT_L(n) asm volatile("s_waitcnt lgkmcnt(" #n ")" ::: "memory")
#define PG8_BAR __builtin_amdgcn_s_barrier()
#define PG8_SCHED __builtin_amdgcn_sched_barrier(0)
#define PG8_AVOFF(dst, uu, uidx) do { _Pragma("unroll") for (int _h = 0; _h < 2; ++_h) _Pragma("unroll") for (int _i = 0; _i < 2; ++_i) \
        dst[_h][_i] = Sched::GATHER ? S.aoff(uidx, _h * HALF + RA[_i]) + (unsigned)CA[_i] * 2u : (unsigned)((_h * HALF + RA[_i]) * K + CA[_i]) * 2u; } while (0)
    Unit cur, nxt; int ui = 0;
    if (!S.next(0, cur)) return;
    f32x4 acc[2][2][4][2];
#pragma unroll
    for (int a = 0; a < 2; ++a)
#pragma unroll
        for (int b = 0; b < 2; ++b)
#pragma unroll
            for (int m = 0; m < 4; ++m)
#pragma unroll
                for (int n = 0; n < 2; ++n) acc[a][b][m][n] = (f32x4){0.f, 0.f, 0.f, 0.f};
    bf16x8 At[4][2], B0[2][2], B1[2][2];
    unsigned vA[2][2], vN[2][2];
    PG8_AVOFF(vA, cur, 0);
    const char* cA = S.abase(cur); const char* cB = S.bbase(cur);
    PG8_STAGE(PG8_SB(0, 0), cB, voffB); PG8_STAGE(PG8_SB(0, 1), cB + hstep, voffB); PG8_STAGE(PG8_SA(0, 0), cA, vA[0]); PG8_STAGE(PG8_SA(0, 1), cA, vA[1]);
    if (wr == 1) PG8_BAR;
    PG8_WAIT_V(2); PG8_BAR;
    PG8_STAGE(PG8_SB(1, 0), cB + kstep, voffB); PG8_STAGE(PG8_SA(1, 0), cA + kstep, vA[0]); PG8_STAGE(PG8_SB(1, 1), cB + hstep + kstep, voffB);
    PG8_WAIT_V(6); PG8_BAR;
    for (;;) {
        const bool has_next = S.next(ui + 1, nxt);
        const char* nA = has_next ? S.abase(nxt) : cA; const char* nB = has_next ? S.bbase(nxt) : cB;
        if (Sched::GATHER) { if (has_next) { PG8_AVOFF(vN, nxt, ui + 1); } else {
#pragma unroll
            for (int h = 0; h < 2; ++h)
#pragma unroll
                for (int i = 0; i < 2; ++i) vN[h][i] = vA[h][i]; } }
        for (int t = 0; t < nt; t += 2) {
            const bool last = (t == nt - 2);
            const char* a1 = cA + (size_t)(t + 1) * kstep;
            const char* a2 = last ? nA : cA + (size_t)(t + 2) * kstep; const char* b2 = last ? nB : cB + (size_t)(t + 2) * kstep;
            const char* a3 = a2 + kstep; const char* b3 = b2 + kstep;
            unsigned v2[2][2];
#pragma unroll
            for (int h = 0; h < 2; ++h)
#pragma unroll
                for (int i = 0; i < 2; ++i) v2[h][i] = (Sched::GATHER && last) ? vN[h][i] : vA[h][i];
            PG8_LDB(B0, 0, 0); PG8_LDB(B1, 0, 1); PG8_SCHED; PG8_LDA(At, 0, 0); PG8_STAGE(PG8_SA(1, 1), a1, vA[1]);
            PG8_WAIT_V(8); PG8_WAIT_L(0); PG8_BAR; PG8_MMA(0, 0, At, B0); PG8_MMA(0, 1, At, B1); PG8_BAR; PG8_SCHED;
            PG8_LDA(At, 0, 1); PG8_STAGE(PG8_SB(0, 0), b2, voffB); PG8_STAGE(PG8_SB(0, 1), b2 + hstep, voffB); PG8_STAGE(PG8_SA(0, 0), a2, v2[0]);
            PG8_WAIT_V(8); PG8_WAIT_L(0); PG8_BAR; PG8_MMA(1, 0, At, B0); PG8_MMA(1, 1, At, B1); PG8_BAR; PG8_SCHED;
            PG8_LDB(B0, 1, 0); PG8_LDB(B1, 1, 1); PG8_SCHED; PG8_LDA(At, 1, 0); PG8_STAGE(PG8_SA(0, 1), a2, v2[1]);
            PG8_WAIT_V(8); PG8_WAIT_L(0); PG8_BAR; PG8_MMA(0, 0, At, B0); PG8_MMA(0, 1, At, B1); PG8_BAR; PG8_SCHED;
            PG8_LDA(At, 1, 1); PG8_STAGE(PG8_SB(1, 0), b3, voffB); PG8_STAGE(PG8_SB(1, 1), b3 + hstep, voffB); PG8_STAGE(PG8_SA(1, 0), a3, v2[0]);
            PG8_WAIT_V(8); PG8_WAIT_L(0); PG8_BAR; PG8_MMA(1, 0, At, B0); PG8_MMA(1, 1, At, B1); PG8_BAR; PG8_SCHED;
        }
        if constexpr (ALIGN_EPI) { if (wr == 0) PG8_BAR; }
        E(acc, cur, wr, wc, fr, fq);
        if (!has_next) break;
#pragma unroll
        for (int a = 0; a < 2; ++a)
#pragma unroll
            for (int b = 0; b < 2; ++b)
#pragma unroll
                for (int m = 0; m < 4; ++m)
#pragma unroll
                    for (int n = 0; n < 2; ++n) acc[a][b][m][n] = (f32x4){0.f, 0.f, 0.f, 0.f};
        cur = nxt; cA = nA; cB = nB; ++ui;
        if (Sched::GATHER) {
#pragma unroll
            for (int h = 0; h < 2; ++h)
#pragma unroll
                for (int i = 0; i < 2; ++i) vA[h][i] = vN[h][i]; }
        if constexpr (ALIGN_EPI) { if (wr == 1) PG8_BAR; }
    }
    PG8_WAIT_V(0);
    if constexpr (!ALIGN_EPI) { if (wr == 0) PG8_BAR; }
    PG8_BAR;
#undef PG8_SA
#undef PG8_SB
#undef PG8_STAGE
#undef PG8_LDA
#undef PG8_LDB
#undef PG8_MMA
#undef PG8_WAIT_V
#undef PG8_WAIT_L
#undef PG8_BAR
#undef PG8_SCHED
#undef PG8_AVOFF
}
}

struct Args { const float* in[20]; float* out; unsigned char* ws; int ph_lo, ph_hi; };
typedef __attribute__((address_space(4))) const unsigned char* kargp_t;
__device__ __forceinline__ kargp_t karg_base() { kargp_t k = (kargp_t)__builtin_amdgcn_kernarg_segment_ptr(); asm volatile("" : "+s"(k)); return k; }
struct ArgsP {
    struct InP { __device__ __forceinline__ const float* operator[](int i) const { return *(const float* const __attribute__((address_space(4)))*)(karg_base() + 8 * i); } } in;
    struct WsP { __device__ __forceinline__ operator unsigned char*() const { return *(unsigned char* const __attribute__((address_space(4)))*)(karg_base() + 168); }
                 __device__ __forceinline__ unsigned char* operator+(size_t o) const { return (unsigned char*)(*this) + o; } } ws;
    struct OutP { __device__ __forceinline__ operator float*() const { return *(float* const __attribute__((address_space(4)))*)(karg_base() + 160); } } out;
};
static_assert(sizeof(Args) == 184, "kernarg layout: in[20] | out @160 | ws @168 | ph_lo @176 | ph_hi @180");
enum { I_X = 0, I_WQKV, I_WO, I_WIN, I_VLNG, I_VLNB, I_WSP, I_BSP, I_WOUT, I_MLNG, I_MLNB, I_WGR, I_BGR, I_WER, I_BER, I_WG, I_WU, I_WDN, I_FLNG, I_FLNB };

struct Ctx { int tid, lane, wave, gw, NGW; LAS unsigned char* lds; unsigned char* ws; };
__device__ __forceinline__ Ctx phase_ctx(const Ctx& c) { Ctx d = c; int t = c.tid; asm volatile("" : "+v"(t)); d.tid = t; d.lane = t & 63; return d; }

typedef short v4i16_t __attribute__((ext_vector_type(4)));
__device__ __forceinline__ s16x4 lds_tr(LAS const unsigned char* p) { return __builtin_bit_cast(s16x4, __builtin_amdgcn_ds_read_tr16_b64_v4i16((LAS v4i16_t*)p)); }
__device__ __forceinline__ s16x4 lds_tr_asm(LAS const unsigned char* p) { s16x4 r; asm volatile("ds_read_b64_tr_b16 %0, %1" : "=v"(r) : "v"((unsigned)(size_t)p) : "memory"); return r; }

constexpr int TRP = 136;
__device__ __forceinline__ void tr_item(const float* __restrict__ src, int N, int k0, int n0, bf16* __restrict__ dst, int Kd, int drow0, float scale, LAS unsigned char* scr, int lane) {
    const int lk = lane >> 4, ln4 = (lane & 15) * 4;
    f32x4 v[16];
#pragma unroll
    for (int i = 0; i < 16; ++i) v[i] = *(const f32x4*)(src + (size_t)(k0 + 4 * i + lk) * N + n0 + ln4);
#pragma unroll
    for (int i = 0; i < 16; ++i) {
        u32x2 w; w.x = cvt_pk_bf16(v[i].x * scale, v[i].y * scale); w.y = cvt_pk_bf16(v[i].z * scale, v[i].w * scale);
        *(LAS u32x2*)(scr + (4 * i + lk) * TRP + ln4 * 2) = w;
    }
    asm volatile("s_waitcnt lgkmcnt(0)" ::: "memory");
    const int g = lane >> 4, i16 = lane & 15, q = i16 >> 2, p = i16 & 3;
#pragma unroll
    for (int t = 0; t < 8; ++t) {
        const int nb = 16 * (t >> 1), oct = (t & 1) * 4 + g;
        LAS const unsigned char* ad = scr + (8 * oct + q) * TRP + (nb + 4 * p) * 2;
        const s16x4 lo = lds_tr(ad), hi = lds_tr(ad + 4 * TRP);
        const bf16x8 o = __builtin_shufflevector(lo, hi, 0, 1, 2, 3, 4, 5, 6, 7);
        *(bf16x8*)(dst + (size_t)(drow0 + nb + i16) * Kd + k0 + 8 * oct) = o;
    }
    asm volatile("s_waitcnt lgkmcnt(0)" ::: "memory");
}

__device__ __forceinline__ void p0_prologue(const ArgsP& a, const Ctx& c) {
    LAS unsigned char* scr = c.lds + RING_OFF + c.wave * 16384;
    constexpr int T_QKV = 2 * (D / 64) * (3 * D / 64), T_WO = 2 * (D / 64) * (D / 64), T_WIN = 2 * (D / 64) * (GF / 64), T_WOUT = 2 * (GH / 64) * (D / 64);
    constexpr int T_G = DEPTH * NX * (D / 64) * (FE / 64), T_DN = DEPTH * NX * (FE / 64) * (D / 64);
    constexpr int NITEMS = T_QKV + T_WO + T_WIN + T_WOUT + ((MOE_DIRECT && FAST_MOE && !DBG_KEEP_CONV) ? 0 : 2 * T_G + T_DN);
    for (int it = c.gw; it < NITEMS; it += c.NGW) {
        int r = it;
        if (r < T_QKV) { const int per = (D / 64) * (3 * D / 64), j = r / per; r %= per; const int kb = r / (3 * D / 64), nb = r % (3 * D / 64);
            tr_item(a.in[I_WQKV] + (size_t)j * D * 3 * D, 3 * D, kb * 64, nb * 64, (bf16*)(a.ws + WS_WQKV) + (size_t)j * 3 * D * D, D, nb * 64, nb * 64 < D ? QSCALE : 1.0f, scr, c.lane); continue; }
        r -= T_QKV;
        if (r < T_WO) { const int per = (D / 64) * (D / 64), j = r / per; r %= per; const int kb = r / (D / 64), nb = r % (D / 64);
            tr_item(a.in[I_WO] + (size_t)j * D * D, D, kb * 64, nb * 64, (bf16*)(a.ws + WS_WO) + (size_t)j * D * D, D, nb * 64, 1.0f, scr, c.lane); continue; }
        r -= T_WO;
        if (r < T_WIN) { const int per = (D / 64) * (GF / 64), j = r / per; r %= per; const int kb = r / (GF / 64), nb = r % (GF / 64);
            tr_item(a.in[I_WIN] + (size_t)j * D * GF, GF, kb * 64, nb * 64, (bf16*)(a.ws + WS_WIN) + (size_t)j * GF * D, D, nb * 64, 1.0f, scr, c.lane); continue; }
        r -= T_WIN;
        if (r < T_WOUT) { const int per = (GH / 64) * (D / 64), j = r / per; r %= per; const int kb = r / (D / 64), nb = r % (D / 64);
            tr_item(a.in[I_WOUT] + (size_t)j * GH * D, D, kb * 64, nb * 64, (bf16*)(a.ws + WS_WOUT) + (size_t)j * D * GH, GH, nb * 64, 1.0f, scr, c.lane); continue; }
        r -= T_WOUT;
        if (r < 2 * T_G) { const int up = r >= T_G; if (up) r -= T_G; const int per = (D / 64) * (FE / 64), x = r / per; r %= per; const int kb = r / (FE / 64), nb = r % (FE / 64);
            const int f0 = nb * 64, drow = 256 * (f0 >> 7) + 128 * up + (f0 & 127);
            tr_item(a.in[up ? I_WU : I_WG] + (size_t)x * D * FE, FE, kb * 64, f0, (bf16*)(a.ws + WS_WGU) + (size_t)x * 1024 * D, D, drow, 1.0f, scr, c.lane); continue; }
        r -= 2 * T_G;
        { const int per = (FE / 64) * (D / 64), x = r / per; r %= per; const int kb = r / (D / 64), nb = r % (D / 64);
            tr_item(a.in[I_WDN] + (size_t)x * FE * D, D, kb * 64, nb * 64, (bf16*)(a.ws + WS_WD) + (size_t)x * D * FE, FE, nb * 64, 1.0f, scr, c.lane); }
    }
    {
        const int gt = blockIdx.x * NTHREADS + c.tid, GT = gridDim.x * NTHREADS;
        bf16* wr = (bf16*)(a.ws + WS_WR);
        for (int i = gt; i < DEPTH * 48 * D; i += GT) {
            const int k = i % D, rho = (i / D) % 48, L = i / (48 * D), nt = rho >> 4, g = (rho >> 2) & 3, ii = rho & 3;
            float v = 0.f;
            if (nt < 2) v = a.in[I_WER][((size_t)(L * NGRP + g) * D + k) * NEXP + 4 * nt + ii];
            else if (ii == 0) v = a.in[I_WGR][((size_t)L * D + k) * NGRP + g];
            wr[i] = (bf16)(cvt_pk_bf16(v, 0.f) & 0xffffu);
        }
        bf16* wsb = (bf16*)(a.ws + WS_WSPB);
        for (int i = gt; i < 2 * GG * CH * CH; i += GT) { const int s_ = i % CH, t_ = (i / CH) % CH; wsb[i] = (bf16)(cvt_pk_bf16(s_ <= t_ ? a.in[I_WSP][i] : 0.f, 0.f) & 0xffffu); }
        const f32x4* x4 = (const f32x4*)a.in[I_X]; u32x2* xb = (u32x2*)(a.ws + WS_XB);
        for (int i = gt; i < M * D / 4; i += GT) { const f32x4 v = x4[i]; u32x2 w; w.x = cvt_pk_bf16(v.x, v.y); w.y = cvt_pk_bf16(v.z, v.w); xb[i] = w; }
    }
}

#define MFMA16(a, b, c) __builtin_amdgcn_mfma_f32_16x16x32_bf16((a), (b), (c), 0, 0, 0)
__device__ __forceinline__ void sg_tile(const bf16* a0, const bf16* a1, const bf16* b0, const bf16* b1, const bf16* b2, const bf16* b3, int K, f32x4 (&acc)[2][4]) {
#pragma unroll
    for (int i = 0; i < 2; ++i)
#pragma unroll
        for (int j = 0; j < 4; ++j) acc[i][j] = (f32x4){0.f, 0.f, 0.f, 0.f};
    for (int k = 0; k < K; k += 32) {
        const bf16x8 fa0 = *(const bf16x8*)(a0 + k), fa1 = *(const bf16x8*)(a1 + k);
        const bf16x8 fb0 = *(const bf16x8*)(b0 + k), fb1 = *(const bf16x8*)(b1 + k), fb2 = *(const bf16x8*)(b2 + k), fb3 = *(const bf16x8*)(b3 + k);
        acc[0][0] = MFMA16(fb0, fa0, acc[0][0]); acc[0][1] = MFMA16(fb1, fa0, acc[0][1]); acc[0][2] = MFMA16(fb2, fa0, acc[0][2]); acc[0][3] = MFMA16(fb3, fa0, acc[0][3]);
        acc[1][0] = MFMA16(fb0, fa1, acc[1][0]); acc[1][1] = MFMA16(fb1, fa1, acc[1][1]); acc[1][2] = MFMA16(fb2, fa1, acc[1][2]); acc[1][3] = MFMA16(fb3, fa1, acc[1][3]);
    }
}
__device__ __forceinline__ void st_bf16x4(bf16* p, f32x4 v) { u32x2 w; w.x = cvt_pk_bf16(v.x, v.y); w.y = cvt_pk_bf16(v.z, v.w); *(u32x2*)p = w; }

template <int EPI>
__device__ __forceinline__ void sg_dense(const Ctx& c, const bf16* A, const bf16* Bt, int Mr, int N, int K, bf16* O) {
    const int fr = c.lane & 15, fq = c.lane >> 4, ntn = N / 64, ntiles = (Mr / 32) * ntn;
    for (int t = c.gw; t < ntiles; t += c.NGW) {
        const int m0 = (t / ntn) * 32, n0 = (t % ntn) * 64;
        f32x4 acc[2][4];
        const bf16* ap = A + (size_t)(m0 + fr) * K + 8 * fq; const bf16* bp = Bt + (size_t)(n0 + fr) * K + 8 * fq;
        sg_tile(ap, ap + (size_t)16 * K, bp, bp + (size_t)16 * K, bp + (size_t)32 * K, bp + (size_t)48 * K, K, acc);
#pragma unroll
        for (int mt = 0; mt < 2; ++mt)
#pragma unroll
            for (int nt = 0; nt < 4; ++nt) {
                const int row = m0 + 16 * mt + fr, col = n0 + 16 * nt + 4 * fq; f32x4 v = acc[mt][nt];
                if (EPI == 0) st_bf16x4(O + (size_t)row * N + col, v);
                if (EPI == 1) { const int w = col / D, cc = col % D; st_bf16x4(O + (size_t)w * ((WS_K - WS_Q) / 2) + (size_t)row * D + cc, v); }
                if (EPI == 2) { v.x = gelu_tanh(v.x); v.y = gelu_tanh(v.y); v.z = gelu_tanh(v.z); v.w = gelu_tanh(v.w); st_bf16x4(O + (size_t)row * N + col, v); }
            }
    }
}

__device__ __forceinline__ void moe_tables(const ArgsP& a, const Ctx& c, int L) {
    LAS int* tab = (LAS int*)(c.lds + TAB_OFF);
    if (c.tid < 64) {
        gu32* cnt = (gu32*)(a.ws + WS_CTL) + CW_CNT + L * 32 * CNT_STRIDE;
        const int e = c.lane & 31;
        const int cj = (int)__hip_atomic_load(cnt + e * CNT_STRIDE, RLX_AGENT), n = (cj + MOE_TR - 1) >> MOE_TSH;
        int incl = n;
#pragma unroll
        for (int o = 1; o < 32; o <<= 1) { const int t = __shfl_up(incl, o, 32); if (e >= o) incl += t; }
        const int base = incl - n;
        if (c.lane < 32) { tab[TB_BASE + e] = base; tab[TB_CNT + e] = cj; if (e == 31) tab[TB_BASE + 32] = incl; for (int i = 0; i < n; ++i) tab[base + i] = e; }
        const int np = (n + 1) >> 1; int pincl = np;
#pragma unroll
        for (int o = 1; o < 32; o <<= 1) { const int t = __shfl_up(pincl, o, 32); if (e >= o) pincl += t; }
        if (c.lane < 32) { const int pb = pincl - np; if (e == 31) tab[TB_NP] = pincl; for (int i = 0; i < np; ++i) tab[TB_PAIR + pb + i] = (base + 2 * i) | ((2 * i + 1 < n ? 2 : 1) << 16); }
    }
    __syncthreads();
}

__device__ __forceinline__ void sg_moe_gu(const ArgsP& a, const Ctx& c, int L) {
    LAS int* tab = (LAS int*)(c.lds + TAB_OFF);
    const int T = tab[TB_BASE + 32], fr = c.lane & 15, fq = c.lane >> 4, ntiles = T * (MOE_TR / 32) * 16;
    const bf16* xb = (const bf16*)(a.ws + WS_XB); const int* list = (const int*)(a.ws + WS_LIST); bf16* hp = (bf16*)(a.ws + WS_HP);
    for (int t = c.gw; t < ntiles; t += c.NGW) {
        const int rt = t / 16, fb = t % 16, prow0 = rt * 32, e = tab[prow0 >> MOE_TSH], ebase = MOE_TR * tab[TB_BASE + e], ecnt = tab[TB_CNT + e];
        const int p0 = prow0 - ebase + fr, p1 = p0 + 16;
        const int tok0 = p0 < ecnt ? (list[e * M + p0] >> 1) : 0, tok1 = p1 < ecnt ? (list[e * M + p1] >> 1) : 0;
        const bf16* w = (const bf16*)(a.ws + WS_WGU) + (size_t)(L * NX + e) * 1024 * D;
        const int vb = 256 * (fb >> 2) + 32 * (fb & 3);
        const bf16* bp = w + (size_t)(vb + fr) * D + 8 * fq;
        f32x4 acc[2][4];
        sg_tile(xb + (size_t)tok0 * D + 8 * fq, xb + (size_t)tok1 * D + 8 * fq, bp, bp + (size_t)16 * D, bp + (size_t)128 * D, bp + (size_t)144 * D, D, acc);
#pragma unroll
        for (int mt = 0; mt < 2; ++mt)
#pragma unroll
            for (int nt = 0; nt < 2; ++nt) {
                const f32x4 g = acc[mt][nt], u = acc[mt][nt + 2]; f32x4 h;
                h.x = silu(g.x) * u.x; h.y = silu(g.y) * u.y; h.z = silu(g.z) * u.z; h.w = silu(g.w) * u.w;
                st_bf16x4(hp + (size_t)(prow0 + 16 * mt + fr) * FE + 128 * (fb >> 2) + 32 * (fb & 3) + 16 * nt + 4 * fq, h);
            }
    }
}
__device__ __forceinline__ void sg_moe_dn(const ArgsP& a, const Ctx& c, int L) {
    LAS int* tab = (LAS int*)(c.lds + TAB_OFF);
    const int T = tab[TB_BASE + 32], fr = c.lane & 15, fq = c.lane >> 4, ntiles = T * (MOE_TR / 32) * (D / 64);
    const bf16* hp = (const bf16*)(a.ws + WS_HP); bf16* yp = (bf16*)(a.ws + WS_YP);
    for (int t = c.gw; t < ntiles; t += c.NGW) {
        const int rt = t / (D / 64), nb = t % (D / 64), prow0 = rt * 32, n0 = nb * 64, e = tab[prow0 >> MOE_TSH];
        const bf16* w = (const bf16*)(a.ws + WS_WD) + (size_t)(L * NX + e) * D * FE;
        const bf16* ap = hp + (size_t)(prow0 + fr) * FE + 8 * fq; const bf16* bp = w + (size_t)(n0 + fr) * FE + 8 * fq;
        f32x4 acc[2][4];
        sg_tile(ap, ap + (size_t)16 * FE, bp, bp + (size_t)16 * FE, bp + (size_t)32 * FE, bp + (size_t)48 * FE, FE, acc);
#pragma unroll
        for (int mt = 0; mt < 2; ++mt)
#pragma unroll
            for (int nt = 0; nt < 4; ++nt) st_bf16x4(yp + (size_t)(prow0 + 16 * mt + fr) * D + n0 + 16 * nt + 4 * fq, acc[mt][nt]);
    }
}

__device__ __forceinline__ void moe_gu_fast(const ArgsP& a, const Ctx& c, int L) {
    LAS int* tab = (LAS int*)(c.lds + TAB_OFF); LAS unsigned* toff = (LAS unsigned*)(c.lds + TOFF_OFF);
    const int G = gridDim.x, bx = blockIdx.x, vcu = (G % 8 == 0) ? (bx % 8) * (G / 8) + bx / 8 : bx;
    pg8::MoeOrder<true, 4> S; S.A = (const bf16*)(a.ws + WS_XB); S.W = (const bf16*)(a.ws + WS_WGU) + (size_t)L * NX * 1024 * D; S.K = D; S.wstride = (size_t)1024 * D;
    S.T = tab[TB_BASE + 32]; S.G = G; S.vcu = vcu; S.tab = tab; S.toff = toff;
    const int* list = (const int*)(a.ws + WS_LIST);
    pg8::Unit u;
    for (int i = 0; i < MAXGU && S.next(i, u); ++i)
        for (int r = c.tid; r < 256; r += NTHREADS) {
            const int pos = MOE_TR * (u.pm - tab[TB_BASE + u.e]) + r;
            const int tok = pos < tab[TB_CNT + u.e] ? (list[u.e * M + pos] >> 1) : 0;
            toff[i * 256 + r] = (unsigned)tok * (unsigned)(D * 2);
        }
    __syncthreads();
    pg8::EpiSwiglu E{(bf16*)(a.ws + WS_HP)};
    pg8::gemm_phase<pg8::EpiSwiglu, pg8::MoeOrder<true, 4>, true>(c.lds + RING_OFF, D, S, E);
}
__device__ __forceinline__ void moe_dn_fast(const ArgsP& a, const Ctx& c, int L) {
    LAS int* tab = (LAS int*)(c.lds + TAB_OFF);
    const int G = gridDim.x, bx = blockIdx.x, vcu = (G % 8 == 0) ? (bx % 8) * (G / 8) + bx / 8 : bx;
    pg8::MoeOrder<false, 8> S; S.A = (const bf16*)(a.ws + WS_HP); S.W = (const bf16*)(a.ws + WS_WD) + (size_t)L * NX * D * FE; S.K = FE; S.wstride = (size_t)D * FE;
    S.T = tab[TB_BASE + 32]; S.G = G; S.vcu = vcu; S.tab = tab; S.toff = nullptr;
    pg8::EpiBf16<0> E{(bf16*)(a.ws + WS_YP), D, 0, 0, nullptr, 0};
    pg8::gemm_phase<pg8::EpiBf16<0>, pg8::MoeOrder<false, 8>, true>(c.lds + RING_OFF, FE, S, E);
}
template <int ACT>
__device__ __forceinline__ void dense_fast(const Ctx& c, const bf16* A, const bf16* Bt, int N, int K, bf16* O, int split_cols, size_t split_stride, f32x2* part = nullptr, int part_pn0 = 0) {
    pg8::DenseOrder S; S.init(A, Bt, M, N, K, gridDim.x, blockIdx.x);
    pg8::EpiBf16<ACT> E{O, split_cols ? split_cols : N, split_cols, split_stride, part, part_pn0};
    pg8::gemm_phase<pg8::EpiBf16<ACT>, pg8::DenseOrder, true>(c.lds + RING_OFF, K, S, E);
}

namespace mg {
constexpr int ASTG = 16384, NAST = 4, BBASE = NAST * ASTG, BSTG = 32768;
template <int MODE  , int VAR = 0  , bool DYN = false  >
__device__ __forceinline__ void moe_direct(const ArgsP& a, const Ctx& c, int L) {
    LAS int* tab = (LAS int*)(c.lds + TAB_OFF); LAS unsigned* toff = (LAS unsigned*)(c.lds + TOFF_OFF);
    LAS unsigned char* ring = c.lds + RING_OFF;
    int tid_ = threadIdx.x; asm volatile("" : "+v"(tid_));
    const int tid = tid_, wid = __builtin_amdgcn_readfirstlane(tid >> 6), lane = tid & 63, wr = wid >> 2, wc = wid & 3, fr = lane & 15, fq = lane >> 4;
    constexpr int K = MODE == 0 ? D : FE, nk = K / 64, NPN = MODE == 0 ? 4 : 8, ldb = MODE == 0 ? FE : D;
    const int T = __builtin_amdgcn_readfirstlane(tab[TB_BASE + 32]), G = gridDim.x, bx = blockIdx.x, vcu = (G % 8 == 0) ? (bx % 8) * (G / 8) + bx / 8 : bx, NU = T * NPN;
    if (MODE == 0) {
        const int* list = (const int*)(a.ws + WS_LIST);
        for (int i = 0; i < 16; ++i) { const int idx = i * G + vcu; if (idx >= NU) break;
            const int rt = DYN ? (idx >> 2) : idx % T, e = tab[rt];
            if (tid < 128) { const int pos = MOE_TR * (rt - tab[TB_BASE + e]) + tid; const int tok = pos < tab[TB_CNT + e] ? (list[e * M + pos] >> 1) : 0; toff[i * 128 + tid] = (unsigned)tok * (unsigned)(D * 2); } }
        __syncthreads();
    }
    int RA[2], CA[2];
#pragma unroll
    for (int i = 0; i < 2; ++i) pg8::stage_rc(tid * 16 + i * 8192, RA[i], CA[i]);
    const int aoff = pg8::lds_byte(wr * 64 + fr, fq * 8);
    const int n4 = MODE == 0 ? (lane & 31) + 32 * (wid & 1) : lane, kr = MODE == 0 ? 2 * (wid >> 1) + (lane >> 5) : wid;
    const unsigned bvoff = MODE == 0 ? (unsigned)(((lane >> 5) * ldb + 4 * (lane & 31)) * 4) : (unsigned)(lane * 16);
    const unsigned bw0 = (unsigned)(kr * 512 + ((n4 ^ ((kr & 3) << 2)) << 3)), bw1 = (unsigned)(kr * 512 + ((n4 ^ (((kr & 3) | 4) << 2)) << 3));
    const int kq = lane >> 4, q4 = (lane & 15) >> 2, p4 = lane & 3, fxl = (q4 | ((kq & 1) << 2)) << 2;
    unsigned boffr[4];
#pragma unroll
    for (int nt = 0; nt < 4; ++nt) { const int g0 = MODE == 0 ? (nt < 2 ? 8 * wc + 4 * nt : 32 + 8 * wc + 4 * (nt - 2)) : 16 * wc + 4 * nt; boffr[nt] = (unsigned)((8 * kq + q4) * 512 + (((g0 + p4) ^ fxl) << 3)); }
    const unsigned ldsw = (unsigned)wid * 1024u;
    gu32* done = (gu32*)(a.ws + WS_CTL) + CW_DONE + L * 256 * DONE_STRIDE; gu32* qhead = (gu32*)(a.ws + WS_CTL) + CW_QDN + L * 64; gu32* tmo = (gu32*)(a.ws + WS_CTL) + CW_TMO;
    for (int ui = 0; ui < (DYN && MODE == 1 ? 0x7fffffff : 16); ++ui) {
        int idx;
        if (DYN && MODE == 1) {
            if (tid == 0) tab[300] = (int)__hip_atomic_fetch_add(qhead, 1u, RLX_AGENT);
            __syncthreads();
            idx = __builtin_amdgcn_readfirstlane(tab[300]); if (idx >= NU) break;
            if (wid == 0) { unsigned sp = 0;
                while (__hip_atomic_load(done + (idx >> 3) * DONE_STRIDE, RLX_AGENT) < 32u) { __builtin_amdgcn_s_sleep(1); if (++sp > (1u << 22)) { if (lane == 0) __hip_atomic_store(tmo, 1u, RLX_AGENT); break; } }
                __builtin_amdgcn_fence(__ATOMIC_ACQUIRE, "agent"); asm volatile("s_waitcnt vmcnt(0)" ::: "memory"); }
            __syncthreads();
        } else { idx = ui * G + vcu; if (idx >= NU) break; }
        const int pn = (DYN && MODE == 1) ? (idx & 7) : (DYN ? (idx & 3) : idx / T), rt = (DYN && MODE == 1) ? (idx >> 3) : (DYN ? (idx >> 2) : idx % T), e = __builtin_amdgcn_readfirstlane(tab[rt]), prow0 = rt * MOE_TR;
        const char* abase; unsigned va[2];
        if (MODE == 0) { abase = (const char*)(a.ws + WS_XB); va[0] = toff[ui * 128 + RA[0]] + (unsigned)CA[0] * 2u; va[1] = toff[ui * 128 + RA[1]] + (unsigned)CA[1] * 2u; }
        else { abase = (const char*)(a.ws + WS_HP) + (size_t)prow0 * FE * 2; va[0] = (unsigned)(RA[0] * FE + CA[0]) * 2u; va[1] = (unsigned)(RA[1] * FE + CA[1]) * 2u; }
        const float* wsrc;
        if (MODE == 0) wsrc = a.in[(wid & 1) ? I_WU : I_WG] + (size_t)(L * NX + e) * D * FE + 128 * pn + (size_t)(2 * (wid >> 1)) * ldb;
        else wsrc = a.in[I_WDN] + (size_t)(L * NX + e) * FE * D + 256 * pn + (size_t)wid * ldb;
        { const unsigned long long wq = (unsigned long long)wsrc; const unsigned wlo = __builtin_amdgcn_readfirstlane((unsigned)wq), whi = __builtin_amdgcn_readfirstlane((unsigned)(wq >> 32));
          wsrc = (const float*)(((unsigned long long)whi << 32) | wlo); }
        f32x4 acc[4][4];
#pragma unroll
        for (int m = 0; m < 4; ++m)
#pragma unroll
            for (int n = 0; n < 4; ++n) acc[m][n] = (f32x4){0.f, 0.f, 0.f, 0.f};
        f32x4 br0[8], br1[8];
#define MG_LOADB(dst, kt) do { if (VAR & 1) break; _Pragma("unroll") for (int _i = 0; _i < 8; ++_i) { const float* _q = wsrc + (size_t)((kt) * 64 + 8 * _i) * ldb; asm volatile("global_load_dwordx4 %0, %1, %2" : "=v"(dst[_i]) : "v"(bvoff), "s"(_q) : "memory"); } } while (0)
#define MG_WAIT(N, r) asm volatile("s_waitcnt vmcnt(" #N ") lgkmcnt(0)" : "+v"(r[0]), "+v"(r[1]), "+v"(r[2]), "+v"(r[3]), "+v"(r[4]), "+v"(r[5]), "+v"(r[6]), "+v"(r[7]) :: "memory")
#define MG_WRITEB(src, st) do { if (VAR & 8) break; _Pragma("unroll") for (int _i = 0; _i < 8; ++_i) { u32x2 _w; _w.x = cvt_pk_bf16(src[_i].x, src[_i].y); _w.y = cvt_pk_bf16(src[_i].z, src[_i].w); \
        *(LAS u32x2*)(ring + BBASE + (st) * BSTG + _i * 4096 + ((_i & 1) ? bw1 : bw0)) = _w; } } while (0)
#define MG_DMAA(kt, st) do { if (VAR & 2) break; _Pragma("unroll") for (int _i = 0; _i < 2; ++_i) \
        __builtin_amdgcn_global_load_lds((const unsigned*)(abase + (size_t)(kt) * 128 + va[_i]), (LAS unsigned*)(ring + (st) * ASTG + ldsw + _i * 8192), 16, 0, 0); } while (0)
#define MG_READ(sb) do { \
        _Pragma("unroll") for (int kk = 0; kk < 2; ++kk) { const unsigned _b = (unsigned)(size_t)(ring + BBASE + (sb) * BSTG + kk * 16384); s16x4 _l0, _h0, _l1, _h1, _l2, _h2, _l3, _h3; \
            asm volatile("ds_read_b64_tr_b16 %0, %8\n\tds_read_b64_tr_b16 %1, %8 offset:2048\n\tds_read_b64_tr_b16 %2, %9\n\tds_read_b64_tr_b16 %3, %9 offset:2048\n\t" \
                         "ds_read_b64_tr_b16 %4, %10\n\tds_read_b64_tr_b16 %5, %10 offset:2048\n\tds_read_b64_tr_b16 %6, %11\n\tds_read_b64_tr_b16 %7, %11 offset:2048" \
                         : "=&v"(_l0), "=&v"(_h0), "=&v"(_l1), "=&v"(_h1), "=&v"(_l2), "=&v"(_h2), "=&v"(_l3), "=&v"(_h3) \
                         : "v"(_b + boffr[0]), "v"(_b + boffr[1]), "v"(_b + boffr[2]), "v"(_b + boffr[3]) : "memory"); \
            Bf[kk][0] = __builtin_shufflevector(_l0, _h0, 0, 1, 2, 3, 4, 5, 6, 7); Bf[kk][1] = __builtin_shufflevector(_l1, _h1, 0, 1, 2, 3, 4, 5, 6, 7); \
            Bf[kk][2] = __builtin_shufflevector(_l2, _h2, 0, 1, 2, 3, 4, 5, 6, 7); Bf[kk][3] = __builtin_shufflevector(_l3, _h3, 0, 1, 2, 3, 4, 5, 6, 7); } } while (0)
#define MG_PIN() asm volatile("" : "+v"(Bf[0][0]), "+v"(Bf[0][1]), "+v"(Bf[0][2]), "+v"(Bf[0][3]), "+v"(Bf[1][0]), "+v"(Bf[1][1]), "+v"(Bf[1][2]), "+v"(Bf[1][3]) :: "memory")
#define MG_MMA(sa) do { bf16x8 Af[2][4]; \
        _Pragma("unroll") for (int kk = 0; kk < 2; ++kk) _Pragma("unroll") for (int m = 0; m < 4; ++m) Af[kk][m] = *(const LAS bf16x8*)(ring + (sa) * ASTG + aoff + m * 2048 + kk * 1024); \
        __builtin_amdgcn_s_setprio(1); \
        _Pragma("unroll") for (int kk = 0; kk < 2; ++kk) _Pragma("unroll") for (int m = 0; m < 4; ++m) _Pragma("unroll") for (int n = 0; n < 4; ++n) { if (!(VAR & 4)) acc[m][n] = MFMA16(Bf[kk][n], Af[kk][m], acc[m][n]); else acc[m][n][0] += __builtin_bit_cast(float, (int)Bf[kk][n][0] + (int)Af[kk][m][0]); } \
        __builtin_amdgcn_s_setprio(0); } while (0)
#define MG_BAR() do { asm volatile("" ::: "memory"); __builtin_amdgcn_s_barrier(); asm volatile("" ::: "memory"); __builtin_amdgcn_sched_barrier(0); } while (0)
        bf16x8 Bf[2][4];
        MG_LOADB(br0, 0); MG_LOADB(br1, 1); MG_DMAA(0, 0); MG_DMAA(1, 1);
        MG_WAIT(12, br0);
        MG_WRITEB(br0, 0);
        __builtin_amdgcn_sched_barrier(0);
        MG_LOADB(br0, 2);
        MG_WAIT(10, br1);
        MG_BAR();
        if (wr == 1) MG_BAR();
#pragma unroll
        for (int kt = 0; kt < nk; ++kt) {
            MG_READ(kt & 1);
            if (kt + 1 < nk) { if ((kt & 1) == 0) MG_WRITEB(br1, 1); else MG_WRITEB(br0, 0); }
            if (kt + 2 < nk) MG_DMAA(kt + 2, (kt + 2) % NAST);
            __builtin_amdgcn_sched_barrier(0);
            if (kt + 3 < nk) { if ((kt & 1) == 0) MG_LOADB(br1, kt + 3); else MG_LOADB(br0, kt + 3); }
            __builtin_amdgcn_sched_barrier(0);
            if ((kt & 1) == 0) { if (kt + 3 < nk) MG_WAIT(10, br0); else if (kt + 2 < nk) MG_WAIT(2, br0); else MG_WAIT(0, br0); }
            else               { if (kt + 3 < nk) MG_WAIT(10, br1); else if (kt + 2 < nk) MG_WAIT(2, br1); else MG_WAIT(0, br1); }
            MG_PIN();
            MG_BAR();
            MG_MMA(kt % NAST);
            MG_BAR();
        }
        if (wr == 0) MG_BAR();
#undef MG_READ
#undef MG_PIN
#undef MG_MMA
#undef MG_BAR
#undef MG_LOADB
#undef MG_WAIT
#undef MG_WRITEB
#undef MG_DMAA
        if (MODE == 0) {
            bf16* H = VAR ? (bf16*)(a.ws + WS_Z) : (bf16*)(a.ws + WS_HP);
#pragma unroll
            for (int m = 0; m < 4; ++m)
#pragma unroll
                for (int nt = 0; nt < 2; ++nt) { const f32x4 g = acc[m][nt], up = acc[m][nt + 2]; f32x4 hh;
                    hh.x = g.x * fast_rcp(1.f + fast_exp2(g.x * -1.4426950408889634f)) * up.x; hh.y = g.y * fast_rcp(1.f + fast_exp2(g.y * -1.4426950408889634f)) * up.y;
                    hh.z = g.z * fast_rcp(1.f + fast_exp2(g.z * -1.4426950408889634f)) * up.z; hh.w = g.w * fast_rcp(1.f + fast_exp2(g.w * -1.4426950408889634f)) * up.w;
                    bf16* hp_ = H + (size_t)(prow0 + 64 * wr + 16 * m + fr) * FE + 128 * pn + 32 * wc + 16 * nt + 4 * fq;
                    if (DYN) { const unsigned long long pk_ = (unsigned long long)cvt_pk_bf16(hh.x, hh.y) | ((unsigned long long)cvt_pk_bf16(hh.z, hh.w) << 32);
                        __hip_atomic_store((GAS unsigned long long*)hp_, pk_, RLX_AGENT); }
                    else st_bf16x4(hp_, hh); }
            if (DYN) { asm volatile("s_waitcnt vmcnt(0)" ::: "memory"); if (lane == 0) __hip_atomic_fetch_add(done + rt * DONE_STRIDE, 1u, RLX_AGENT); }
        } else {
            bf16* Y = VAR ? (bf16*)(a.ws + WS_Z) + 16 * 1048576 : (bf16*)(a.ws + WS_YP);
#pragma unroll
            for (int m = 0; m < 4; ++m)
#pragma unroll
                for (int nt = 0; nt < 4; ++nt) st_bf16x4(Y + (size_t)(prow0 + 64 * wr + 16 * m + fr) * D + 256 * pn + 64 * wc + 16 * nt + 4 * fq, acc[m][nt]);
        }
    }
}
}

namespace mg3 {
constexpr int ASUB = 8192, ASTG = 16384, NAST = 3, BBASE = NAST * ASTG, BSTG = 16384;
template <int MODE  >
__device__ __forceinline__ void moe_pairs(const ArgsP& a, const Ctx& c, int L) {
    constexpr bool GU = MODE != 1;
    LAS int* tab = (LAS int*)(c.lds + TAB_OFF); LAS unsigned* toff = (LAS unsigned*)(c.lds + TOFF_OFF);
    LAS unsigned char* ring = c.lds + RING_OFF;
    int tid_ = threadIdx.x; asm volatile("" : "+v"(tid_));
    const int tid = tid_, wid = __builtin_amdgcn_readfirstlane(tid >> 6), lane = tid & 63, wr = wid >> 2, wc = wid & 3, fr = lane & 15, fq = lane >> 4;
    constexpr int nk = MODE == 0 ? D / 32 : MODE == 2 ? D / 64 : FE / 32, NPN = GU ? 4 : 8, ldb = GU ? FE : D;
    const int NP = __builtin_amdgcn_readfirstlane(tab[TB_NP]), G = gridDim.x, bx = blockIdx.x, vcu = (G % 8 == 0) ? (bx % 8) * (G / 8) + bx / 8 : bx, NU = NP * NPN;
    const int nround = (NU + 255) >> 8, rlast = NU - ((nround - 1) << 8); const bool ksplit = GU && G == 256 && nround >= 2 && rlast <= 128;
    const int nfull = nround - (ksplit ? 1 : 0);
    if (MODE == 2 && (!ksplit || vcu >= 2 * rlast)) return;
    const int khalf = MODE == 2 ? (vcu & 1) : 0;
    if (GU) {
        const int* list = (const int*)(a.ws + WS_LIST);
        for (int i = 0; i < (MODE == 2 ? 1 : MAXGU); ++i) { const int idx = MODE == 2 ? (nround - 1) * G + (vcu >> 1) : i * G + vcu; if (MODE == 0 && (i >= nfull || idx >= NU)) break;
            const int pw = tab[TB_PAIR + (idx >> 2)], rt0 = pw & 0xffff, e = tab[rt0];
            if (tid < 256) { const int pos = MOE_TR * (rt0 - tab[TB_BASE + e]) + tid; const int tok = pos < tab[TB_CNT + e] ? (list[e * M + pos] >> 1) : 0; toff[i * 256 + tid] = (unsigned)tok * (unsigned)(D * 2); } }
        __syncthreads();
    }
    const int aoff = (wr * 64 + fr) * 64 + 16 * (fq ^ ((fr >> 2) & 3));
    const int n4 = GU ? (lane & 31) + 32 * (wid & 1) : lane, kr = GU ? 2 * (wid >> 1) + (lane >> 5) : wid;
    const unsigned bvoff = GU ? (unsigned)(((lane >> 5) * ldb + 4 * (lane & 31)) * 4) : (unsigned)(lane * 16);
    const unsigned bw0 = (unsigned)(kr * 512 + ((n4 ^ ((kr & 3) << 2)) << 3));
    const int kq = lane >> 4, q4 = (lane & 15) >> 2, p4 = lane & 3, fxl = (q4 | ((kq & 1) << 2)) << 2;
    const int g00 = GU ? 8 * wc : 16 * wc;
    const unsigned boffr0 = (unsigned)((8 * kq + q4) * 512 + (((g00 + p4) ^ fxl) << 3));
    const unsigned ldsw = (unsigned)wid * 1024u;
    gu32* done = (gu32*)(a.ws + WS_CTL) + CW_DONE + L * 256 * DONE_STRIDE; gu32* qhead = (gu32*)(a.ws + WS_CTL) + CW_QDN + L * 64; gu32* tmo = (gu32*)(a.ws + WS_CTL) + CW_TMO;
    for (int ui = 0; ui < (MODE == 1 ? 0x7fffffff : MAXGU); ++ui) {
        int idx;
        if (MODE == 1) {
            if (tid == 0) tab[300] = (int)__hip_atomic_fetch_add(qhead, 1u, RLX_AGENT);
            __syncthreads();
            idx = __builtin_amdgcn_readfirstlane(tab[300]); if (idx >= NU) break;
            if (wid == 0) { unsigned sp = 0;
                while (__hip_atomic_load(done + (idx >> 3) * DONE_STRIDE, RLX_AGENT) < 32u) { __builtin_amdgcn_s_sleep(1); if (++sp > (1u << 22)) { if (lane == 0) __hip_atomic_store(tmo, 1u, RLX_AGENT); break; } }
                __builtin_amdgcn_fence(__ATOMIC_ACQUIRE, "agent"); asm volatile("s_waitcnt vmcnt(0)" ::: "memory"); }
            __syncthreads();
        } else if (MODE == 2) { if (ui > 0) break; idx = (nround - 1) * G + (vcu >> 1); }
        else { idx = ui * G + vcu; if (ui >= nfull || idx >= NU) break; }
        const int pair = MODE == 1 ? (idx >> 3) : (idx >> 2), pn = MODE == 1 ? (idx & 7) : (idx & 3);
        const int pw = __builtin_amdgcn_readfirstlane(tab[TB_PAIR + pair]), rt0 = pw & 0xffff, nsub = pw >> 16, e = __builtin_amdgcn_readfirstlane(tab[rt0]), prow0 = rt0 * MOE_TR;
        int t1_ = threadIdx.x; asm volatile("" : "+v"(t1_));
        const int RA = t1_ >> 2, CA = 8 * ((t1_ & 3) ^ ((RA >> 2) & 3));
        const char* abase; unsigned va[2];
#pragma unroll
        for (int sb = 0; sb < 2; ++sb) va[sb] = GU ? toff[ui * 256 + 128 * sb + RA] + (unsigned)CA * 2u : (unsigned)((128 * sb + RA) * FE + CA) * 2u;
        if (GU) abase = (const char*)(a.ws + WS_XB) + khalf * (nk * 64); else abase = (const char*)(a.ws + WS_HP) + (size_t)prow0 * FE * 2;
        const float* wsrc;
        if (GU) wsrc = a.in[(wid & 1) ? I_WU : I_WG] + (size_t)(L * NX + e) * D * FE + 128 * pn + (size_t)(2 * (wid >> 1) + khalf * (nk * 32)) * ldb;
        else wsrc = a.in[I_WDN] + (size_t)(L * NX + e) * FE * D + 256 * pn + (size_t)wid * ldb;
        { const unsigned long long wq = (unsigned long long)wsrc; const unsigned wlo = __builtin_amdgcn_readfirstlane((unsigned)wq), whi = __builtin_amdgcn_readfirstlane((unsigned)(wq >> 32));
          wsrc = (const float*)(((unsigned long long)whi << 32) | wlo); }
        f32x4 acc[2][4][4];
#pragma unroll
        for (int sb = 0; sb < 2; ++sb)
#pragma unroll
            for (int m = 0; m < 4; ++m)
#pragma unroll
                for (int n = 0; n < 4; ++n) acc[sb][m][n] = (f32x4){0.f, 0.f, 0.f, 0.f};
        f32x4 br0[4], br1[4];
#define M3_LOADB(dst, kt) do { const float* _w = wsrc + (size_t)((kt) * 32) * ldb; asm volatile("" : "+s"(_w));     \
        _Pragma("unroll") for (int _i = 0; _i < 4; ++_i) { const float* _q = _w + (size_t)(8 * _i) * ldb; asm volatile("global_load_dwordx4 %0, %1, %2" : "=v"(dst[_i]) : "v"(bvoff), "s"(_q) : "memory"); } } while (0)
#define M3_WAIT(N, r) asm volatile("s_waitcnt vmcnt(" #N ") lgkmcnt(0)" : "+v"(r[0]), "+v"(r[1]), "+v"(r[2]), "+v"(r[3]) :: "memory")
#define M3_WRITEB(src, st) do { _Pragma("unroll") for (int _i = 0; _i < 4; ++_i) { u32x2 _w; _w.x = cvt_pk_bf16(src[_i].x, src[_i].y); _w.y = cvt_pk_bf16(src[_i].z, src[_i].w); \
        *(LAS u32x2*)(ring + BBASE + (st) * BSTG + _i * 4096 + ((_i & 1) ? (bw0 ^ 128u) : bw0)) = _w; } } while (0)
#define M3_DMAA(kt, st) do { _Pragma("unroll") for (int _s = 0; _s < 2; ++_s) \
        __builtin_amdgcn_global_load_lds((const unsigned*)(abase + (size_t)(kt) * 64 + va[_s]), (LAS unsigned*)(ring + (st) * ASTG + _s * ASUB + ldsw), 16, 0, 0); } while (0)
#define M3_BOFF(nt) (GU ? ((boffr0 ^ (32u * ((nt) & 1))) + 256u * ((nt) >> 1)) : (boffr0 ^ (32u * (nt))))
#define M3_READ(sa, sbf) do { \
        { const unsigned _b = (unsigned)(size_t)(ring + BBASE + (sbf) * BSTG); s16x4 _l0, _h0, _l1, _h1, _l2, _h2, _l3, _h3; \
            asm volatile("ds_read_b64_tr_b16 %0, %8\n\tds_read_b64_tr_b16 %1, %8 offset:2048\n\tds_read_b64_tr_b16 %2, %9\n\tds_read_b64_tr_b16 %3, %9 offset:2048\n\t" \
                         "ds_read_b64_tr_b16 %4, %10\n\tds_read_b64_tr_b16 %5, %10 offset:2048\n\tds_read_b64_tr_b16 %6, %11\n\tds_read_b64_tr_b16 %7, %11 offset:2048" \
                         : "=&v"(_l0), "=&v"(_h0), "=&v"(_l1), "=&v"(_h1), "=&v"(_l2), "=&v"(_h2), "=&v"(_l3), "=&v"(_h3) \
                         : "v"(_b + M3_BOFF(0)), "v"(_b + M3_BOFF(1)), "v"(_b + M3_BOFF(2)), "v"(_b + M3_BOFF(3)) : "memory"); \
            Bf[0] = __builtin_shufflevector(_l0, _h0, 0, 1, 2, 3, 4, 5, 6, 7); Bf[1] = __builtin_shufflevector(_l1, _h1, 0, 1, 2, 3, 4, 5, 6, 7); \
            Bf[2] = __builtin_shufflevector(_l2, _h2, 0, 1, 2, 3, 4, 5, 6, 7); Bf[3] = __builtin_shufflevector(_l3, _h3, 0, 1, 2, 3, 4, 5, 6, 7); } \
        _Pragma("unroll") for (int m = 0; m < 4; ++m) Af[m] = *(const LAS bf16x8*)(ring + (sa) * ASTG + aoff + m * 1024); \
        if (nsub == 2) { _Pragma("unroll") for (int m = 0; m < 4; ++m) Ag[m] = *(const LAS bf16x8*)(ring + (sa) * ASTG + ASUB + aoff + m * 1024); } } while (0)
#define M3_PIN() asm volatile("" : "+v"(Bf[0]), "+v"(Bf[1]), "+v"(Bf[2]), "+v"(Bf[3]), "+v"(Af[0]), "+v"(Af[1]), "+v"(Af[2]), "+v"(Af[3]), "+v"(Ag[0]), "+v"(Ag[1]), "+v"(Ag[2]), "+v"(Ag[3]) :: "memory")
#define M3_MMA() do { __builtin_amdgcn_s_setprio(1); \
        _Pragma("unroll") for (int m = 0; m < 4; ++m) _Pragma("unroll") for (int n = 0; n < 4; ++n) acc[0][m][n] = MFMA16(Bf[n], Af[m], acc[0][m][n]); \
        if (nsub == 2) { _Pragma("unroll") for (int m = 0; m < 4; ++m) _Pragma("unroll") for (int n = 0; n < 4; ++n) acc[1][m][n] = MFMA16(Bf[n], Ag[m], acc[1][m][n]); } \
        __builtin_amdgcn_s_setprio(0); } while (0)
#define M3_BAR() do { asm volatile("" ::: "memory"); __builtin_amdgcn_s_barrier(); asm volatile("" ::: "memory"); __builtin_amdgcn_sched_barrier(0); } while (0)
        bf16x8 Bf[4], Af[4], Ag[4];
#pragma unroll
        for (int m = 0; m < 4; ++m) Ag[m] = (bf16x8){0, 0, 0, 0, 0, 0, 0, 0};
        M3_LOADB(br0, 0); M3_LOADB(br1, 1); M3_DMAA(0, 0); M3_DMAA(1, 1);
        M3_WAIT(8, br0);
        M3_WRITEB(br0, 0);
        __builtin_amdgcn_sched_barrier(0);
        M3_LOADB(br0, 2);
        M3_WAIT(6, br1);
        M3_BAR();
        if (wr == 1) M3_BAR();
#pragma unroll
        for (int kt = 0; kt < nk; ++kt) {
            M3_READ(kt % NAST, kt & 1);
            if (kt + 1 < nk) { if ((kt & 1) == 0) M3_WRITEB(br1, 1); else M3_WRITEB(br0, 0); }
            if (kt + 2 < nk) M3_DMAA(kt + 2, (kt + 2) % NAST);
            __builtin_amdgcn_sched_barrier(0);
            if (kt + 3 < nk) { if ((kt & 1) == 0) M3_LOADB(br1, kt + 3); else M3_LOADB(br0, kt + 3); }
            __builtin_amdgcn_sched_barrier(0);
            if ((kt & 1) == 0) { if (kt + 3 < nk) M3_WAIT(6, br0); else if (kt + 2 < nk) M3_WAIT(2, br0); else M3_WAIT(0, br0); }
            else               { if (kt + 3 < nk) M3_WAIT(6, br1); else if (kt + 2 < nk) M3_WAIT(2, br1); else M3_WAIT(0, br1); }
            M3_PIN();
            M3_BAR();
            M3_MMA();
            M3_BAR();
        }
        if (wr == 0) M3_BAR();
#undef M3_LOADB
#undef M3_WAIT
#undef M3_WRITEB
#undef M3_DMAA
#undef M3_BOFF
#undef M3_READ
#undef M3_PIN
#undef M3_MMA
#undef M3_BAR
        int t2_ = threadIdx.x; asm volatile("" : "+v"(t2_)); const int fre = t2_ & 15, fqe = (t2_ & 63) >> 4;
        if (MODE == 2) {
            float* pbuf = (float*)(a.ws + WS_Z) + ((size_t)(vcu >> 1) * 8 + (t2_ >> 6)) * (32 * 256) + (t2_ & 63) * 4;
            gu32* pflag = (gu32*)(a.ws + WS_CTL) + CW_PFLAG + (L * 128 + (vcu >> 1)) * 32;
            if (khalf == 1) {
#pragma unroll
                for (int sb = 0; sb < 2; ++sb) if (sb < nsub) {
#pragma unroll
                    for (int m = 0; m < 4; ++m)
#pragma unroll
                        for (int n = 0; n < 4; ++n) { float* q_ = pbuf + ((sb * 4 + m) * 4 + n) * 256; asm volatile("global_store_dwordx4 %0, %1, off sc1\n\ts_nop 1" :: "v"(q_), "v"(acc[sb][m][n]) : "memory"); } }
                asm volatile("s_waitcnt vmcnt(0)" ::: "memory");
                if ((t2_ & 63) == 0) __hip_atomic_fetch_add(pflag, 1u, RLX_AGENT);
                break;
            }
            if ((t2_ >> 6) == 0) { unsigned sp = 0;
              while (__hip_atomic_load(pflag, RLX_AGENT) < 8u) { __builtin_amdgcn_s_sleep(1); if (++sp > (1u << 22)) { if ((t2_ & 63) == 0) __hip_atomic_store(tmo, 1u, RLX_AGENT); break; } }
              __builtin_amdgcn_fence(__ATOMIC_ACQUIRE, "agent"); asm volatile("s_waitcnt vmcnt(0)" ::: "memory"); }
            __syncthreads();
#pragma unroll
            for (int sb = 0; sb < 2; ++sb) if (sb < nsub) {
#pragma unroll
                for (int m = 0; m < 4; ++m)
#pragma unroll
                    for (int n = 0; n < 4; ++n) acc[sb][m][n] += *(const f32x4*)(pbuf + ((sb * 4 + m) * 4 + n) * 256); }
        }
#pragma unroll
        for (int sb = 0; sb < 2; ++sb) if (sb < nsub) {
            if (GU) {
                bf16* H = (bf16*)(a.ws + WS_HP);
#pragma unroll
                for (int m = 0; m < 4; ++m)
#pragma unroll
                    for (int nt = 0; nt < 2; ++nt) { const f32x4 g = acc[sb][m][nt], up = acc[sb][m][nt + 2]; f32x4 hh;
                        hh.x = g.x * fast_rcp(1.f + fast_exp2(g.x * -1.4426950408889634f)) * up.x; hh.y = g.y * fast_rcp(1.f + fast_exp2(g.y * -1.4426950408889634f)) * up.y;
                        hh.z = g.z * fast_rcp(1.f + fast_exp2(g.z * -1.4426950408889634f)) * up.z; hh.w = g.w * fast_rcp(1.f + fast_exp2(g.w * -1.4426950408889634f)) * up.w;
                        bf16* hp_ = H + (size_t)(prow0 + 128 * sb + 64 * wr + 16 * m + fre) * FE + 128 * pn + 32 * wc + 16 * nt + 4 * fqe;
                        const unsigned long long pk_ = (unsigned long long)cvt_pk_bf16(hh.x, hh.y) | ((unsigned long long)cvt_pk_bf16(hh.z, hh.w) << 32);
                        __hip_atomic_store((GAS unsigned long long*)hp_, pk_, RLX_AGENT); }
            } else {
                bf16* Y = (bf16*)(a.ws + WS_YP);
#pragma unroll
                for (int m = 0; m < 4; ++m)
#pragma unroll
                    for (int nt = 0; nt < 4; ++nt) st_bf16x4(Y + (size_t)(prow0 + 128 * sb + 64 * wr + 16 * m + fre) * D + 256 * pn + 64 * wc + 16 * nt + 4 * fqe, acc[sb][m][nt]);
            }
        }
        if (GU) { asm volatile("s_waitcnt vmcnt(0)" ::: "memory"); if ((t2_ & 63) == 0) __hip_atomic_fetch_add(done + pair * DONE_STRIDE, 1u, RLX_AGENT); }
    }
}
}

__device__ __forceinline__ void ln_finish(f32x4 (&v)[8], const float* g, const float* b, float* xo, bf16* xbo, int lane) {
    float s = 0.f;
#pragma unroll
    for (int j = 0; j < 8; ++j) s += (v[j].x + v[j].y) + (v[j].z + v[j].w);
    const float mean = wave_sum(s) * (1.f / D); float s2 = 0.f;
#pragma unroll
    for (int j = 0; j < 8; ++j) { v[j] = v[j] - mean; s2 += (v[j].x * v[j].x + v[j].y * v[j].y) + (v[j].z * v[j].z + v[j].w * v[j].w); }
    const float rstd = 1.f / sqrtf(wave_sum(s2) * (1.f / D) + LN_EPS);
#pragma unroll
    for (int j = 0; j < 8; ++j) {
        const f32x4 gg = *(const f32x4*)(g + 256 * j + 4 * lane), bb = *(const f32x4*)(b + 256 * j + 4 * lane);
        const f32x4 y = v[j] * rstd * gg + bb;
        if (xo) *(f32x4*)(xo + 256 * j + 4 * lane) = y;
        if (xbo) { u32x2 w; w.x = cvt_pk_bf16(y.x, y.y); w.y = cvt_pk_bf16(y.z, y.w); *(u32x2*)(xbo + 256 * j + 4 * lane) = w; }
    }
}
__device__ __forceinline__ void ln_finish_r(f32x4 (&v)[8], const f32x4 (&G)[8], const f32x4 (&B)[8], float* xo, bf16* xbo, int lane) {
    float s = 0.f;
#pragma unroll
    for (int j = 0; j < 8; ++j) s += (v[j].x + v[j].y) + (v[j].z + v[j].w);
    const float mean = wave_sum(s) * (1.f / D); float s2 = 0.f;
#pragma unroll
    for (int j = 0; j < 8; ++j) { v[j] = v[j] - mean; s2 += (v[j].x * v[j].x + v[j].y * v[j].y) + (v[j].z * v[j].z + v[j].w * v[j].w); }
    const float rstd = 1.f / sqrtf(wave_sum(s2) * (1.f / D) + LN_EPS);
#pragma unroll
    for (int j = 0; j < 8; ++j) {
        const f32x4 y = v[j] * rstd * G[j] + B[j];
        if (xo) *(f32x4*)(xo + 256 * j + 4 * lane) = y;
        if (xbo) { u32x2 w; w.x = cvt_pk_bf16(y.x, y.y); w.y = cvt_pk_bf16(y.z, y.w); *(u32x2*)(xbo + 256 * j + 4 * lane) = w; }
    }
}
__device__ __forceinline__ void ln_finish_r8(f32x4 (&v)[8], const f32x4 (&G)[8], const f32x4 (&B)[8], float* xo, bf16* xbo, int lane) {
    float s = 0.f;
#pragma unroll
    for (int j = 0; j < 8; ++j) s += (v[j].x + v[j].y) + (v[j].z + v[j].w);
    const float mean = wave_sum(s) * (1.f / D); float s2 = 0.f;
#pragma unroll
    for (int j = 0; j < 8; ++j) { v[j] = v[j] - mean; s2 += (v[j].x * v[j].x + v[j].y * v[j].y) + (v[j].z * v[j].z + v[j].w * v[j].w); }
    const float rstd = 1.f / sqrtf(wave_sum(s2) * (1.f / D) + LN_EPS);
#pragma unroll
    for (int j = 0; j < 4; ++j) {
        const f32x4 y0 = v[2 * j] * rstd * G[2 * j] + B[2 * j], y1 = v[2 * j + 1] * rstd * G[2 * j + 1] + B[2 * j + 1];
        if (xo) { *(f32x4*)(xo + 512 * j + 8 * lane) = y0; *(f32x4*)(xo + 512 * j + 8 * lane + 4) = y1; }
        if (xbo) { u32x4 w; w.x = cvt_pk_bf16(y0.x, y0.y); w.y = cvt_pk_bf16(y0.z, y0.w); w.z = cvt_pk_bf16(y1.x, y1.y); w.w = cvt_pk_bf16(y1.z, y1.w); *(u32x4*)(xbo + 512 * j + 8 * lane) = w; }
    }
}
__device__ __forceinline__ f32x4 ld_bf16x4(const bf16* p) { const u32x2 h = *(const u32x2*)p; return (f32x4){bf_lo(h.x), bf_hi(h.x), bf_lo(h.y), bf_hi(h.y)}; }

__device__ __forceinline__ void ln_mix(const ArgsP& a, const Ctx& c, int L) {
    const float* xin = (L == 0) ? a.in[I_X] : (const float*)(a.ws + WS_X);
    float* xout = (float*)(a.ws + WS_X); bf16* xb = (bf16*)(a.ws + WS_XB); const bf16* hm = (const bf16*)(a.ws + WS_HMIX);
    for (int row = c.gw; row < M; row += c.NGW) {
        f32x4 v[8];
#pragma unroll
        for (int j = 0; j < 8; ++j) { const size_t o = (size_t)row * D + 256 * j + 4 * c.lane; v[j] = ALPHA * *(const f32x4*)(xin + o) + ld_bf16x4(hm + o); }
        ln_finish(v, a.in[I_MLNG] + L * D, a.in[I_MLNB] + L * D, xout + (size_t)row * D, xb + (size_t)row * D, c.lane);
    }
}
__device__ __forceinline__ void ln_ffn(const ArgsP& a, const Ctx& c, int L) {
    LAS int* tab = (LAS int*)(c.lds + TAB_OFF);
    const float* xin = (const float*)(a.ws + WS_X); float* xout = (L == DEPTH - 1) ? (float*)a.out : (float*)(a.ws + WS_X);
    bf16* xb = (bf16*)(a.ws + WS_XB); const bf16* yp = (const bf16*)(a.ws + WS_YP);
    const int* te = (const int*)(a.ws + WS_TOK); const int* tp = te + 2 * M; const float* tw = (const float*)(tp + 2 * M);
#define LNF_IDX(r, E0, E1, P0, P1, W0, W1) do { E0 = te[2 * (r)]; E1 = te[2 * (r) + 1]; P0 = tp[2 * (r)]; P1 = tp[2 * (r) + 1]; W0 = tw[2 * (r)]; W1 = tw[2 * (r) + 1]; } while (0)
#define LNF_LOAD(r, E0, E1, P0, P1, XR, Y0, Y1) do { const size_t _r0 = (size_t)(MOE_TR * tab[TB_BASE + E0] + P0), _r1 = (size_t)(MOE_TR * tab[TB_BASE + E1] + P1); \
        _Pragma("unroll") for (int j = 0; j < 4; ++j) { const int o = 512 * j + 8 * c.lane; XR[j] = *(const u32x4*)(xb + (size_t)(r) * D + o); Y0[j] = *(const u32x4*)(yp + _r0 * D + o); Y1[j] = *(const u32x4*)(yp + _r1 * D + o); } } while (0)
    int row = c.gw;
    if (row >= M) return;
    f32x4 G[8], B[8];
#pragma unroll
    for (int j = 0; j < 8; ++j) { const int o = 512 * (j >> 1) + 8 * c.lane + 4 * (j & 1); G[j] = *(const f32x4*)(a.in[I_FLNG] + L * D + o); B[j] = *(const f32x4*)(a.in[I_FLNB] + L * D + o); }
    int e0, e1, p0, p1, ne0 = 0, ne1 = 0, np0 = 0, np1 = 0; float w0, w1, nw0 = 0.f, nw1 = 0.f;
    u32x4 X[4], Y0[4], Y1[4];
    LNF_IDX(row, e0, e1, p0, p1, w0, w1);
    LNF_LOAD(row, e0, e1, p0, p1, X, Y0, Y1);
    if (row + c.NGW < M) LNF_IDX(row + c.NGW, ne0, ne1, np0, np1, nw0, nw1);
    for (;;) {
        const int nrow = row + c.NGW; const bool hn = nrow < M;
        u32x4 NX_[4], NY0[4], NY1[4]; int fe0 = 0, fe1 = 0, fp0 = 0, fp1 = 0; float fw0 = 0.f, fw1 = 0.f;
        if (hn) { LNF_LOAD(nrow, ne0, ne1, np0, np1, NX_, NY0, NY1); if (nrow + c.NGW < M) LNF_IDX(nrow + c.NGW, fe0, fe1, fp0, fp1, fw0, fw1); }
        f32x4 v[8];
#pragma unroll
        for (int j = 0; j < 4; ++j) { const int o = 512 * j + 8 * c.lane;
            const f32x4 xa = RES_BF16 ? (f32x4){bf_lo(X[j].x), bf_hi(X[j].x), bf_lo(X[j].y), bf_hi(X[j].y)} : *(const f32x4*)(xin + (size_t)row * D + o);
            const f32x4 xc = RES_BF16 ? (f32x4){bf_lo(X[j].z), bf_hi(X[j].z), bf_lo(X[j].w), bf_hi(X[j].w)} : *(const f32x4*)(xin + (size_t)row * D + o + 4);
            v[2 * j] = ALPHA * xa + w0 * (f32x4){bf_lo(Y0[j].x), bf_hi(Y0[j].x), bf_lo(Y0[j].y), bf_hi(Y0[j].y)} + w1 * (f32x4){bf_lo(Y1[j].x), bf_hi(Y1[j].x), bf_lo(Y1[j].y), bf_hi(Y1[j].y)};
            v[2 * j + 1] = ALPHA * xc + w0 * (f32x4){bf_lo(Y0[j].z), bf_hi(Y0[j].z), bf_lo(Y0[j].w), bf_hi(Y0[j].w)} + w1 * (f32x4){bf_lo(Y1[j].z), bf_hi(Y1[j].z), bf_lo(Y1[j].w), bf_hi(Y1[j].w)}; }
        ln_finish_r8(v, G, B, (RES_BF16 && L != DEPTH - 1) ? (float*)nullptr : xout + (size_t)row * D, (L == DEPTH - 1) ? (bf16*)nullptr : xb + (size_t)row * D, c.lane);
        if (!hn) break;
        row = nrow; w0 = nw0; w1 = nw1; ne0 = fe0; ne1 = fe1; np0 = fp0; np1 = fp1; nw0 = fw0; nw1 = fw1;
#pragma unroll
        for (int j = 0; j < 4; ++j) { X[j] = NX_[j]; Y0[j] = NY0[j]; Y1[j] = NY1[j]; }
    }
#undef LNF_IDX
#undef LNF_LOAD
}

__device__ __forceinline__ void route_select(const ArgsP& a, int L, int tok, int fr, int fq, f32x4 a0, f32x4 a1, f32x4 a2) {
    int* te = (int*)(a.ws + WS_TOK); int* tp = te + 2 * M; float* tw = (float*)(tp + 2 * M); int* list = (int*)(a.ws + WS_LIST);
    gu32* cnt = (gu32*)(a.ws + WS_CTL) + CW_CNT + L * 32 * CNT_STRIDE;
    f32x4 acc[3] = {a0, a1, a2};
    const float* be = a.in[I_BER] + (L * NGRP + fq) * NEXP;
    float el[8];
    el[0] = acc[0].x + be[0]; el[1] = acc[0].y + be[1]; el[2] = acc[0].z + be[2]; el[3] = acc[0].w + be[3];
    el[4] = acc[1].x + be[4]; el[5] = acc[1].y + be[5]; el[6] = acc[1].z + be[6]; el[7] = acc[1].w + be[7];
    const float gl = acc[2].x + a.in[I_BGR][L * NGRP + fq];
    int i1 = 0; float v1 = el[0];
#pragma unroll
    for (int e = 1; e < 8; ++e) if (el[e] > v1) { v1 = el[e]; i1 = e; }
    int i2 = -1; float v2 = -INFINITY;
#pragma unroll
    for (int e = 0; e < 8; ++e) if (e != i1 && el[e] > v2) { v2 = el[e]; i2 = e; }
    float one_ = 1.f; asm volatile("" : "+v"(one_));
    const float tw1 = one_ / (one_ + __expf(v2 - v1)), tw2 = one_ - tw1;
    float gls[4];
#pragma unroll
    for (int r = 0; r < 4; ++r) gls[r] = __shfl(gl, fr + 16 * r);
    int gs = 0; float gm = gls[0];
#pragma unroll
    for (int r = 1; r < 4; ++r) if (gls[r] > gm) { gm = gls[r]; gs = r; }
    float den = 0.f;
#pragma unroll
    for (int r = 0; r < 4; ++r) den += __expf(gls[r] - gm);
    const float pg = 1.f / den;
    if (fq == gs) {
        const int e0 = 8 * gs + i1, e1 = 8 * gs + i2;
        const int p0 = (int)__hip_atomic_fetch_add(cnt + e0 * CNT_STRIDE, 1u, RLX_AGENT), p1 = (int)__hip_atomic_fetch_add(cnt + e1 * CNT_STRIDE, 1u, RLX_AGENT);
        list[e0 * M + p0] = 2 * tok; list[e1 * M + p1] = 2 * tok + 1;
        te[2 * tok] = e0; te[2 * tok + 1] = e1; tp[2 * tok] = p0; tp[2 * tok + 1] = p1; tw[2 * tok] = pg * tw1; tw[2 * tok + 1] = pg * tw2;
    }
}

constexpr int LNR_PITCH = 2 * D + 16, LNR_PART_OFF = 16 * LNR_PITCH;
__device__ __forceinline__ void ln_mix_router(const ArgsP& a, const Ctx& c, int L) {
    const float* xin = (L == 0) ? a.in[I_X] : (const float*)(a.ws + WS_X);
    float* xout = (float*)(a.ws + WS_X); bf16* xb = (bf16*)(a.ws + WS_XB); const bf16* hm = (const bf16*)(a.ws + WS_HMIX);
    const bf16* wr = (const bf16*)(a.ws + WS_WR) + (size_t)L * 48 * D;
    const float* g = a.in[I_MLNG] + L * D; const float* bta = a.in[I_MLNB] + L * D;
    LAS unsigned char* T = c.lds + RING_OFF; LAS f32x4* Pp = (LAS f32x4*)(c.lds + RING_OFF + LNR_PART_OFF);
    const int lane = c.lane, w = c.wave, fr = lane & 15, fq = lane >> 4;
    if ((int)blockIdx.x >= M / 16) return;
    LAS f32x4* GBl = (LAS f32x4*)(c.lds + RING_OFF + 98304);
    u32x4 RX[4], RH[4];
    { const size_t row = (size_t)16 * blockIdx.x + 2 * w;
#pragma unroll
      for (int j = 0; j < 4; ++j) { const size_t o = row * D + 512 * j + 8 * lane; RX[j] = *(const u32x4*)(xb + o); RH[j] = *(const u32x4*)(hm + o); } }
    for (int i = c.tid; i < D / 4; i += NTHREADS) { GBl[i] = ((const f32x4*)g)[i]; GBl[D / 4 + i] = ((const f32x4*)bta)[i]; }
    __syncthreads();
    for (int grp = blockIdx.x; grp < M / 16; grp += gridDim.x) {
#pragma unroll
        for (int rr = 0; rr < 2; ++rr) {
            const int rl = 2 * w + rr; const size_t row = (size_t)16 * grp + rl;
            const size_t nrow = rr == 0 ? row + 1 : (size_t)16 * (grp + gridDim.x) + 2 * w; const bool hn = rr == 0 || (grp + (int)gridDim.x) < M / 16;
            u32x4 NX_[4], NH[4];
            if (hn) {
#pragma unroll
                for (int j = 0; j < 4; ++j) { const size_t o = nrow * D + 512 * j + 8 * lane; NX_[j] = *(const u32x4*)(xb + o); NH[j] = *(const u32x4*)(hm + o); } }
            f32x4 v[8]; float s1 = 0.f;
#pragma unroll
            for (int j = 0; j < 4; ++j) { const size_t o = row * D + 512 * j + 8 * lane;
                const f32x4 xa = RES_BF16 ? (f32x4){bf_lo(RX[j].x), bf_hi(RX[j].x), bf_lo(RX[j].y), bf_hi(RX[j].y)} : *(const f32x4*)(xin + o);
                const f32x4 xc = RES_BF16 ? (f32x4){bf_lo(RX[j].z), bf_hi(RX[j].z), bf_lo(RX[j].w), bf_hi(RX[j].w)} : *(const f32x4*)(xin + o + 4);
                v[2 * j] = ALPHA * xa + (f32x4){bf_lo(RH[j].x), bf_hi(RH[j].x), bf_lo(RH[j].y), bf_hi(RH[j].y)};
                v[2 * j + 1] = ALPHA * xc + (f32x4){bf_lo(RH[j].z), bf_hi(RH[j].z), bf_lo(RH[j].w), bf_hi(RH[j].w)};
                s1 += ((v[2 * j].x + v[2 * j].y) + (v[2 * j].z + v[2 * j].w)) + ((v[2 * j + 1].x + v[2 * j + 1].y) + (v[2 * j + 1].z + v[2 * j + 1].w)); }
            const float mean = wave_sum(s1) * (1.f / D); float s2 = 0.f;
#pragma unroll
            for (int j = 0; j < 8; ++j) { v[j] = v[j] - mean; s2 += (v[j].x * v[j].x + v[j].y * v[j].y) + (v[j].z * v[j].z + v[j].w * v[j].w); }
            const float rstd = 1.f / sqrtf(wave_sum(s2) * (1.f / D) + LN_EPS);
#pragma unroll
            for (int j = 0; j < 4; ++j) {
                const int e4 = 128 * j + 2 * lane;
                const f32x4 y0 = v[2 * j] * rstd * GBl[e4] + GBl[D / 4 + e4], y1 = v[2 * j + 1] * rstd * GBl[e4 + 1] + GBl[D / 4 + e4 + 1];
                if (!RES_BF16) { *(f32x4*)(xout + row * D + 512 * j + 8 * lane) = y0; *(f32x4*)(xout + row * D + 512 * j + 8 * lane + 4) = y1; }
                u32x4 pk; pk.x = cvt_pk_bf16(y0.x, y0.y); pk.y = cvt_pk_bf16(y0.z, y0.w); pk.z = cvt_pk_bf16(y1.x, y1.y); pk.w = cvt_pk_bf16(y1.z, y1.w);
                *(u32x4*)(xb + row * D + 512 * j + 8 * lane) = pk;
                *(LAS u32x4*)(T + rl * LNR_PITCH + (512 * j + 8 * lane) * 2) = pk;
            }
            if (hn) {
#pragma unroll
                for (int j = 0; j < 4; ++j) { RX[j] = NX_[j]; RH[j] = NH[j]; } }
        }
        bf16x8 wa[3][8];
#pragma unroll
        for (int nt = 0; nt < 3; ++nt)
#pragma unroll
            for (int s_ = 0; s_ < 8; ++s_) wa[nt][s_] = *(const bf16x8*)(wr + (size_t)(16 * nt + fr) * D + 256 * w + 32 * s_ + 8 * fq);
        __syncthreads();
        f32x4 acc[3];
#pragma unroll
        for (int i = 0; i < 3; ++i) acc[i] = (f32x4){0.f, 0.f, 0.f, 0.f};
#pragma unroll
        for (int s_ = 0; s_ < 8; ++s_) {
            const bf16x8 fb = *(const LAS bf16x8*)(T + fr * LNR_PITCH + (256 * w + 32 * s_ + 8 * fq) * 2);
            acc[0] = MFMA16(wa[0][s_], fb, acc[0]); acc[1] = MFMA16(wa[1][s_], fb, acc[1]); acc[2] = MFMA16(wa[2][s_], fb, acc[2]);
        }
#pragma unroll
        for (int nt = 0; nt < 3; ++nt) Pp[(w * 3 + nt) * 64 + lane] = acc[nt];
        __syncthreads();
        if (w == 0) {
            f32x4 t0 = Pp[lane], t1 = Pp[64 + lane], t2 = Pp[128 + lane];
#pragma unroll
            for (int ww = 1; ww < 8; ++ww) { t0 += Pp[(ww * 3 + 0) * 64 + lane]; t1 += Pp[(ww * 3 + 1) * 64 + lane]; t2 += Pp[(ww * 3 + 2) * 64 + lane]; }
            route_select(a, L, 16 * grp + fr, fr, fq, t0, t1, t2);
        }
    }
}

__device__ __forceinline__ void router(const ArgsP& a, const Ctx& c, int L) {
    const bf16* xb = (const bf16*)(a.ws + WS_XB); const bf16* wr = (const bf16*)(a.ws + WS_WR) + (size_t)L * 48 * D;
    int* te = (int*)(a.ws + WS_TOK); int* tp = te + 2 * M; float* tw = (float*)(tp + 2 * M); int* list = (int*)(a.ws + WS_LIST);
    gu32* cnt = (gu32*)(a.ws + WS_CTL) + CW_CNT + L * 32 * CNT_STRIDE;
    const int fr = c.lane & 15, fq = c.lane >> 4;
    for (int task = c.gw; task < M / 16; task += c.NGW) {
        const int tok = task * 16 + fr;
        f32x4 acc[3];
#pragma unroll
        for (int i = 0; i < 3; ++i) acc[i] = (f32x4){0.f, 0.f, 0.f, 0.f};
        const bf16* bp = xb + (size_t)tok * D + 8 * fq; const bf16* ap = wr + (size_t)fr * D + 8 * fq;
        for (int k = 0; k < D; k += 32) {
            const bf16x8 fb = *(const bf16x8*)(bp + k);
            const bf16x8 a0 = *(const bf16x8*)(ap + k), a1 = *(const bf16x8*)(ap + (size_t)16 * D + k), a2 = *(const bf16x8*)(ap + (size_t)32 * D + k);
            acc[0] = MFMA16(a0, fb, acc[0]); acc[1] = MFMA16(a1, fb, acc[1]); acc[2] = MFMA16(a2, fb, acc[2]);
        }
        route_select(a, L, tok, fr, fq, acc[0], acc[1], acc[2]);
    }
}

__device__ __forceinline__ void gm_stats(const ArgsP& a, const Ctx& c) {
    const bf16* z = (const bf16*)(a.ws + WS_Z); f32x2* st = (f32x2*)(a.ws + WS_STAT);
    for (int row = c.gw; row < M; row += c.NGW) {
        const bf16* p = z + (size_t)row * GF + GH;
        u32x4 h[12]; float s = 0.f;
#pragma unroll
        for (int j = 0; j < 12; ++j) { h[j] = *(const u32x4*)(p + (j * 64 + c.lane) * 8);
            s += (bf_lo(h[j].x) + bf_hi(h[j].x)) + (bf_lo(h[j].y) + bf_hi(h[j].y)) + (bf_lo(h[j].z) + bf_hi(h[j].z)) + (bf_lo(h[j].w) + bf_hi(h[j].w)); }
        const float mean = wave_sum(s) * (1.f / GH); float q = 0.f;
#pragma unroll
        for (int j = 0; j < 12; ++j) {
            float d;
            d = bf_lo(h[j].x) - mean; q += d * d; d = bf_hi(h[j].x) - mean; q += d * d; d = bf_lo(h[j].y) - mean; q += d * d; d = bf_hi(h[j].y) - mean; q += d * d;
            d = bf_lo(h[j].z) - mean; q += d * d; d = bf_hi(h[j].z) - mean; q += d * d; d = bf_lo(h[j].w) - mean; q += d * d; d = bf_hi(h[j].w) - mean; q += d * d;
        }
        const float rstd = 1.f / sqrtf(wave_sum(q) * (1.f / GH) + LN_EPS);
        if (c.lane == 0) st[row] = (f32x2){mean, rstd};
    }
}
__device__ __forceinline__ void gm_spatial_simple(const ArgsP& a, const Ctx& c, int j) {
    const bf16* z = (const bf16*)(a.ws + WS_Z); const f32x2* st = (const f32x2*)(a.ws + WS_STAT); bf16* gt = (bf16*)(a.ws + WS_GATED);
    const float* wsp = a.in[I_WSP] + (size_t)j * GG * CH * CH; const float* bsp = a.in[I_BSP] + j * GG * CH;
    const float* lg = a.in[I_VLNG] + j * GH; const float* lb = a.in[I_VLNB] + j * GH;
    const int gtid = blockIdx.x * NTHREADS + c.tid, GT = gridDim.x * NTHREADS;
    for (int i = gtid; i < M * GH; i += GT) {
        const int row = i / GH, ch = i % GH, g = ch / GD, t = row & (CH - 1), cb = row - t;
        const float gam = lg[ch], bet = lb[ch]; const float* w = wsp + ((size_t)g * CH + t) * CH;
        float acc = 0.f;
        for (int s = 0; s <= t; ++s) { const f32x2 ms = st[cb + s]; const float vn = (bf2f(z[(size_t)(cb + s) * GF + GH + ch]) - ms.x) * ms.y * gam + bet; acc += w[s] * vn; }
        const float o = bf2f(z[(size_t)row * GF + ch]) * (acc + bsp[g * CH + t]);
        gt[i] = (bf16)(cvt_pk_bf16(o, 0.f) & 0xffffu);
    }
}

__device__ __forceinline__ void attn_simple(const ArgsP& a, const Ctx& c) {
    const bf16* Q = (const bf16*)(a.ws + WS_Q); const bf16* Kp = (const bf16*)(a.ws + WS_K); const bf16* V = (const bf16*)(a.ws + WS_V); bf16* O = (bf16*)(a.ws + WS_O);
    for (int task = c.gw; task < NB * NH * SEQ; task += c.NGW) {
        const int t = task % SEQ, h = (task / SEQ) % NH, b = task / (SEQ * NH);
        const size_t col = (size_t)h * HD + 2 * c.lane;
        const unsigned qq = *(const unsigned*)(Q + (size_t)(b * SEQ + t) * D + col); const float q0 = bf_lo(qq), q1 = bf_hi(qq);
        float C = 1.f, o0 = 0.f, o1 = 0.f;
        for (int s = t - 1; s >= 0; --s) {
            const size_t off = (size_t)(b * SEQ + s) * D + col;
            const unsigned kk = *(const unsigned*)(Kp + off), vv = *(const unsigned*)(V + off);
            float z = wave_sum(q0 * bf_lo(kk) + q1 * bf_hi(kk));
            z = fminf(fmaxf(z, -120.f), 120.f);
            const float e = fast_exp2(-z), beta = fast_rcp(1.f + e), P = beta * C;
            C *= e * beta;
            o0 += P * bf_lo(vv); o1 += P * bf_hi(vv);
        }
        *(unsigned*)(O + (size_t)(b * SEQ + t) * D + col) = cvt_pk_bf16(o0, o1);
    }
}

#ifndef ATT_EARLY_EXIT
#define ATT_EARLY_EXIT 1
#endif
typedef float f32x16 __attribute__((ext_vector_type(16)));
#define MFMA32(a, b, c) __builtin_amdgcn_mfma_f32_32x32x16_bf16((a), (b), (c), 0, 0, 0)
__device__ __forceinline__ int swz16(int row) { return ((row & 3) << 2) | ((row >> 2) & 3); }
__device__ __forceinline__ void attn_fast(const ArgsP& a, const Ctx& c) {
    const bf16* Q = (const bf16*)(a.ws + WS_Q); const bf16* Kp = (const bf16*)(a.ws + WS_K); const bf16* V = (const bf16*)(a.ws + WS_V); bf16* O = (bf16*)(a.ws + WS_O);
    LAS unsigned char* vbuf = c.lds + RING_OFF + c.wave * 16384;
    const int lane = c.lane, r32 = lane & 31, h = lane >> 5, l4 = lane >> 4, i16 = lane & 15, q4 = i16 >> 2, p4 = i16 & 3, colhalf = l4 & 1;
    const int G = gridDim.x, bx = blockIdx.x, vcu = (G % 8 == 0) ? (bx % 8) * (G / 8) + bx / 8 : bx;
    for (int u = vcu * NWAVES + c.wave; u < NB * NH * (SEQ / 32); u += c.NGW) {
        const int qb = u % (SEQ / 32), bh = u / (SEQ / 32), b = bh / NH, hd = bh % NH, q0 = qb * 32;
        const size_t rowbase = (size_t)b * SEQ;
        const bf16* Qp = Q + (rowbase + q0 + r32) * D + hd * HD + 8 * h;
        const bf16* Kb = Kp + rowbase * D + hd * HD + 8 * h;
        const bf16* Vb = V + rowbase * D + hd * HD;
        bf16x8 qf[8], kf[8];
#pragma unroll
        for (int s = 0; s < 8; ++s) qf[s] = *(const bf16x8*)(Qp + 16 * s);
        f32x16 oacc[4];
#pragma unroll
        for (int d = 0; d < 4; ++d)
#pragma unroll
            for (int i = 0; i < 16; ++i) oacc[d][i] = 0.f;
        float C = 1.f;
        int jt = qb;
#pragma unroll
        for (int s = 0; s < 8; ++s) kf[s] = *(const bf16x8*)(Kb + (size_t)(32 * jt + r32) * D + 16 * s);
#pragma unroll
        for (int i = 0; i < 8; ++i) { const int row = 4 * i + l4, ch = i16 ^ ((l4 << 2) | (i & 3));
            __builtin_amdgcn_global_load_lds((const unsigned*)(Vb + (size_t)(32 * jt + row) * D + 8 * ch), (LAS unsigned*)(vbuf + i * 1024), 16, 0, 0); }
        for (int it = 0;; ++it) {
            LAS unsigned char* vb = vbuf + (it & 1) * 8192;
            f32x16 p;
#pragma unroll
            for (int i = 0; i < 16; ++i) p[i] = 0.f;
#pragma unroll
            for (int s = 0; s < 8; ++s) p = MFMA32(kf[s], qf[s], p);
            const int jn = jt > 0 ? jt - 1 : 0;
#pragma unroll
            for (int s = 0; s < 8; ++s) kf[s] = *(const bf16x8*)(Kb + (size_t)(32 * jn + r32) * D + 16 * s);
            float bet[16], mm[16];
#pragma unroll
            for (int i = 0; i < 16; ++i) { const float e = fast_exp2(fminf(-p[i], 100.f)); const float bb = fast_rcp(1.f + e); bet[i] = bb; mm[i] = e * bb; }
            if (it == 0) {
#pragma unroll
                for (int i = 0; i < 16; ++i) { const bool valid = ((i & 3) + 8 * (i >> 2) + 4 * h) < r32; bet[i] = valid ? bet[i] : 0.f; mm[i] = valid ? mm[i] : 1.f; }
            }
            float gpp[4];
#pragma unroll
            for (int g = 0; g < 4; ++g) { const float gp = (mm[4 * g] * mm[4 * g + 1]) * (mm[4 * g + 2] * mm[4 * g + 3]); gpp[g] = __shfl_xor(gp, 32); }
            float E = C, P[16];
#pragma unroll
            for (int g = 3; g >= 0; --g) {
                const float E1 = (h == 0) ? E * gpp[g] : E;
                const float x3 = E1, x2 = x3 * mm[4 * g + 3], x1 = x2 * mm[4 * g + 2], x0 = x1 * mm[4 * g + 1];
                P[4 * g + 3] = bet[4 * g + 3] * x3; P[4 * g + 2] = bet[4 * g + 2] * x2; P[4 * g + 1] = bet[4 * g + 1] * x1; P[4 * g] = bet[4 * g] * x0;
                const float E2 = x0 * mm[4 * g];
                E = (h == 1) ? E2 * gpp[g] : E2;
            }
            C = E;
            bf16x8 pf[2];
#pragma unroll
            for (int s = 0; s < 2; ++s) { u32x4 w; w.x = cvt_pk_bf16(P[8 * s], P[8 * s + 1]); w.y = cvt_pk_bf16(P[8 * s + 2], P[8 * s + 3]); w.z = cvt_pk_bf16(P[8 * s + 4], P[8 * s + 5]); w.w = cvt_pk_bf16(P[8 * s + 6], P[8 * s + 7]);
                pf[s] = __builtin_bit_cast(bf16x8, w); }
            asm volatile("s_waitcnt vmcnt(0)" ::: "memory");
            s16x4 tlo[4][2], thi[4][2];
#pragma unroll
            for (int db = 0; db < 4; ++db)
#pragma unroll
                for (int s = 0; s < 2; ++s) {
                    { const int row = 16 * s + 4 * h + q4, ch = 4 * db + 2 * colhalf + (p4 >> 1); tlo[db][s] = lds_tr_asm(vb + 256 * row + 16 * (ch ^ swz16(row)) + 8 * (p4 & 1)); }
                    { const int row = 16 * s + 8 + 4 * h + q4, ch = 4 * db + 2 * colhalf + (p4 >> 1); thi[db][s] = lds_tr_asm(vb + 256 * row + 16 * (ch ^ swz16(row)) + 8 * (p4 & 1)); }
                }
            asm volatile("s_waitcnt lgkmcnt(0)" ::: "memory");
#pragma unroll
            for (int db = 0; db < 4; ++db)
#pragma unroll
                for (int s = 0; s < 2; ++s) { asm volatile("" : "+v"(tlo[db][s]), "+v"(thi[db][s]));
                    oacc[db] = MFMA32(__builtin_shufflevector(tlo[db][s], thi[db][s], 0, 1, 2, 3, 4, 5, 6, 7), pf[s], oacc[db]);
                }
            bool done = (jt == 0);
#if ATT_EARLY_EXIT
            done = done || __all(C < 1e-37f);
#endif
            if (done) break;
            jt = jn;
            asm volatile("s_waitcnt lgkmcnt(0)" ::: "memory");
            { LAS unsigned char* vn = vbuf + ((it + 1) & 1) * 8192;
#pragma unroll
              for (int i = 0; i < 8; ++i) { const int row = 4 * i + l4, ch = i16 ^ ((l4 << 2) | (i & 3));
                  __builtin_amdgcn_global_load_lds((const unsigned*)(Vb + (size_t)(32 * jt + row) * D + 8 * ch), (LAS unsigned*)(vn + i * 1024), 16, 0, 0); } }
        }
        asm volatile("s_waitcnt vmcnt(0) lgkmcnt(0)" ::: "memory");
        bf16* Op = O + (rowbase + q0 + r32) * D + hd * HD + 4 * h;
#pragma unroll
        for (int db = 0; db < 4; ++db)
#pragma unroll
            for (int g = 0; g < 4; ++g) { u32x2 w; w.x = cvt_pk_bf16(oacc[db][4 * g], oacc[db][4 * g + 1]); w.y = cvt_pk_bf16(oacc[db][4 * g + 2], oacc[db][4 * g + 3]); *(u32x2*)(Op + 32 * db + 8 * g) = w; }
    }
}

__device__ __forceinline__ void gm_spatial_fast(const ArgsP& a, const Ctx& c, int j) {
    const bf16* z = (const bf16*)(a.ws + WS_Z); bf16* gt = (bf16*)(a.ws + WS_GATED);
    const bf16* wsb = (const bf16*)(a.ws + WS_WSPB) + (size_t)j * GG * CH * CH; const float* bsp = a.in[I_BSP] + j * GG * CH;
    const float* lg = a.in[I_VLNG] + j * GH; const float* lb = a.in[I_VLNB] + j * GH;
    LAS unsigned char* img = c.lds + RING_OFF;
    LAS unsigned char* uo = c.lds + RING_OFF + 65536;
    LAS f32x2* srow = (LAS f32x2*)(c.lds + TOFF_OFF);
    const int lane = c.lane, r32 = lane & 31, h = lane >> 5, l4 = lane >> 4, i16 = lane & 15, q4 = i16 >> 2, p4 = i16 & 3, colhalf = l4 & 1, w = c.wave;
    const int NU = NB * (SEQ / CH) * GG, per = (NU + gridDim.x - 1) / gridDim.x;
    const int u0 = blockIdx.x * per, u1 = min(NU, u0 + per), nstep = 3 * (u1 - u0);
    if (nstep <= 0) return;
    const int tbA = w & 3, dqA = w >> 2, tbB = 3 - tbA, dqB = 2 + (w >> 2), nA = 2 * (tbA + 1), nB = 2 * (tbB + 1);
    const int scc = c.tid & 15, srow0 = c.tid >> 4;
    int last_bc = -1;
#define SP_LOADHV(HV, st_) do { const int un_ = u0 + (st_) / 3, pn_ = (st_) % 3, gn_ = un_ % GG; const size_t rown_ = (size_t)(un_ / GG) * CH; \
        _Pragma("unroll") for (int it = 0; it < 4; ++it) HV[it] = *(const u32x4*)(z + (rown_ + srow0 + 32 * it) * GF + GH + gn_ * GD + 128 * pn_ + 8 * scc); } while (0)
#define SP_LOADU(HU, st_) do { const int un_ = u0 + (st_) / 3, pn_ = (st_) % 3, gn_ = un_ % GG; const size_t rown_ = (size_t)(un_ / GG) * CH; \
        _Pragma("unroll") for (int it = 0; it < 4; ++it) HU[it] = *(const u32x4*)(z + (rown_ + srow0 + 32 * it) * GF + gn_ * GD + 128 * pn_ + 8 * scc); } while (0)
    u32x4 hv0[4], hv1[4], hu[4];
    SP_LOADHV(hv0, 0); if (nstep > 1) SP_LOADHV(hv1, 1);
    SP_LOADU(hu, 0);
    bf16x8 wf[10];
    for (int step2 = 0; step2 < nstep; step2 += 2) {
#pragma unroll
      for (int par = 0; par < 2; ++par) {
        const int step = step2 + par; if (step >= nstep) break;
        const int u = u0 + step / 3, p = step % 3, g = u % GG, bc = u / GG; const size_t row0 = (size_t)bc * CH;
        LAS unsigned char* pb = img + (step & 1) * 32768; LAS unsigned char* ub = uo + (step & 1) * 32768;
        if (bc != last_bc) {
            last_bc = bc;
            {
                const int rw = c.tid >> 2, qd = c.tid & 3; const f32x4* pp = (const f32x4*)((const f32x2*)(a.ws + WS_PART) + (row0 + rw) * 96 + 24 * qd);
                f32x4 t[12];
#pragma unroll
                for (int i = 0; i < 12; ++i) t[i] = pp[i];
                float s1 = 0.f, s2 = 0.f;
#pragma unroll
                for (int i = 0; i < 12; ++i) { s1 += t[i].x + t[i].z; s2 += t[i].y + t[i].w; }
                s1 += __shfl_xor(s1, 1); s2 += __shfl_xor(s2, 1); s1 += __shfl_xor(s1, 2); s2 += __shfl_xor(s2, 2);
                const float mean = s1 * (1.f / GH), var = fmaxf(s2 * (1.f / GH) - mean * mean, 0.f);
                if (qd == 0) srow[rw] = (f32x2){mean, 1.f / sqrtf(var + LN_EPS)}; }
            __syncthreads();
        }
        { const int ch0 = g * GD + 128 * p + 8 * scc;
          const f32x4 g0 = *(const f32x4*)(lg + ch0), g1 = *(const f32x4*)(lg + ch0 + 4), b0 = *(const f32x4*)(lb + ch0), b1 = *(const f32x4*)(lb + ch0 + 4);
#pragma unroll
          for (int it = 0; it < 4; ++it) {
              const int row = srow0 + 32 * it; const f32x2 ms = srow[row]; const u32x4 h_ = par == 0 ? hv0[it] : hv1[it]; u32x4 o;
              o.x = cvt_pk_bf16((bf_lo(h_.x) - ms.x) * ms.y * g0.x + b0.x, (bf_hi(h_.x) - ms.x) * ms.y * g0.y + b0.y);
              o.y = cvt_pk_bf16((bf_lo(h_.y) - ms.x) * ms.y * g0.z + b0.z, (bf_hi(h_.y) - ms.x) * ms.y * g0.w + b0.w);
              o.z = cvt_pk_bf16((bf_lo(h_.z) - ms.x) * ms.y * g1.x + b1.x, (bf_hi(h_.z) - ms.x) * ms.y * g1.y + b1.y);
              o.w = cvt_pk_bf16((bf_lo(h_.w) - ms.x) * ms.y * g1.z + b1.z, (bf_hi(h_.w) - ms.x) * ms.y * g1.w + b1.w);
              *(LAS u32x4*)(pb + 256 * row + 16 * (scc ^ swz16(row))) = o;
              *(LAS u32x4*)(ub + 256 * row + 16 * (scc ^ swz16(row))) = hu[it];
          } }
        if (step + 2 < nstep) { if (par == 0) SP_LOADHV(hv0, step + 2); else SP_LOADHV(hv1, step + 2); }
        if (p == 0) {
            const bf16* wg = wsb + (size_t)g * CH * CH;
#define SP_WLOAD(TBA) do { _Pragma("unroll") for (int ks = 0; ks < 2 * ((TBA) + 1); ++ks) wf[ks] = *(const bf16x8*)(wg + (size_t)(32 * (TBA) + r32) * CH + 16 * ks + 8 * h); \
                           _Pragma("unroll") for (int ks = 0; ks < 2 * (4 - (TBA)); ++ks) wf[2 * ((TBA) + 1) + ks] = *(const bf16x8*)(wg + (size_t)(32 * (3 - (TBA)) + r32) * CH + 16 * ks + 8 * h); } while (0)
            if (tbA == 0) SP_WLOAD(0); else if (tbA == 1) SP_WLOAD(1); else if (tbA == 2) SP_WLOAD(2); else SP_WLOAD(3);
#undef SP_WLOAD
        }
        const int tA = 32 * tbA + r32, tB = 32 * tbB + r32;
        const float btA = bsp[g * CH + tA], btB = bsp[g * CH + tB];
        __syncthreads();
        f32x16 accA, accB;
#pragma unroll
        for (int i = 0; i < 16; ++i) { accA[i] = 0.f; accB[i] = 0.f; }
#define SP_BLOCKS(TBA) do { constexpr int NA_ = 2 * ((TBA) + 1), NB_ = 2 * (4 - (TBA)); s16x4 ta[NA_][2], tb[NB_][2]; \
            _Pragma("unroll") for (int ks = 0; ks < NA_; ++ks) _Pragma("unroll") for (int hh = 0; hh < 2; ++hh) { const int row = 16 * ks + 8 * h + 4 * hh + q4, ch = 4 * dqA + 2 * colhalf + (p4 >> 1); ta[ks][hh] = lds_tr_asm(pb + 256 * row + 16 * (ch ^ swz16(row)) + 8 * (p4 & 1)); } \
            _Pragma("unroll") for (int ks = 0; ks < NB_; ++ks) _Pragma("unroll") for (int hh = 0; hh < 2; ++hh) { const int row = 16 * ks + 8 * h + 4 * hh + q4, ch = 4 * dqB + 2 * colhalf + (p4 >> 1); tb[ks][hh] = lds_tr_asm(pb + 256 * row + 16 * (ch ^ swz16(row)) + 8 * (p4 & 1)); } \
            asm volatile("s_waitcnt lgkmcnt(0)" ::: "memory"); \
            _Pragma("unroll") for (int ks = 0; ks < NA_; ++ks) { asm volatile("" : "+v"(ta[ks][0]), "+v"(ta[ks][1])); accA = MFMA32(__builtin_shufflevector(ta[ks][0], ta[ks][1], 0, 1, 2, 3, 4, 5, 6, 7), wf[ks], accA); } \
            _Pragma("unroll") for (int ks = 0; ks < NB_; ++ks) { asm volatile("" : "+v"(tb[ks][0]), "+v"(tb[ks][1])); accB = MFMA32(__builtin_shufflevector(tb[ks][0], tb[ks][1], 0, 1, 2, 3, 4, 5, 6, 7), wf[NA_ + ks], accB); } } while (0)
        if (tbA == 0) SP_BLOCKS(0); else if (tbA == 1) SP_BLOCKS(1); else if (tbA == 2) SP_BLOCKS(2); else SP_BLOCKS(3);
#undef SP_BLOCKS
        if (step + 1 < nstep) SP_LOADU(hu, step + 1);
#pragma unroll
        for (int gq = 0; gq < 4; ++gq) {
            LAS u32x2* pa = (LAS u32x2*)(ub + 256 * tA + 16 * ((4 * dqA + gq) ^ swz16(tA)) + 8 * h); LAS u32x2* pq = (LAS u32x2*)(ub + 256 * tB + 16 * ((4 * dqB + gq) ^ swz16(tB)) + 8 * h);
            const u32x2 ua = *pa, ubv = *pq; u32x2 oa, ob;
            oa.x = cvt_pk_bf16(bf_lo(ua.x) * (accA[4 * gq] + btA), bf_hi(ua.x) * (accA[4 * gq + 1] + btA)); oa.y = cvt_pk_bf16(bf_lo(ua.y) * (accA[4 * gq + 2] + btA), bf_hi(ua.y) * (accA[4 * gq + 3] + btA));
            ob.x = cvt_pk_bf16(bf_lo(ubv.x) * (accB[4 * gq] + btB), bf_hi(ubv.x) * (accB[4 * gq + 1] + btB)); ob.y = cvt_pk_bf16(bf_lo(ubv.y) * (accB[4 * gq + 2] + btB), bf_hi(ubv.y) * (accB[4 * gq + 3] + btB));
            *pa = oa; *pq = ob;
        }
        __syncthreads();
#pragma unroll
        for (int it = 0; it < 4; ++it) { const int row = srow0 + 32 * it;
            *(u32x4*)(gt + (row0 + row) * GH + g * GD + 128 * p + 8 * scc) = *(const LAS u32x4*)(ub + 256 * row + 16 * (scc ^ swz16(row))); }
      }
    }
#undef SP_LOADHV
#undef SP_LOADU
    __syncthreads();
}

constexpr int NPHASE = 1 + 9 * DEPTH;
__global__ void __launch_bounds__(NTHREADS, 2) mk_fwd(Args a) {
    extern __shared__ __attribute__((aligned(16))) unsigned char lds_raw[];
    Ctx c0;
    const ArgsP ap{};
    c0.lds = (LAS unsigned char*)lds_raw; c0.ws = nullptr;
    c0.tid = threadIdx.x; c0.lane = c0.tid & 63; c0.wave = __builtin_amdgcn_readfirstlane(c0.tid >> 6);
    c0.gw = blockIdx.x * NWAVES + c0.wave; c0.NGW = gridDim.x * NWAVES;
    volatile LAS unsigned* MISC = (volatile LAS unsigned*)(c0.lds + MISC_OFF);
    for (int u = c0.tid; u < (LDS_BYTES - LDSCTL_OFF) / 4; u += NTHREADS) ((LAS unsigned*)(c0.lds + LDSCTL_OFF))[u] = 0u;
    __syncthreads();
    unsigned* barw = (unsigned*)((gu32*)(ap.ws + WS_CTL) + CW_BAR);
    XcdBarrier bar; bar.bar = barw; bar.x = 0; bar.st = nullptr;
    if (!MK_PER_PHASE) bar = xcd_barrier_post(barw, MISC + 8);
    const int lo = a.ph_lo, hi = a.ph_hi;
#define IN(k) (lo <= (k) && (k) < hi)
#define PC phase_ctx(c0)
#define SEAM(k) do { if (!MK_PER_PHASE && (k) + 1 < hi) xcd_barrier(bar); } while (0)

    if (IN(0)) { for (int rep = 0; rep < REP_PRO; ++rep) p0_prologue(ap, PC); SEAM(0); }
    for (int L = 0; L < DEPTH; ++L) {
        const int pb = 1 + 9 * L, j = L >> 1;
        if ((L & 1) == 0) {
            if (IN(pb + 0)) {
#if FAST_DENSE
                for (int rep = 0; rep < REP_DENSE; ++rep)
                dense_fast<0>(PC, (const bf16*)(ap.ws + WS_XB), (const bf16*)(ap.ws + WS_WQKV) + (size_t)j * 3 * D * D, 3 * D, D, (bf16*)(ap.ws + WS_Q), D, (WS_K - WS_Q) / 2);
#else
                sg_dense<1>(PC, (const bf16*)(ap.ws + WS_XB), (const bf16*)(ap.ws + WS_WQKV) + (size_t)j * 3 * D * D, M, 3 * D, D, (bf16*)(ap.ws + WS_Q));
#endif
                SEAM(pb + 0); }
#if FAST_ATTN
            if (IN(pb + 1)) { for (int rep = 0; rep < REP_MIX; ++rep) attn_fast(ap, PC); SEAM(pb + 2); }
#else
            if (IN(pb + 1)) { attn_simple(ap, PC); SEAM(pb + 2); }
#endif
            if (IN(pb + 3)) {
#if FAST_DENSE
                for (int rep = 0; rep < REP_DENSE; ++rep)
                dense_fast<0>(PC, (const bf16*)(ap.ws + WS_O), (const bf16*)(ap.ws + WS_WO) + (size_t)j * D * D, D, D, (bf16*)(ap.ws + WS_HMIX), 0, 0);
#else
                sg_dense<0>(PC, (const bf16*)(ap.ws + WS_O), (const bf16*)(ap.ws + WS_WO) + (size_t)j * D * D, M, D, D, (bf16*)(ap.ws + WS_HMIX));
#endif
                SEAM(pb + 3); }
        } else {
            if (IN(pb + 0)) {
#if FAST_DENSE
                for (int rep = 0; rep < REP_DENSE; ++rep)
                dense_fast<2>(PC, (const bf16*)(ap.ws + WS_XB), (const bf16*)(ap.ws + WS_WIN) + (size_t)j * GF * D, GF, D, (bf16*)(ap.ws + WS_Z), 0, 0, FUSE_STATS ? (f32x2*)(ap.ws + WS_PART) : (f32x2*)nullptr, GH / 256);
#else
                sg_dense<2>(PC, (const bf16*)(ap.ws + WS_XB), (const bf16*)(ap.ws + WS_WIN) + (size_t)j * GF * D, M, GF, D, (bf16*)(ap.ws + WS_Z));
#endif
                SEAM(pb + 0); }
#if !(FUSE_STATS && FAST_DENSE && FAST_SPATIAL)
            if (IN(pb + 1)) { for (int rep = 0; rep < REP_MIX; ++rep) gm_stats(ap, PC); SEAM(pb + 1); }
#endif
#if FAST_SPATIAL
            if (IN(pb + 2)) { for (int rep = 0; rep < REP_MIX; ++rep) gm_spatial_fast(ap, PC, j); SEAM(pb + 2); }
#else
            if (IN(pb + 2)) { gm_spatial_simple(ap, PC, j); SEAM(pb + 2); }
#endif
            if (IN(pb + 3)) {
#if FAST_DENSE
                for (int rep = 0; rep < REP_DENSE; ++rep)
                dense_fast<0>(PC, (const bf16*)(ap.ws + WS_GATED), (const bf16*)(ap.ws + WS_WOUT) + (size_t)j * D * GH, D, GH, (bf16*)(ap.ws + WS_HMIX), 0, 0);
#else
                sg_dense<0>(PC, (const bf16*)(ap.ws + WS_GATED), (const bf16*)(ap.ws + WS_WOUT) + (size_t)j * D * GH, M, D, GH, (bf16*)(ap.ws + WS_HMIX));
#endif
                SEAM(pb + 3); }
        }
#if FUSE_ROUTER
        if (IN(pb + 4)) { ln_mix_router(ap, PC, L); SEAM(pb + 5); }
#else
        if (IN(pb + 4)) { ln_mix(ap, PC, L); SEAM(pb + 4); }
        if (IN(pb + 5)) { router(ap, PC, L); SEAM(pb + 5); }
#endif
#if FAST_MOE && MOE_DIRECT
#ifndef DBG_GU_SIMPLE
#define DBG_GU_SIMPLE 0
#endif
#ifndef DBG_DN_SIMPLE
#define DBG_DN_SIMPLE 0
#endif
#if MOE_MERGE
#if MOE_PAIRS
        if (IN(pb + 6)) { moe_tables(ap, PC, L); mg3::moe_pairs<0>(ap, PC, L); mg3::moe_pairs<2>(ap, PC, L); mg3::moe_pairs<1>(ap, PC, L); SEAM(pb + 7); }
#else
        if (IN(pb + 6)) { moe_tables(ap, PC, L); mg::moe_direct<0, 0, true>(ap, PC, L); mg::moe_direct<1, 0, true>(ap, PC, L); SEAM(pb + 7); }
#endif
#else
        if (IN(pb + 6)) { moe_tables(ap, PC, L); if (DBG_GU_SIMPLE) sg_moe_gu(ap, PC, L); else for (int rep = 0; rep < REP_MOE; ++rep) mg::moe_direct<0>(ap, PC, L);
            if (PROBE_GU) mg::moe_direct<0, PROBE_GU>(ap, PC, L); SEAM(pb + 6); }
        if (IN(pb + 7)) { moe_tables(ap, PC, L); if (DBG_DN_SIMPLE) sg_moe_dn(ap, PC, L); else for (int rep = 0; rep < REP_MOE; ++rep) mg::moe_direct<1>(ap, PC, L);
            if (PROBE_DN) mg::moe_direct<1, PROBE_DN>(ap, PC, L); SEAM(pb + 7); }
#endif
#elif FAST_MOE
        if (IN(pb + 6)) { moe_tables(ap, PC, L); for (int rep = 0; rep < REP_MOE; ++rep) moe_gu_fast(ap, PC, L); SEAM(pb + 6); }
        if (IN(pb + 7)) { moe_tables(ap, PC, L); for (int rep = 0; rep < REP_MOE; ++rep) moe_dn_fast(ap, PC, L); SEAM(pb + 7); }
#else
        if (IN(pb + 6)) { moe_tables(ap, PC, L); sg_moe_gu(ap, PC, L); SEAM(pb + 6); }
        if (IN(pb + 7)) { moe_tables(ap, PC, L); sg_moe_dn(ap, PC, L); SEAM(pb + 7); }
#endif
        if (IN(pb + 8)) { moe_tables(ap, PC, L); ln_ffn(ap, PC, L); SEAM(pb + 8); }
    }
#undef IN
#undef SEAM
}

extern "C" void kernel_launch(void* const* d_in, const int* in_sizes, int n_in, void* d_out, int out_size, void* d_ws, size_t ws_size, hipStream_t stream) {
    static int grid = 0;
    if (grid == 0) {
        if (n_in != 20 || in_sizes[0] != M * D || out_size != M * D || ws_size < WS_END) { fprintf(stderr, "kernel_launch: unexpected problem shape / workspace (%d inputs, ws %zu)\n", n_in, ws_size); grid = -1; return; }
        int dev = 0, cus = 0, per_cu = 0;
        if (hipGetDevice(&dev) != hipSuccess || hipDeviceGetAttribute(&cus, hipDeviceAttributeMultiprocessorCount, dev) != hipSuccess) { grid = -1; return; }
        if (hipFuncSetAttribute((const void*)mk_fwd, hipFuncAttributeMaxDynamicSharedMemorySize, LDS_BYTES) != hipSuccess) { fprintf(stderr, "kernel_launch: hipFuncSetAttribute failed\n"); grid = -1; return; }
        if (hipOccupancyMaxActiveBlocksPerMultiprocessor(&per_cu, (const void*)mk_fwd, NTHREADS, LDS_BYTES) != hipSuccess || per_cu < 1) { fprintf(stderr, "kernel_launch: occupancy query reports %d\n", per_cu); }
        (void)hipGetLastError();
        grid = cus;
    }
    if (grid < 0) return;
    if (hipMemsetAsync((char*)d_ws + WS_CTL, 0, CTL_ZERO_BYTES, stream) != hipSuccess) return;
    Args a{};
    for (int i = 0; i < 20; ++i) a.in[i] = (const float*)d_in[i];
    a.out = (float*)d_out; a.ws = (unsigned char*)d_ws;
#if MK_PER_PHASE
    for (int p = 0; p < NPHASE; ++p) {
        if (p >= 1) { const int L = (p - 1) / 9, s = (p - 1) % 9; if ((L & 1) == 0 && s == 2) continue; if (FUSE_ROUTER && s == 5) continue; if (MOE_MERGE && FAST_MOE && MOE_DIRECT && s == 7) continue; if (FUSE_STATS && FAST_DENSE && FAST_SPATIAL && (L & 1) == 1 && s == 1) continue; }
        a.ph_lo = p; a.ph_hi = p + 1;
        hipLaunchKernelGGL(mk_fwd, dim3(grid), dim3(NTHREADS), LDS_BYTES, stream, a);
    }
#else
    a.ph_lo = 0; a.ph_hi = NPHASE;
    hipLaunchKernelGGL(mk_fwd, dim3(grid), dim3(NTHREADS), LDS_BYTES, stream, a);
#endif
}
```

```cpp
#include <hip/hip_runtime.h>
#include <cstdint>
#include <cstdio>

#ifndef MK_PER_PHASE
#define MK_PER_PHASE 0
#endif
#ifndef FAST_DENSE
#define FAST_DENSE 1
#endif
#ifndef REP_DENSE
#define REP_DENSE 1
#endif
#ifndef REP_PRO
#define REP_PRO 1
#endif
#ifndef REP_MOE
#define REP_MOE 1
#endif
#ifndef REP_MIX
#define REP_MIX 1
#endif
#ifndef PROBE_GU
#define PROBE_GU 0
#endif
#ifndef PROBE_DN
#define PROBE_DN 0
#endif
#ifndef DBG_KEEP_CONV
#define DBG_KEEP_CONV 0
#endif
#ifndef RES_BF16
#define RES_BF16 1
#endif
#ifndef MOE_PAIRS
#define MOE_PAIRS 1
#endif
#ifndef MOE_MERGE
#define MOE_MERGE 1
#endif
#ifndef MOE_DIRECT
#define MOE_DIRECT 1
#endif
#ifndef FUSE_STATS
#define FUSE_STATS 1
#endif
#ifndef FUSE_ROUTER
#define FUSE_ROUTER 1
#endif
#ifndef FAST_ATTN
#define FAST_ATTN 1
#endif
#ifndef FAST_SPATIAL
#define FAST_SPATIAL 1
#endif
#ifndef FAST_MOE
#define FAST_MOE 1
#endif

#define GAS __attribute__((address_space(1)))
#define LAS __attribute__((address_space(3)))
typedef unsigned short bf16;
typedef float f32x4 __attribute__((ext_vector_type(4)));
typedef float f32x2 __attribute__((ext_vector_type(2)));
typedef short bf16x8 __attribute__((ext_vector_type(8)));
typedef short s16x4 __attribute__((ext_vector_type(4)));
typedef unsigned u32x4 __attribute__((ext_vector_type(4)));
typedef unsigned u32x2 __attribute__((ext_vector_type(2)));
typedef GAS unsigned gu32;
#define RLX_AGENT __ATOMIC_RELAXED, __HIP_MEMORY_SCOPE_AGENT

constexpr int NB = 2, SEQ = 4096, M = NB * SEQ, D = 2048, NH = 16, HD = 128;
constexpr int GF = 12288, GH = 6144, GG = 16, GD = 384, CH = 128;
constexpr int NGRP = 4, NEXP = 8, NX = 32, FE = 512, DEPTH = 4;
constexpr float LN_EPS = 1e-5f;
constexpr float ALPHA = 1.6817928305074290f;
constexpr float QSCALE = 0.08838834764831845f * 1.4426950408889634f;
constexpr int NWAVES = 8, NTHREADS = NWAVES * 64;

constexpr size_t MiB = 1u << 20;
constexpr size_t WS_CTL = 0, CTL_ZERO_BYTES = 1 * MiB;
constexpr size_t WS_WR = 1 * MiB;
constexpr size_t WS_WQKV = 2 * MiB;
constexpr size_t WS_WO = 50 * MiB;
constexpr size_t WS_WIN = 66 * MiB;
constexpr size_t WS_WOUT = 162 * MiB;
constexpr size_t WS_WGU = 210 * MiB;
constexpr size_t WS_WD = 722 * MiB;
constexpr size_t WS_X = 978 * MiB;
constexpr size_t WS_XB = 1042 * MiB;
constexpr size_t WS_Q = 1074 * MiB, WS_K = 1106 * MiB, WS_V = 1138 * MiB, WS_O = 1170 * MiB;
constexpr size_t WS_Z = 1202 * MiB;
constexpr size_t WS_GATED = 1394 * MiB;
constexpr size_t WS_HMIX = 1490 * MiB;
constexpr size_t WS_HP = 1522 * MiB;
constexpr size_t WS_YP = 1546 * MiB;
constexpr size_t WS_LIST = 1642 * MiB;
constexpr size_t WS_TOK = 1643 * MiB;
constexpr size_t WS_STAT = 1644 * MiB;
constexpr size_t WS_WSPB = 1645 * MiB;
constexpr size_t WS_PART = 1646 * MiB;
constexpr size_t WS_END = 1654 * MiB;
constexpr int CNT_STRIDE = 64, DONE_STRIDE = 32;
constexpr int CW_TMO = 0, CW_CODE = 1, CW_CNT = 8192  , CW_DONE = 32768  , CW_QDN = 2048  , CW_BAR = 4096, CW_PFLAG = 131072  ;

constexpr int RING_OFF = 0, RING_BYTES = 131072;
constexpr int TAB_OFF = RING_BYTES;
constexpr int TOFF_OFF = TAB_OFF + 2048, MAXGU = 8;
constexpr int TB_BASE = 192, TB_CNT = 232, TB_NP = 318, TB_PAIR = 320;
constexpr int MOE_TSH = MOE_DIRECT ? 7 : 8, MOE_TR = 1 << MOE_TSH;
constexpr int LDSCTL_OFF = RING_BYTES + 12288, MISC_OFF = LDSCTL_OFF + 320;
constexpr int LDS_BYTES = 147456;

__device__ __forceinline__ unsigned cvt_pk_bf16(float lo, float hi) { unsigned r; asm("v_cvt_pk_bf16_f32 %0, %1, %2" : "=v"(r) : "v"(lo), "v"(hi)); return r; }
__device__ __forceinline__ float bf_lo(unsigned u) { return __uint_as_float(u << 16); }
__device__ __forceinline__ float bf_hi(unsigned u) { return __uint_as_float(u & 0xffff0000u); }
__device__ __forceinline__ float bf2f(bf16 b) { return __uint_as_float((unsigned)b << 16); }
__device__ __forceinline__ float wave_sum(float v) {
#pragma unroll
    for (int o = 1; o < 64; o <<= 1) v += __shfl_xor(v, o);
    return v;
}
__device__ __forceinline__ float fast_exp2(float x) { return __builtin_amdgcn_exp2f(x); }
__device__ __forceinline__ float fast_rcp(float x) { return __builtin_amdgcn_rcpf(x); }
__device__ __forceinline__ float gelu_tanh(float x) {
    const float u = 0.7978845608028654f * (x + 0.044715f * x * x * x);
    const float t = fminf(fmaxf(-2.0f * 1.4426950408889634f * u, -120.f), 120.f);
    return x * fast_rcp(1.0f + fast_exp2(t));
}
__device__ __forceinline__ float silu(float x) {
    const float t = fminf(fmaxf(-1.4426950408889634f * x, -120.f), 120.f);
    return x * fast_rcp(1.0f + fast_exp2(t));
}

#define XB_TMO      128
#define XB_XCNT(j)  (256  + 64 * (j))
#define XB_XSUB(j)  (1280 + 64 * (j))
#define XB_XGEN(j)  (2304 + 64 * (j))
#define XB_TOP      3328
#define XB_TOPGEN   3392
#define XCD_BAR_WORDS 3456
#define XB_SPIN_CAP (1u << 22)

__device__ __forceinline__ unsigned xb_ld(unsigned* p)              { return __hip_atomic_load(p, __ATOMIC_RELAXED, __HIP_MEMORY_SCOPE_AGENT); }
__device__ __forceinline__ unsigned xb_add(unsigned* p, unsigned v) { return __hip_atomic_fetch_add(p, v, __ATOMIC_RELAXED, __HIP_MEMORY_SCOPE_AGENT); }
__device__ __forceinline__ unsigned xb_xcc_id() { return (unsigned)__builtin_amdgcn_s_getreg((3 << 11) | 20) & 0xFu; }
#define XB_SPIN(cond, bar) do { unsigned _sp = 0; while (cond) { __builtin_amdgcn_s_sleep(1); \
    if ((++_sp & 255u) == 0u) { if (xb_ld(&(bar)[XB_TMO])) break; if (_sp > XB_SPIN_CAP) { atomicAdd(&(bar)[XB_TMO], 1u); break; } } } } while (0)

struct XcdBarrier { unsigned* bar; unsigned x; volatile LAS unsigned* st; };

__device__ __forceinline__ XcdBarrier xcd_barrier_post(unsigned* bar, volatile LAS unsigned* st) {
    XcdBarrier b; b.bar = bar; b.x = xb_xcc_id(); b.st = st;
    if (threadIdx.x == 0) (void)xb_add(&bar[XB_XCNT(b.x)], 1u);
    return b;
}
__device__ __forceinline__ void xcd_barrier_complete(unsigned* bar, unsigned x, unsigned& nloc, unsigned& nx) {
    const unsigned G = gridDim.x * gridDim.y * gridDim.z;
    unsigned sum, cnt, mine, sp = 0u;
    for (;;) {
        sum = 0u; cnt = 0u; mine = 0u;
#pragma unroll
        for (unsigned j = 0; j < 16; ++j) { const unsigned c = xb_ld(&bar[XB_XCNT(j)]); sum += c; cnt += (c > 0u) ? 1u : 0u; mine = (j == x) ? c : mine; }
        if (sum == G) break;
        __builtin_amdgcn_s_sleep(1);
        if ((++sp & 255u) == 0u) { if (xb_ld(&bar[XB_TMO])) break; if (sp > XB_SPIN_CAP) { atomicAdd(&bar[XB_TMO], 1u); break; } }
    }
    nloc = mine > 0u ? mine : 1u; nx = cnt > 0u ? cnt : 1u;
}
__device__ __forceinline__ void xcd_barrier(const XcdBarrier& b) {
    asm volatile("s_waitcnt vmcnt(0)" ::: "memory");
    __syncthreads();
    if (threadIdx.x == 0) {
        unsigned* bar = b.bar;
        __builtin_amdgcn_s_waitcnt(0);
        unsigned nloc = b.st[0], nx = b.st[1];
        if (nloc == 0u) { xcd_barrier_complete(bar, b.x, nloc, nx); b.st[0] = nloc; b.st[1] = nx; }
        const unsigned old = xb_add(&bar[XB_XSUB(b.x)], 1u);
        const unsigned gen = old / nloc;
        if (old + 1u == (gen + 1u) * nloc) {
            __builtin_amdgcn_fence(__ATOMIC_RELEASE, "agent");
            asm volatile("s_waitcnt vmcnt(0)" ::: "memory");
            const unsigned og = xb_add(&bar[XB_TOP], 1u);
            const unsigned tg = og / nx;
            if (og + 1u == (tg + 1u) * nx) xb_add(&bar[XB_TOPGEN], 1u);
            else XB_SPIN(xb_ld(&bar[XB_TOPGEN]) == tg, bar);
            __builtin_amdgcn_fence(__ATOMIC_ACQUIRE, "agent");
            xb_add(&bar[XB_XGEN(b.x)], 1u);
            asm volatile("s_waitcnt vmcnt(0)" ::: "memory");
        } else {
            XB_SPIN(xb_ld(&bar[XB_XGEN(b.x)]) == gen, bar);
            __builtin_amdgcn_fence(__ATOMIC_ACQUIRE, "agent");
            asm volatile("s_waitcnt vmcnt(0)" ::: "memory");
        }
    }
    __syncthreads();
}

namespace pg8 {
constexpr int BM = 256, BK = 64, HALF = 128, HTB = HALF * BK * 2, STAGE_BYTES = 8 * HTB, NXCD = 8, WGM = 8;
__host__ __device__ __forceinline__ int lds_byte(int r, int c) { const int st = (r >> 4) * 2 + (c >> 5), rr = r & 15, cc = c & 31, ob = rr * 64 + cc * 2; return st * 1024 + (ob ^ (((ob >> 9) & 1) << 5)); }
__host__ __device__ __forceinline__ void stage_rc(int b, int& R, int& C) { const int st = b / 1024, sb = b % 1024, swz = sb ^ (((sb >> 9) & 1) << 5); R = (st >> 1) * 16 + swz / 64; C = (st & 1) * 32 + (swz % 64) / 2; }
__host__ __device__ __forceinline__ int perm32(int rho) { const int n = rho >> 4, i = rho & 15; return 8 * (i >> 2) + 4 * n + (i & 3); }

struct Unit { int pm, pn, e; };

struct DenseOrder {
    static constexpr bool GATHER = false;
    const bf16* A; const bf16* Bt; int K; int nM, nN, nwg, G, c;
    __device__ void init(const bf16* A_, const bf16* Bt_, int M_, int N_, int K_, int G_, int c_) { A = A_; Bt = Bt_; K = K_; nM = M_ / BM; nN = N_ / BM; nwg = nM * nN; G = G_; c = c_; }
    __device__ bool next(int i, Unit& u) const {
        const long L = (long)i * G + c; if (L >= nwg) return false;
        int wgid = (int)L; { const int q = nwg / NXCD, r = nwg % NXCD, xcd = wgid % NXCD, off = wgid / NXCD; wgid = (xcd < r ? xcd * (q + 1) : r * (q + 1) + (xcd - r) * q) + off; }
        const int nig = WGM * nN, gid = wgid / nig, fm = gid * WGM, gsz = (nM - fm) < WGM ? (nM - fm) : WGM;
        u.pm = fm + ((wgid % nig) % gsz); u.pn = (wgid % nig) / gsz; u.e = 0; return true;
    }
    __device__ __forceinline__ const char* abase(const Unit& u) const { return (const char*)A + (size_t)u.pm * BM * K * 2; }
    __device__ __forceinline__ const char* bbase(const Unit& u) const { return (const char*)Bt + (size_t)u.pn * BM * K * 2; }
    __device__ __forceinline__ unsigned aoff(int, int) const { return 0u; }
};
template <bool GATHER_, int NPN>
struct MoeOrder {
    static constexpr bool GATHER = GATHER_;
    const bf16* A; const bf16* W; int K; size_t wstride; int T, G, vcu; const LAS int* tab; const LAS unsigned* toff;
    __device__ bool next(int i, Unit& u) const {
        const int idx = i * G + vcu; if (idx >= T * NPN || (GATHER && i >= MAXGU)) return false;
        u.pm = idx / NPN; u.pn = idx % NPN; u.e = tab[u.pm]; return true;
    }
    __device__ __forceinline__ const char* abase(const Unit& u) const { return GATHER ? (const char*)A : (const char*)A + (size_t)u.pm * BM * K * 2; }
    __device__ __forceinline__ const char* bbase(const Unit& u) const { return (const char*)W + ((size_t)u.e * wstride + (size_t)u.pn * BM * K) * 2; }
    __device__ __forceinline__ unsigned aoff(int ui, int r) const { return toff[ui * 256 + r]; }
};

__device__ __forceinline__ f32x2 gelu_tanh2(f32x2 v) {
    const f32x2 u = (v * v * 0.044715f + 1.0f) * v * (-2.0f * 0.7978845608028654f * 1.4426950408889634f);
    f32x2 e; e.x = __builtin_amdgcn_exp2f(u.x); e.y = __builtin_amdgcn_exp2f(u.y);
    const f32x2 d = e + 1.0f; f32x2 r; r.x = __builtin_amdgcn_rcpf(d.x); r.y = __builtin_amdgcn_rcpf(d.y);
    return v * r;
}
template <int ACT  > struct EpiBf16 {
    bf16* O; int ldc; int split_cols; size_t split_stride; f32x2* part; int part_pn0;
    __device__ __forceinline__ void operator()(const f32x4 (&acc)[2][2][4][2], const Unit& u, int wr, int wc, int fr, int fq) const {
        const int row0 = u.pm * BM + wr * 64 + fr; int colt = u.pn * BM; bf16* base = O;
        if (split_cols) { const int t = colt / split_cols; base += (size_t)t * split_stride; colt -= t * split_cols; }
        const int col0 = colt + wc * 32 + 8 * fq;
#pragma unroll
        for (int ai = 0; ai < 2; ++ai)
#pragma unroll
            for (int m = 0; m < 4; ++m) { bf16* rowp = base + (size_t)(row0 + ai * HALF + m * 16) * ldc + col0; float ps = 0.f, pq = 0.f;
#pragma unroll
                for (int bj = 0; bj < 2; ++bj) { f32x4 v0 = acc[ai][bj][m][0], v1 = acc[ai][bj][m][1];
                    if (ACT == 2) { const f32x2 a = gelu_tanh2((f32x2){v0[0], v0[1]}), b = gelu_tanh2((f32x2){v0[2], v0[3]}), c = gelu_tanh2((f32x2){v1[0], v1[1]}), d = gelu_tanh2((f32x2){v1[2], v1[3]});
                        v0 = (f32x4){a.x, a.y, b.x, b.y}; v1 = (f32x4){c.x, c.y, d.x, d.y}; }
                    u32x4 w; w.x = cvt_pk_bf16(v0[0], v0[1]); w.y = cvt_pk_bf16(v0[2], v0[3]); w.z = cvt_pk_bf16(v1[0], v1[1]); w.w = cvt_pk_bf16(v1[2], v1[3]);
                    *(u32x4*)(rowp + bj * HALF) = w;
                    if (ACT == 2) { ps += (bf_lo(w.x) + bf_hi(w.x)) + (bf_lo(w.y) + bf_hi(w.y)) + (bf_lo(w.z) + bf_hi(w.z)) + (bf_lo(w.w) + bf_hi(w.w));
                        pq += (bf_lo(w.x) * bf_lo(w.x) + bf_hi(w.x) * bf_hi(w.x)) + (bf_lo(w.y) * bf_lo(w.y) + bf_hi(w.y) * bf_hi(w.y)) + (bf_lo(w.z) * bf_lo(w.z) + bf_hi(w.z) * bf_hi(w.z)) + (bf_lo(w.w) * bf_lo(w.w) + bf_hi(w.w) * bf_hi(w.w)); } }
                if (ACT == 2 && part && u.pn >= part_pn0) {
                    ps += __shfl_xor(ps, 16); ps += __shfl_xor(ps, 32); pq += __shfl_xor(pq, 16); pq += __shfl_xor(pq, 32);
                    if (fq == 0) part[(size_t)(row0 + ai * HALF + m * 16) * 96 + (u.pn - part_pn0) * 4 + wc] = (f32x2){ps, pq}; } }
    }
};
struct EpiSwiglu {
    bf16* H;
    __device__ __forceinline__ void operator()(const f32x4 (&acc)[2][2][4][2], const Unit& u, int wr, int wc, int fr, int fq) const {
        const int row0 = u.pm * BM + wr * 64 + fr, col0 = u.pn * HALF + wc * 32 + 8 * fq;
#pragma unroll
        for (int ai = 0; ai < 2; ++ai)
#pragma unroll
            for (int m = 0; m < 4; ++m) {
                f32x4 h[2];
#pragma unroll
                for (int n = 0; n < 2; ++n) { const f32x4 g = acc[ai][0][m][n], up = acc[ai][1][m][n];
                    f32x4 e; e.x = __builtin_amdgcn_exp2f(g.x * -1.4426950408889634f); e.y = __builtin_amdgcn_exp2f(g.y * -1.4426950408889634f); e.z = __builtin_amdgcn_exp2f(g.z * -1.4426950408889634f); e.w = __builtin_amdgcn_exp2f(g.w * -1.4426950408889634f);
                    e = e + 1.0f; f32x4 r; r.x = __builtin_amdgcn_rcpf(e.x); r.y = __builtin_amdgcn_rcpf(e.y); r.z = __builtin_amdgcn_rcpf(e.z); r.w = __builtin_amdgcn_rcpf(e.w);
                    h[n] = g * r * up; }
                u32x4 w; w.x = cvt_pk_bf16(h[0][0], h[0][1]); w.y = cvt_pk_bf16(h[0][2], h[0][3]); w.z = cvt_pk_bf16(h[1][0], h[1][1]); w.w = cvt_pk_bf16(h[1][2], h[1][3]);
                *(u32x4*)(H + (size_t)(row0 + ai * HALF + m * 16) * FE + col0) = w;
            }
    }
};

template <class Epi, class Sched, bool ALIGN_EPI>
__device__ __forceinline__ void gemm_phase(LAS unsigned char* lds, const int K, const Sched& S, const Epi& E) {
    int tid_ = threadIdx.x; asm volatile("" : "+v"(tid_));
    const int tid = tid_, wid = __builtin_amdgcn_readfirstlane(tid >> 6), lane = tid & 63, wr = wid >> 2, wc = wid & 3, fr = lane & 15, fq = lane >> 4;
    const int nt = K / BK;
    int RA[2], CA[2]; unsigned voffB[2];
#pragma unroll
    for (int i = 0; i < 2; ++i) { int R, C; stage_rc(tid * 16 + i * 8192, R, C); const int Rb = (R & ~31) + perm32(R & 31); RA[i] = R; CA[i] = C; voffB[i] = (unsigned)(Rb * K + C) * 2u; }
    const size_t kstep = (size_t)(BK * 2);
    const size_t hstep = (size_t)HALF * K * 2;
    const unsigned ldsw = (unsigned)wid * 1024u;
    const int aoff = lds_byte(wr * 64 + fr, fq * 8), boff = lds_byte(wc * 32 + fr, fq * 8);
#define PG8_SA(b, h) (((b) * 2 + (h)) * HTB)
#define PG8_SB(b, h) ((4 + (b) * 2 + (h)) * HTB)
#define PG8_STAGE(bufoff, gbase, voff) do { _Pragma("unroll") for (int _i = 0; _i < 2; ++_i) \
        __builtin_amdgcn_global_load_lds((const unsigned*)((const char*)(gbase) + (voff)[_i]), (LAS unsigned*)(lds + (bufoff) + ldsw + _i * 8192), 16, 0, 0); } while (0)
#define PG8_LDA(dst, b, h) do { _Pragma("unroll") for (int m = 0; m < 4; ++m) _Pragma("unroll") for (int k = 0; k < 2; ++k) dst[m][k] = *(const LAS bf16x8*)(lds + PG8_SA(b, h) + aoff + m * 2048 + k * 1024); } while (0)
#define PG8_LDB(dst, b, h) do { _Pragma("unroll") for (int n = 0; n < 2; ++n) _Pragma("unroll") for (int k = 0; k < 2; ++k) dst[n][k] = *(const LAS bf16x8*)(lds + PG8_SB(b, h) + boff + n * 2048 + k * 1024); } while (0)
#define PG8_MMA(ai, bj, At, Bt) do { __builtin_amdgcn_s_setprio(1); _Pragma("unroll") for (int m = 0; m < 4; ++m) _Pragma("unroll") for (int n = 0; n < 2; ++n) _Pragma("unroll") for (int k = 0; k < 2; ++k) \
        acc[ai][bj][m][n] = __builtin_amdgcn_mfma_f32_16x16x32_bf16(Bt[n][k], At[m][k], acc[ai][bj][m][n], 0, 0, 0); __builtin_amdgcn_s_setprio(0); } while (0)
#define PG8_WAIT_V(n) asm volatile("s_waitcnt vmcnt(" #n ")" ::: "memory")
#define PG8_WAIT_L(n) asm volatile("s_waitcnt lgkmcnt(" #n ")" ::: "memory")
#define PG8_BAR __builtin_amdgcn_s_barrier()
#define PG8_SCHED __builtin_amdgcn_sched_barrier(0)
#define PG8_AVOFF(dst, uu, uidx) do { _Pragma("unroll") for (int _h = 0; _h < 2; ++_h) _Pragma("unroll") for (int _i = 0; _i < 2; ++_i) \
        dst[_h][_i] = Sched::GATHER ? S.aoff(uidx, _h * HALF + RA[_i]) + (unsigned)CA[_i] * 2u : (unsigned)((_h * HALF + RA[_i]) * K + CA[_i]) * 2u; } while (0)
    Unit cur, nxt; int ui = 0;
    if (!S.next(0, cur)) return;
    f32x4 acc[2][2][4][2];
#pragma unroll
    for (int a = 0; a < 2; ++a)
#pragma unroll
        for (int b = 0; b < 2; ++b)
#pragma unroll
            for (int m = 0; m < 4; ++m)
#pragma unroll
                for (int n = 0; n < 2; ++n) acc[a][b][m][n] = (f32x4){0.f, 0.f, 0.f, 0.f};
    bf16x8 At[4][2], B0[2][2], B1[2][2];
    unsigned vA[2][2], vN[2][2];
    PG8_AVOFF(vA, cur, 0);
    const char* cA = S.abase(cur); const char* cB = S.bbase(cur);
    PG8_STAGE(PG8_SB(0, 0), cB, voffB); PG8_STAGE(PG8_SB(0, 1), cB + hstep, voffB); PG8_STAGE(PG8_SA(0, 0), cA, vA[0]); PG8_STAGE(PG8_SA(0, 1), cA, vA[1]);
    if (wr == 1) PG8_BAR;
    PG8_WAIT_V(2); PG8_BAR;
    PG8_STAGE(PG8_SB(1, 0), cB + kstep, voffB); PG8_STAGE(PG8_SA(1, 0), cA + kstep, vA[0]); PG8_STAGE(PG8_SB(1, 1), cB + hstep + kstep, voffB);
    PG8_WAIT_V(6); PG8_BAR;
    for (;;) {
        const bool has_next = S.next(ui + 1, nxt);
        const char* nA = has_next ? S.abase(nxt) : cA; const char* nB = has_next ? S.bbase(nxt) : cB;
        if (Sched::GATHER) { if (has_next) { PG8_AVOFF(vN, nxt, ui + 1); } else {
#pragma unroll
            for (int h = 0; h < 2; ++h)
#pragma unroll
                for (int i = 0; i < 2; ++i) vN[h][i] = vA[h][i]; } }
        for (int t = 0; t < nt; t += 2) {
            const bool last = (t == nt - 2);
            const char* a1 = cA + (size_t)(t + 1) * kstep;
            const char* a2 = last ? nA : cA + (size_t)(t + 2) * kstep; const char* b2 = last ? nB : cB + (size_t)(t + 2) * kstep;
            const char* a3 = a2 + kstep; const char* b3 = b2 + kstep;
            unsigned v2[2][2];
#pragma unroll
            for (int h = 0; h < 2; ++h)
#pragma unroll
                for (int i = 0; i < 2; ++i) v2[h][i] = (Sched::GATHER && last) ? vN[h][i] : vA[h][i];
            PG8_LDB(B0, 0, 0); PG8_LDB(B1, 0, 1); PG8_SCHED; PG8_LDA(At, 0, 0); PG8_STAGE(PG8_SA(1, 1), a1, vA[1]);
            PG8_WAIT_V(8); PG8_WAIT_L(0); PG8_BAR; PG8_MMA(0, 0, At, B0); PG8_MMA(0, 1, At, B1); PG8_BAR; PG8_SCHED;
            PG8_LDA(At, 0, 1); PG8_STAGE(PG8_SB(0, 0), b2, voffB); PG8_STAGE(PG8_SB(0, 1), b2 + hstep, voffB); PG8_STAGE(PG8_SA(0, 0), a2, v2[0]);
            PG8_WAIT_V(8); PG8_WAIT_L(0); PG8_BAR; PG8_MMA(1, 0, At, B0); PG8_MMA(1, 1, At, B1); PG8_BAR; PG8_SCHED;
            PG8_LDB(B0, 1, 0); PG8_LDB(B1, 1, 1); PG8_SCHED; PG8_LDA(At, 1, 0); PG8_STAGE(PG8_SA(0, 1), a2, v2[1]);
            PG8_WAIT_V(8); PG8_WAIT_L(0); PG8_BAR; PG8_MMA(0, 0, At, B0); PG8_MMA(0, 1, At, B1); PG8_BAR; PG8_SCHED;
            PG8_LDA(At, 1, 1); PG8_STAGE(PG8_SB(1, 0), b3, voffB); PG8_STAGE(PG8_SB(1, 1), b3 + hstep, voffB); PG8_STAGE(PG8_SA(1, 0), a3, v2[0]);
            PG8_WAIT_V(8); PG8_WAIT_L(0); PG8_BAR; PG8_MMA(1, 0, At, B0); PG8_MMA(1, 1, At, B1); PG8_BAR; PG8_SCHED;
        }
        if constexpr (ALIGN_EPI) { if (wr == 0) PG8_BAR; }
        E(acc, cur, wr, wc, fr, fq);
        if (!has_next) break;
#pragma unroll
        for (int a = 0; a < 2; ++a)
#pragma unroll
            for (int b = 0; b < 2; ++b)
#pragma unroll
                for (int m = 0; m < 4; ++m)
#pragma unroll
                    for (int n = 0; n < 2; ++n) acc[a][b][m][n] = (f32x4){0.f, 0.f, 0.f, 0.f};
        cur = nxt; cA = nA; cB = nB; ++ui;
        if (Sched::GATHER) {
#pragma unroll
            for (int h = 0; h < 2; ++h)
#pragma unroll
                for (int i = 0; i < 2; ++i) vA[h][i] = vN[h][i]; }
        if constexpr (ALIGN_EPI) { if (wr == 1) PG8_BAR; }
    }
    PG8_WAIT_V(0);
    if constexpr (!ALIGN_EPI) { if (wr == 0) PG8_BAR; }
    PG8_BAR;
#undef PG8_SA
#undef PG8_SB
#undef PG8_STAGE
#undef PG8_LDA
#undef PG8_LDB
#undef PG8_MMA
#undef PG8_WAIT_V
#undef PG8_WAIT_L
#undef PG8_BAR
#undef PG8_SCHED
#undef PG8_AVOFF
}
}

struct Args { const float* in[20]; float* out; unsigned char* ws; int ph_lo, ph_hi; };
typedef __attribute__((address_space(4))) const unsigned char* kargp_t;
__device__ __forceinline__ kargp_t karg_base() { kargp_t k = (kargp_t)__builtin_amdgcn_kernarg_segment_ptr(); asm volatile("" : "+s"(k)); return k; }
struct ArgsP {
    struct InP { __device__ __forceinline__ const float* operator[](int i) const { return *(const float* const __attribute__((address_space(4)))*)(karg_base() + 8 * i); } } in;
    struct WsP { __device__ __forceinline__ operator unsigned char*() const { return *(unsigned char* const __attribute__((address_space(4)))*)(karg_base() + 168); }
                 __device__ __forceinline__ unsigned char* operator+(size_t o) const { return (unsigned char*)(*this) + o; } } ws;
    struct OutP { __device__ __forceinline__ operator float*() const { return *(float* const __attribute__((address_space(4)))*)(karg_base() + 160); } } out;
};
static_assert(sizeof(Args) == 184, "kernarg layout: in[20] | out @160 | ws @168 | ph_lo @176 | ph_hi @180");
enum { I_X = 0, I_WQKV, I_WO, I_WIN, I_VLNG, I_VLNB, I_WSP, I_BSP, I_WOUT, I_MLNG, I_MLNB, I_WGR, I_BGR, I_WER, I_BER, I_WG, I_WU, I_WDN, I_FLNG, I_FLNB };

struct Ctx { int tid, lane, wave, gw, NGW; LAS unsigned char* lds; unsigned char* ws; };
__device__ __forceinline__ Ctx phase_ctx(const Ctx& c) { Ctx d = c; int t = c.tid; asm volatile("" : "+v"(t)); d.tid = t; d.lane = t & 63; return d; }

typedef short v4i16_t __attribute__((ext_vector_type(4)));
__device__ __forceinline__ s16x4 lds_tr(LAS const unsigned char* p) { return __builtin_bit_cast(s16x4, __builtin_amdgcn_ds_read_tr16_b64_v4i16((LAS v4i16_t*)p)); }
__device__ __forceinline__ s16x4 lds_tr_asm(LAS const unsigned char* p) { s16x4 r; asm volatile("ds_read_b64_tr_b16 %0, %1" : "=v"(r) : "v"((unsigned)(size_t)p) : "memory"); return r; }

constexpr int TRP = 136;
__device__ __forceinline__ void tr_item(const float* __restrict__ src, int N, int k0, int n0, bf16* __restrict__ dst, int Kd, int drow0, float scale, LAS unsigned char* scr, int lane) {
    const int lk = lane >> 4, ln4 = (lane & 15) * 4;
    f32x4 v[16];
#pragma unroll
    for (int i = 0; i < 16; ++i) v[i] = *(const f32x4*)(src + (size_t)(k0 + 4 * i + lk) * N + n0 + ln4);
#pragma unroll
    for (int i = 0; i < 16; ++i) {
        u32x2 w; w.x = cvt_pk_bf16(v[i].x * scale, v[i].y * scale); w.y = cvt_pk_bf16(v[i].z * scale, v[i].w * scale);
        *(LAS u32x2*)(scr + (4 * i + lk) * TRP + ln4 * 2) = w;
    }
    asm volatile("s_waitcnt lgkmcnt(0)" ::: "memory");
    const int g = lane >> 4, i16 = lane & 15, q = i16 >> 2, p = i16 & 3;
#pragma unroll
    for (int t = 0; t < 8; ++t) {
        const int nb = 16 * (t >> 1), oct = (t & 1) * 4 + g;
        LAS const unsigned char* ad = scr + (8 * oct + q) * TRP + (nb + 4 * p) * 2;
        const s16x4 lo = lds_tr(ad), hi = lds_tr(ad + 4 * TRP);
        const bf16x8 o = __builtin_shufflevector(lo, hi, 0, 1, 2, 3, 4, 5, 6, 7);
        *(bf16x8*)(dst + (size_t)(drow0 + nb + i16) * Kd + k0 + 8 * oct) = o;
    }
    asm volatile("s_waitcnt lgkmcnt(0)" ::: "memory");
}

__device__ __forceinline__ void p0_prologue(const ArgsP& a, const Ctx& c) {
    LAS unsigned char* scr = c.lds + RING_OFF + c.wave * 16384;
    constexpr int T_QKV = 2 * (D / 64) * (3 * D / 64), T_WO = 2 * (D / 64) * (D / 64), T_WIN = 2 * (D / 64) * (GF / 64), T_WOUT = 2 * (GH / 64) * (D / 64);
    constexpr int T_G = DEPTH * NX * (D / 64) * (FE / 64), T_DN = DEPTH * NX * (FE / 64) * (D / 64);
    constexpr int NITEMS = T_QKV + T_WO + T_WIN + T_WOUT + ((MOE_DIRECT && FAST_MOE && !DBG_KEEP_CONV) ? 0 : 2 * T_G + T_DN);
    for (int it = c.gw; it < NITEMS; it += c.NGW) {
        int r = it;
        if (r < T_QKV) { const int per = (D / 64) * (3 * D / 64), j = r / per; r %= per; const int kb = r / (3 * D / 64), nb = r % (3 * D / 64);
            tr_item(a.in[I_WQKV] + (size_t)j * D * 3 * D, 3 * D, kb * 64, nb * 64, (bf16*)(a.ws + WS_WQKV) + (size_t)j * 3 * D * D, D, nb * 64, nb * 64 < D ? QSCALE : 1.0f, scr, c.lane); continue; }
        r -= T_QKV;
        if (r < T_WO) { const int per = (D / 64) * (D / 64), j = r / per; r %= per; const int kb = r / (D / 64), nb = r % (D / 64);
            tr_item(a.in[I_WO] + (size_t)j * D * D, D, kb * 64, nb * 64, (bf16*)(a.ws + WS_WO) + (size_t)j * D * D, D, nb * 64, 1.0f, scr, c.lane); continue; }
        r -= T_WO;
        if (r < T_WIN) { const int per = (D / 64) * (GF / 64), j = r / per; r %= per; const int kb = r / (GF / 64), nb = r % (GF / 64);
            tr_item(a.in[I_WIN] + (size_t)j * D * GF, GF, kb * 64, nb * 64, (bf16*)(a.ws + WS_WIN) + (size_t)j * GF * D, D, nb * 64, 1.0f, scr, c.lane); continue; }
        r -= T_WIN;
        if (r < T_WOUT) { const int per = (GH / 64) * (D / 64), j = r / per; r %= per; const int kb = r / (D / 64), nb = r % (D / 64);
            tr_item(a.in[I_WOUT] + (size_t)j * GH * D, D, kb * 64, nb * 64, (bf16*)(a.ws + WS_WOUT) + (size_t)j * D * GH, GH, nb * 64, 1.0f, scr, c.lane); continue; }
        r -= T_WOUT;
        if (r < 2 * T_G) { const int up = r >= T_G; if (up) r -= T_G; const int per = (D / 64) * (FE / 64), x = r / per; r %= per; const int kb = r / (FE / 64), nb = r % (FE / 64);
            const int f0 = nb * 64, drow = 256 * (f0 >> 7) + 128 * up + (f0 & 127);
            tr_item(a.in[up ? I_WU : I_WG] + (size_t)x * D * FE, FE, kb * 64, f0, (bf16*)(a.ws + WS_WGU) + (size_t)x * 1024 * D, D, drow, 1.0f, scr, c.lane); continue; }
        r -= 2 * T_G;
        { const int per = (FE / 64) * (D / 64), x = r / per; r %= per; const int kb = r / (D / 64), nb = r % (D / 64);
            tr_item(a.in[I_WDN] + (size_t)x * FE * D, D, kb * 64, nb * 64, (bf16*)(a.ws + WS_WD) + (size_t)x * D * FE, FE, nb * 64, 1.0f, scr, c.lane); }
    }
    {
        const int gt = blockIdx.x * NTHREADS + c.tid, GT = gridDim.x * NTHREADS;
        bf16* wr = (bf16*)(a.ws + WS_WR);
        for (int i = gt; i < DEPTH * 48 * D; i += GT) {
            const int k = i % D, rho = (i / D) % 48, L = i / (48 * D), nt = rho >> 4, g = (rho >> 2) & 3, ii = rho & 3;
            float v = 0.f;
            if (nt < 2) v = a.in[I_WER][((size_t)(L * NGRP + g) * D + k) * NEXP + 4 * nt + ii];
            else if (ii == 0) v = a.in[I_WGR][((size_t)L * D + k) * NGRP + g];
            wr[i] = (bf16)(cvt_pk_bf16(v, 0.f) & 0xffffu);
        }
        bf16* wsb = (bf16*)(a.ws + WS_WSPB);
        for (int i = gt; i < 2 * GG * CH * CH; i += GT) { const int s_ = i % CH, t_ = (i / CH) % CH; wsb[i] = (bf16)(cvt_pk_bf16(s_ <= t_ ? a.in[I_WSP][i] : 0.f, 0.f) & 0xffffu); }
        const f32x4* x4 = (const f32x4*)a.in[I_X]; u32x2* xb = (u32x2*)(a.ws + WS_XB);
        for (int i = gt; i < M * D / 4; i += GT) { const f32x4 v = x4[i]; u32x2 w; w.x = cvt_pk_bf16(v.x, v.y); w.y = cvt_pk_bf16(v.z, v.w); xb[i] = w; }
    }
}

#define MFMA16(a, b, c) __builtin_amdgcn_mfma_f32_16x16x32_bf16((a), (b), (c), 0, 0, 0)
__device__ __forceinline__ void sg_tile(const bf16* a0, const bf16* a1, const bf16* b0, const bf16* b1, const bf16* b2, const bf16* b3, int K, f32x4 (&acc)[2][4]) {
#pragma unroll
    for (int i = 0; i < 2; ++i)
#pragma unroll
        for (int j = 0; j < 4; ++j) acc[i][j] = (f32x4){0.f, 0.f, 0.f, 0.f};
    for (int k = 0; k < K; k += 32) {
        const bf16x8 fa0 = *(const bf16x8*)(a0 + k), fa1 = *(const bf16x8*)(a1 + k);
        const bf16x8 fb0 = *(const bf16x8*)(b0 + k), fb1 = *(const bf16x8*)(b1 + k), fb2 = *(const bf16x8*)(b2 + k), fb3 = *(const bf16x8*)(b3 + k);
        acc[0][0] = MFMA16(fb0, fa0, acc[0][0]); acc[0][1] = MFMA16(fb1, fa0, acc[0][1]); acc[0][2] = MFMA16(fb2, fa0, acc[0][2]); acc[0][3] = MFMA16(fb3, fa0, acc[0][3]);
        acc[1][0] = MFMA16(fb0, fa1, acc[1][0]); acc[1][1] = MFMA16(fb1, fa1, acc[1][1]); acc[1][2] = MFMA16(fb2, fa1, acc[1][2]); acc[1][3] = MFMA16(fb3, fa1, acc[1][3]);
    }
}
__device__ __forceinline__ void st_bf16x4(bf16* p, f32x4 v) { u32x2 w; w.x = cvt_pk_bf16(v.x, v.y); w.y = cvt_pk_bf16(v.z, v.w); *(u32x2*)p = w; }

template <int EPI>
__device__ __forceinline__ void sg_dense(const Ctx& c, const bf16* A, const bf16* Bt, int Mr, int N, int K, bf16* O) {
    const int fr = c.lane & 15, fq = c.lane >> 4, ntn = N / 64, ntiles = (Mr / 32) * ntn;
    for (int t = c.gw; t < ntiles; t += c.NGW) {
        const int m0 = (t / ntn) * 32, n0 = (t % ntn) * 64;
        f32x4 acc[2][4];
        const bf16* ap = A + (size_t)(m0 + fr) * K + 8 * fq; const bf16* bp = Bt + (size_t)(n0 + fr) * K + 8 * fq;
        sg_tile(ap, ap + (size_t)16 * K, bp, bp + (size_t)16 * K, bp + (size_t)32 * K, bp + (size_t)48 * K, K, acc);
#pragma unroll
        for (int mt = 0; mt < 2; ++mt)
#pragma unroll
            for (int nt = 0; nt < 4; ++nt) {
                const int row = m0 + 16 * mt + fr, col = n0 + 16 * nt + 4 * fq; f32x4 v = acc[mt][nt];
                if (EPI == 0) st_bf16x4(O + (size_t)row * N + col, v);
                if (EPI == 1) { const int w = col / D, cc = col % D; st_bf16x4(O + (size_t)w * ((WS_K - WS_Q) / 2) + (size_t)row * D + cc, v); }
                if (EPI == 2) { v.x = gelu_tanh(v.x); v.y = gelu_tanh(v.y); v.z = gelu_tanh(v.z); v.w = gelu_tanh(v.w); st_bf16x4(O + (size_t)row * N + col, v); }
            }
    }
}

__device__ __forceinline__ void moe_tables(const ArgsP& a, const Ctx& c, int L) {
    LAS int* tab = (LAS int*)(c.lds + TAB_OFF);
    if (c.tid < 64) {
        gu32* cnt = (gu32*)(a.ws + WS_CTL) + CW_CNT + L * 32 * CNT_STRIDE;
        const int e = c.lane & 31;
        const int cj = (int)__hip_atomic_load(cnt + e * CNT_STRIDE, RLX_AGENT), n = (cj + MOE_TR - 1) >> MOE_TSH;
        int incl = n;
#pragma unroll
        for (int o = 1; o < 32; o <<= 1) { const int t = __shfl_up(incl, o, 32); if (e >= o) incl += t; }
        const int base = incl - n;
        if (c.lane < 32) { tab[TB_BASE + e] = base; tab[TB_CNT + e] = cj; if (e == 31) tab[TB_BASE + 32] = incl; for (int i = 0; i < n; ++i) tab[base + i] = e; }
        const int np = (n + 1) >> 1; int pincl = np;
#pragma unroll
        for (int o = 1; o < 32; o <<= 1) { const int t = __shfl_up(pincl, o, 32); if (e >= o) pincl += t; }
        if (c.lane < 32) { const int pb = pincl - np; if (e == 31) tab[TB_NP] = pincl; for (int i = 0; i < np; ++i) tab[TB_PAIR + pb + i] = (base + 2 * i) | ((2 * i + 1 < n ? 2 : 1) << 16); }
    }
    __syncthreads();
}

__device__ __forceinline__ void sg_moe_gu(const ArgsP& a, const Ctx& c, int L) {
    LAS int* tab = (LAS int*)(c.lds + TAB_OFF);
    const int T = tab[TB_BASE + 32], fr = c.lane & 15, fq = c.lane >> 4, ntiles = T * (MOE_TR / 32) * 16;
    const bf16* xb = (const bf16*)(a.ws + WS_XB); const int* list = (const int*)(a.ws + WS_LIST); bf16* hp = (bf16*)(a.ws + WS_HP);
    for (int t = c.gw; t < ntiles; t += c.NGW) {
        const int rt = t / 16, fb = t % 16, prow0 = rt * 32, e = tab[prow0 >> MOE_TSH], ebase = MOE_TR * tab[TB_BASE + e], ecnt = tab[TB_CNT + e];
        const int p0 = prow0 - ebase + fr, p1 = p0 + 16;
        const int tok0 = p0 < ecnt ? (list[e * M + p0] >> 1) : 0, tok1 = p1 < ecnt ? (list[e * M + p1] >> 1) : 0;
        const bf16* w = (const bf16*)(a.ws + WS_WGU) + (size_t)(L * NX + e) * 1024 * D;
        const int vb = 256 * (fb >> 2) + 32 * (fb & 3);
        const bf16* bp = w + (size_t)(vb + fr) * D + 8 * fq;
        f32x4 acc[2][4];
        sg_tile(xb + (size_t)tok0 * D + 8 * fq, xb + (size_t)tok1 * D + 8 * fq, bp, bp + (size_t)16 * D, bp + (size_t)128 * D, bp + (size_t)144 * D, D, acc);
#pragma unroll
        for (int mt = 0; mt < 2; ++mt)
#pragma unroll
            for (int nt = 0; nt < 2; ++nt) {
                const f32x4 g = acc[mt][nt], u = acc[mt][nt + 2]; f32x4 h;
                h.x = silu(g.x) * u.x; h.y = silu(g.y) * u.y; h.z = silu(g.z) * u.z; h.w = silu(g.w) * u.w;
                st_bf16x4(hp + (size_t)(prow0 + 16 * mt + fr) * FE + 128 * (fb >> 2) + 32 * (fb & 3) + 16 * nt + 4 * fq, h);
            }
    }
}
__device__ __forceinline__ void sg_moe_dn(const ArgsP& a, const Ctx& c, int L) {
    LAS int* tab = (LAS int*)(c.lds + TAB_OFF);
    const int T = tab[TB_BASE + 32], fr = c.lane & 15, fq = c.lane >> 4, ntiles = T * (MOE_TR / 32) * (D / 64);
    const bf16* hp = (const bf16*)(a.ws + WS_HP); bf16* yp = (bf16*)(a.ws + WS_YP);
    for (int t = c.gw; t < ntiles; t += c.NGW) {
        const int rt = t / (D / 64), nb = t % (D / 64), prow0 = rt * 32, n0 = nb * 64, e = tab[prow0 >> MOE_TSH];
        const bf16* w = (const bf16*)(a.ws + WS_WD) + (size_t)(L * NX + e) * D * FE;
        const bf16* ap = hp + (size_t)(prow0 + fr) * FE + 8 * fq; const bf16* bp = w + (size_t)(n0 + fr) * FE + 8 * fq;
        f32x4 acc[2][4];
        sg_tile(ap, ap + (size_t)16 * FE, bp, bp + (size_t)16 * FE, bp + (size_t)32 * FE, bp + (size_t)48 * FE, FE, acc);
#pragma unroll
        for (int mt = 0; mt < 2; ++mt)
#pragma unroll
            for (int nt = 0; nt < 4; ++nt) st_bf16x4(yp + (size_t)(prow0 + 16 * mt + fr) * D + n0 + 16 * nt + 4 * fq, acc[mt][nt]);
    }
}

__device__ __forceinline__ void moe_gu_fast(const ArgsP& a, const Ctx& c, int L) {
    LAS int* tab = (LAS int*)(c.lds + TAB_OFF); LAS unsigned* toff = (LAS unsigned*)(c.lds + TOFF_OFF);
    const int G = gridDim.x, bx = blockIdx.x, vcu = (G % 8 == 0) ? (bx % 8) * (G / 8) + bx / 8 : bx;
    pg8::MoeOrder<true, 4> S; S.A = (const bf16*)(a.ws + WS_XB); S.W = (const bf16*)(a.ws + WS_WGU) + (size_t)L * NX * 1024 * D; S.K = D; S.wstride = (size_t)1024 * D;
    S.T = tab[TB_BASE + 32]; S.G = G; S.vcu = vcu; S.tab = tab; S.toff = toff;
    const int* list = (const int*)(a.ws + WS_LIST);
    pg8::Unit u;
    for (int i = 0; i < MAXGU && S.next(i, u); ++i)
        for (int r = c.tid; r < 256; r += NTHREADS) {
            const int pos = MOE_TR * (u.pm - tab[TB_BASE + u.e]) + r;
            const int tok = pos < tab[TB_CNT + u.e] ? (list[u.e * M + pos] >> 1) : 0;
            toff[i * 256 + r] = (unsigned)tok * (unsigned)(D * 2);
        }
    __syncthreads();
    pg8::EpiSwiglu E{(bf16*)(a.ws + WS_HP)};
    pg8::gemm_phase<pg8::EpiSwiglu, pg8::MoeOrder<true, 4>, true>(c.lds + RING_OFF, D, S, E);
}
__device__ __forceinline__ void moe_dn_fast(const ArgsP& a, const Ctx& c, int L) {
    LAS int* tab = (LAS int*)(c.lds + TAB_OFF);
    const int G = gridDim.x, bx = blockIdx.x, vcu = (G % 8 == 0) ? (bx % 8) * (G / 8) + bx / 8 : bx;
    pg8::MoeOrder<false, 8> S; S.A = (const bf16*)(a.ws + WS_HP); S.W = (const bf16*)(a.ws + WS_WD) + (size_t)L * NX * D * FE; S.K = FE; S.wstride = (size_t)D * FE;
    S.T = tab[TB_BASE + 32]; S.G = G; S.vcu = vcu; S.tab = tab; S.toff = nullptr;
    pg8::EpiBf16<0> E{(bf16*)(a.ws + WS_YP), D, 0, 0, nullptr, 0};
    pg8::gemm_phase<pg8::EpiBf16<0>, pg8::MoeOrder<false, 8>, true>(c.lds + RING_OFF, FE, S, E);
}
template <int ACT>
__device__ __forceinline__ void dense_fast(const Ctx& c, const bf16* A, const bf16* Bt, int N, int K, bf16* O, int split_cols, size_t split_stride, f32x2* part = nullptr, int part_pn0 = 0) {
    pg8::DenseOrder S; S.init(A, Bt, M, N, K, gridDim.x, blockIdx.x);
    pg8::EpiBf16<ACT> E{O, split_cols ? split_cols : N, split_cols, split_stride, part, part_pn0};
    pg8::gemm_phase<pg8::EpiBf16<ACT>, pg8::DenseOrder, true>(c.lds + RING_OFF, K, S, E);
}

namespace mg {
constexpr int ASTG = 16384, NAST = 4, BBASE = NAST * ASTG, BSTG = 32768;
template <int MODE  , int VAR = 0  , bool DYN = false  >
__device__ __forceinline__ void moe_direct(const ArgsP& a, const Ctx& c, int L) {
    LAS int* tab = (LAS int*)(c.lds + TAB_OFF); LAS unsigned* toff = (LAS unsigned*)(c.lds + TOFF_OFF);
    LAS unsigned char* ring = c.lds + RING_OFF;
    int tid_ = threadIdx.x; asm volatile("" : "+v"(tid_));
    const int tid = tid_, wid = __builtin_amdgcn_readfirstlane(tid >> 6), lane = tid & 63, wr = wid >> 2, wc = wid & 3, fr = lane & 15, fq = lane >> 4;
    constexpr int K = MODE == 0 ? D : FE, nk = K / 64, NPN = MODE == 0 ? 4 : 8, ldb = MODE == 0 ? FE : D;
    const int T = __builtin_amdgcn_readfirstlane(tab[TB_BASE + 32]), G = gridDim.x, bx = blockIdx.x, vcu = (G % 8 == 0) ? (bx % 8) * (G / 8) + bx / 8 : bx, NU = T * NPN;
    if (MODE == 0) {
        const int* list = (const int*)(a.ws + WS_LIST);
        for (int i = 0; i < 16; ++i) { const int idx = i * G + vcu; if (idx >= NU) break;
            const int rt = DYN ? (idx >> 2) : idx % T, e = tab[rt];
            if (tid < 128) { const int pos = MOE_TR * (rt - tab[TB_BASE + e]) + tid; const int tok = pos < tab[TB_CNT + e] ? (list[e * M + pos] >> 1) : 0; toff[i * 128 + tid] = (unsigned)tok * (unsigned)(D * 2); } }
        __syncthreads();
    }
    int RA[2], CA[2];
#pragma unroll
    for (int i = 0; i < 2; ++i) pg8::stage_rc(tid * 16 + i * 8192, RA[i], CA[i]);
    const int aoff = pg8::lds_byte(wr * 64 + fr, fq * 8);
    const int n4 = MODE == 0 ? (lane & 31) + 32 * (wid & 1) : lane, kr = MODE == 0 ? 2 * (wid >> 1) + (lane >> 5) : wid;
    const unsigned bvoff = MODE == 0 ? (unsigned)(((lane >> 5) * ldb + 4 * (lane & 31)) * 4) : (unsigned)(lane * 16);
    const unsigned bw0 = (unsigned)(kr * 512 + ((n4 ^ ((kr & 3) << 2)) << 3)), bw1 = (unsigned)(kr * 512 + ((n4 ^ (((kr & 3) | 4) << 2)) << 3));
    const int kq = lane >> 4, q4 = (lane & 15) >> 2, p4 = lane & 3, fxl = (q4 | ((kq & 1) << 2)) << 2;
    unsigned boffr[4];
#pragma unroll
    for (int nt = 0; nt < 4; ++nt) { const int g0 = MODE == 0 ? (nt < 2 ? 8 * wc + 4 * nt : 32 + 8 * wc + 4 * (nt - 2)) : 16 * wc + 4 * nt; boffr[nt] = (unsigned)((8 * kq + q4) * 512 + (((g0 + p4) ^ fxl) << 3)); }
    const unsigned ldsw = (unsigned)wid * 1024u;
    gu32* done = (gu32*)(a.ws + WS_CTL) + CW_DONE + L * 256 * DONE_STRIDE; gu32* qhead = (gu32*)(a.ws + WS_CTL) + CW_QDN + L * 64; gu32* tmo = (gu32*)(a.ws + WS_CTL) + CW_TMO;
    for (int ui = 0; ui < (DYN && MODE == 1 ? 0x7fffffff : 16); ++ui) {
        int idx;
        if (DYN && MODE == 1) {
            if (tid == 0) tab[300] = (int)__hip_atomic_fetch_add(qhead, 1u, RLX_AGENT);
            __syncthreads();
            idx = __builtin_amdgcn_readfirstlane(tab[300]); if (idx >= NU) break;
            if (wid == 0) { unsigned sp = 0;
                while (__hip_atomic_load(done + (idx >> 3) * DONE_STRIDE, RLX_AGENT) < 32u) { __builtin_amdgcn_s_sleep(1); if (++sp > (1u << 22)) { if (lane == 0) __hip_atomic_store(tmo, 1u, RLX_AGENT); break; } }
                __builtin_amdgcn_fence(__ATOMIC_ACQUIRE, "agent"); asm volatile("s_waitcnt vmcnt(0)" ::: "memory"); }
            __syncthreads();
        } else { idx = ui * G + vcu; if (idx >= NU) break; }
        const int pn = (DYN && MODE == 1) ? (idx & 7) : (DYN ? (idx & 3) : idx / T), rt = (DYN && MODE == 1) ? (idx >> 3) : (DYN ? (idx >> 2) : idx % T), e = __builtin_amdgcn_readfirstlane(tab[rt]), prow0 = rt * MOE_TR;
        const char* abase; unsigned va[2];
        if (MODE == 0) { abase = (const char*)(a.ws + WS_XB); va[0] = toff[ui * 128 + RA[0]] + (unsigned)CA[0] * 2u; va[1] = toff[ui * 128 + RA[1]] + (unsigned)CA[1] * 2u; }
        else { abase = (const char*)(a.ws + WS_HP) + (size_t)prow0 * FE * 2; va[0] = (unsigned)(RA[0] * FE + CA[0]) * 2u; va[1] = (unsigned)(RA[1] * FE + CA[1]) * 2u; }
        const float* wsrc;
        if (MODE == 0) wsrc = a.in[(wid & 1) ? I_WU : I_WG] + (size_t)(L * NX + e) * D * FE + 128 * pn + (size_t)(2 * (wid >> 1)) * ldb;
        else wsrc = a.in[I_WDN] + (size_t)(L * NX + e) * FE * D + 256 * pn + (size_t)wid * ldb;
        { const unsigned long long wq = (unsigned long long)wsrc; const unsigned wlo = __builtin_amdgcn_readfirstlane((unsigned)wq), whi = __builtin_amdgcn_readfirstlane((unsigned)(wq >> 32));
          wsrc = (const float*)(((unsigned long long)whi << 32) | wlo); }
        f32x4 acc[4][4];
#pragma unroll
        for (int m = 0; m < 4; ++m)
#pragma unroll
            for (int n = 0; n < 4; ++n) acc[m][n] = (f32x4){0.f, 0.f, 0.f, 0.f};
        f32x4 br0[8], br1[8];
#define MG_LOADB(dst, kt) do { if (VAR & 1) break; _Pragma("unroll") for (int _i = 0; _i < 8; ++_i) { const float* _q = wsrc + (size_t)((kt) * 64 + 8 * _i) * ldb; asm volatile("global_load_dwordx4 %0, %1, %2" : "=v"(dst[_i]) : "v"(bvoff), "s"(_q) : "memory"); } } while (0)
#define MG_WAIT(N, r) asm volatile("s_waitcnt vmcnt(" #N ") lgkmcnt(0)" : "+v"(r[0]), "+v"(r[1]), "+v"(r[2]), "+v"(r[3]), "+v"(r[4]), "+v"(r[5]), "+v"(r[6]), "+v"(r[7]) :: "memory")
#define MG_WRITEB(src, st) do { if (VAR & 8) break; _Pragma("unroll") for (int _i = 0; _i < 8; ++_i) { u32x2 _w; _w.x = cvt_pk_bf16(src[_i].x, src[_i].y); _w.y = cvt_pk_bf16(src[_i].z, src[_i].w); \
        *(LAS u32x2*)(ring + BBASE + (st) * BSTG + _i * 4096 + ((_i & 1) ? bw1 : bw0)) = _w; } } while (0)
#define MG_DMAA(kt, st) do { if (VAR & 2) break; _Pragma("unroll") for (int _i = 0; _i < 2; ++_i) \
        __builtin_amdgcn_global_load_lds((const unsigned*)(abase + (size_t)(kt) * 128 + va[_i]), (LAS unsigned*)(ring + (st) * ASTG + ldsw + _i * 8192), 16, 0, 0); } while (0)
#define MG_READ(sb) do { \
        _Pragma("unroll") for (int kk = 0; kk < 2; ++kk) { const unsigned _b = (unsigned)(size_t)(ring + BBASE + (sb) * BSTG + kk * 16384); s16x4 _l0, _h0, _l1, _h1, _l2, _h2, _l3, _h3; \
            asm volatile("ds_read_b64_tr_b16 %0, %8\n\tds_read_b64_tr_b16 %1, %8 offset:2048\n\tds_read_b64_tr_b16 %2, %9\n\tds_read_b64_tr_b16 %3, %9 offset:2048\n\t" \
                         "ds_read_b64_tr_b16 %4, %10\n\tds_read_b64_tr_b16 %5, %10 offset:2048\n\tds_read_b64_tr_b16 %6, %11\n\tds_read_b64_tr_b16 %7, %11 offset:2048" \
                         : "=&v"(_l0), "=&v"(_h0), "=&v"(_l1), "=&v"(_h1), "=&v"(_l2), "=&v"(_h2), "=&v"(_l3), "=&v"(_h3) \
                         : "v"(_b + boffr[0]), "v"(_b + boffr[1]), "v"(_b + boffr[2]), "v"(_b + boffr[3]) : "memory"); \
            Bf[kk][0] = __builtin_shufflevector(_l0, _h0, 0, 1, 2, 3, 4, 5, 6, 7); Bf[kk][1] = __builtin_shufflevector(_l1, _h1, 0, 1, 2, 3, 4, 5, 6, 7); \
            Bf[kk][2] = __builtin_shufflevector(_l2, _h2, 0, 1, 2, 3, 4, 5, 6, 7); Bf[kk][3] = __builtin_shufflevector(_l3, _h3, 0, 1, 2, 3, 4, 5, 6, 7); } } while (0)
#define MG_PIN() asm volatile("" : "+v"(Bf[0][0]), "+v"(Bf[0][1]), "+v"(Bf[0][2]), "+v"(Bf[0][3]), "+v"(Bf[1][0]), "+v"(Bf[1][1]), "+v"(Bf[1][2]), "+v"(Bf[1][3]) :: "memory")
#define MG_MMA(sa) do { bf16x8 Af[2][4]; \
        _Pragma("unroll") for (int kk = 0; kk < 2; ++kk) _Pragma("unroll") for (int m = 0; m < 4; ++m) Af[kk][m] = *(const LAS bf16x8*)(ring + (sa) * ASTG + aoff + m * 2048 + kk * 1024); \
        __builtin_amdgcn_s_setprio(1); \
        _Pragma("unroll") for (int kk = 0; kk < 2; ++kk) _Pragma("unroll") for (int m = 0; m < 4; ++m) _Pragma("unroll") for (int n = 0; n < 4; ++n) { if (!(VAR & 4)) acc[m][n] = MFMA16(Bf[kk][n], Af[kk][m], acc[m][n]); else acc[m][n][0] += __builtin_bit_cast(float, (int)Bf[kk][n][0] + (int)Af[kk][m][0]); } \
        __builtin_amdgcn_s_setprio(0); } while (0)
#define MG_BAR() do { asm volatile("" ::: "memory"); __builtin_amdgcn_s_barrier(); asm volatile("" ::: "memory"); __builtin_amdgcn_sched_barrier(0); } while (0)
        bf16x8 Bf[2][4];
        MG_LOADB(br0, 0); MG_LOADB(br1, 1); MG_DMAA(0, 0); MG_DMAA(1, 1);
        MG_WAIT(12, br0);
        MG_WRITEB(br0, 0);
        __builtin_amdgcn_sched_barrier(0);
        MG_LOADB(br0, 2);
        MG_WAIT(10, br1);
        MG_BAR();
        if (wr == 1) MG_BAR();
#pragma unroll
        for (int kt = 0; kt < nk; ++kt) {
            MG_READ(kt & 1);
            if (kt + 1 < nk) { if ((kt & 1) == 0) MG_WRITEB(br1, 1); else MG_WRITEB(br0, 0); }
            if (kt + 2 < nk) MG_DMAA(kt + 2, (kt + 2) % NAST);
            __builtin_amdgcn_sched_barrier(0);
            if (kt + 3 < nk) { if ((kt & 1) == 0) MG_LOADB(br1, kt + 3); else MG_LOADB(br0, kt + 3); }
            __builtin_amdgcn_sched_barrier(0);
            if ((kt & 1) == 0) { if (kt + 3 < nk) MG_WAIT(10, br0); else if (kt + 2 < nk) MG_WAIT(2, br0); else MG_WAIT(0, br0); }
            else               { if (kt + 3 < nk) MG_WAIT(10, br1); else if (kt + 2 < nk) MG_WAIT(2, br1); else MG_WAIT(0, br1); }
            MG_PIN();
            MG_BAR();
            MG_MMA(kt % NAST);
            MG_BAR();
        }
        if (wr == 0) MG_BAR();
#undef MG_READ
#undef MG_PIN
#undef MG_MMA
#undef MG_BAR
#undef MG_LOADB
#undef MG_WAIT
#undef MG_WRITEB
#undef MG_DMAA
        if (MODE == 0) {
            bf16* H = VAR ? (bf16*)(a.ws + WS_Z) : (bf16*)(a.ws + WS_HP);
#pragma unroll
            for (int m = 0; m < 4; ++m)
#pragma unroll
                for (int nt = 0; nt < 2; ++nt) { const f32x4 g = acc[m][nt], up = acc[m][nt + 2]; f32x4 hh;
                    hh.x = g.x * fast_rcp(1.f + fast_exp2(g.x * -1.4426950408889634f)) * up.x; hh.y = g.y * fast_rcp(1.f + fast_exp2(g.y * -1.4426950408889634f)) * up.y;
                    hh.z = g.z * fast_rcp(1.f + fast_exp2(g.z * -1.4426950408889634f)) * up.z; hh.w = g.w * fast_rcp(1.f + fast_exp2(g.w * -1.4426950408889634f)) * up.w;
                    bf16* hp_ = H + (size_t)(prow0 + 64 * wr + 16 * m + fr) * FE + 128 * pn + 32 * wc + 16 * nt + 4 * fq;
                    if (DYN) { const unsigned long long pk_ = (unsigned long long)cvt_pk_bf16(hh.x, hh.y) | ((unsigned long long)cvt_pk_bf16(hh.z, hh.w) << 32);
                        __hip_atomic_store((GAS unsigned long long*)hp_, pk_, RLX_AGENT); }
                    else st_bf16x4(hp_, hh); }
            if (DYN) { asm volatile("s_waitcnt vmcnt(0)" ::: "memory"); if (lane == 0) __hip_atomic_fetch_add(done + rt * DONE_STRIDE, 1u, RLX_AGENT); }
        } else {
            bf16* Y = VAR ? (bf16*)(a.ws + WS_Z) + 16 * 1048576 : (bf16*)(a.ws + WS_YP);
#pragma unroll
            for (int m = 0; m < 4; ++m)
#pragma unroll
                for (int nt = 0; nt < 4; ++nt) st_bf16x4(Y + (size_t)(prow0 + 64 * wr + 16 * m + fr) * D + 256 * pn + 64 * wc + 16 * nt + 4 * fq, acc[m][nt]);
        }
    }
}
}

namespace mg3 {
constexpr int ASUB = 8192, ASTG = 16384, NAST = 3, BBASE = NAST * ASTG, BSTG = 16384;
template <int MODE  >
__device__ __forceinline__ void moe_pairs(const ArgsP& a, const Ctx& c, int L) {
    constexpr bool GU = MODE != 1;
    LAS int* tab = (LAS int*)(c.lds + TAB_OFF); LAS unsigned* toff = (LAS unsigned*)(c.lds + TOFF_OFF);
    LAS unsigned char* ring = c.lds + RING_OFF;
    int tid_ = threadIdx.x; asm volatile("" : "+v"(tid_));
    const int tid = tid_, wid = __builtin_amdgcn_readfirstlane(tid >> 6), lane = tid & 63, wr = wid >> 2, wc = wid & 3, fr = lane & 15, fq = lane >> 4;
    constexpr int nk = MODE == 0 ? D / 32 : MODE == 2 ? D / 64 : FE / 32, NPN = GU ? 4 : 8, ldb = GU ? FE : D;
    const int NP = __builtin_amdgcn_readfirstlane(tab[TB_NP]), G = gridDim.x, bx = blockIdx.x, vcu = (G % 8 == 0) ? (bx % 8) * (G / 8) + bx / 8 : bx, NU = NP * NPN;
    const int nround = (NU + 255) >> 8, rlast = NU - ((nround - 1) << 8); const bool ksplit = GU && G == 256 && nround >= 2 && rlast <= 128;
    const int nfull = nround - (ksplit ? 1 : 0);
    if (MODE == 2 && (!ksplit || vcu >= 2 * rlast)) return;
    const int khalf = MODE == 2 ? (vcu & 1) : 0;
    if (GU) {
        const int* list = (const int*)(a.ws + WS_LIST);
        for (int i = 0; i < (MODE == 2 ? 1 : MAXGU); ++i) { const int idx = MODE == 2 ? (nround - 1) * G + (vcu >> 1) : i * G + vcu; if (MODE == 0 && (i >= nfull || idx >= NU)) break;
            const int pw = tab[TB_PAIR + (idx >> 2)], rt0 = pw & 0xffff, e = tab[rt0];
            if (tid < 256) { const int pos = MOE_TR * (rt0 - tab[TB_BASE + e]) + tid; const int tok = pos < tab[TB_CNT + e] ? (list[e * M + pos] >> 1) : 0; toff[i * 256 + tid] = (unsigned)tok * (unsigned)(D * 2); } }
        __syncthreads();
    }
    const int aoff = (wr * 64 + fr) * 64 + 16 * (fq ^ ((fr >> 2) & 3));
    const int n4 = GU ? (lane & 31) + 32 * (wid & 1) : lane, kr = GU ? 2 * (wid >> 1) + (lane >> 5) : wid;
    const unsigned bvoff = GU ? (unsigned)(((lane >> 5) * ldb + 4 * (lane & 31)) * 4) : (unsigned)(lane * 16);
    const unsigned bw0 = (unsigned)(kr * 512 + ((n4 ^ ((kr & 3) << 2)) << 3));
    const int kq = lane >> 4, q4 = (lane & 15) >> 2, p4 = lane & 3, fxl = (q4 | ((kq & 1) << 2)) << 2;
    const int g00 = GU ? 8 * wc : 16 * wc;
    const unsigned boffr0 = (unsigned)((8 * kq + q4) * 512 + (((g00 + p4) ^ fxl) << 3));
    const unsigned ldsw = (unsigned)wid * 1024u;
    gu32* done = (gu32*)(a.ws + WS_CTL) + CW_DONE + L * 256 * DONE_STRIDE; gu32* qhead = (gu32*)(a.ws + WS_CTL) + CW_QDN + L * 64; gu32* tmo = (gu32*)(a.ws + WS_CTL) + CW_TMO;
    for (int ui = 0; ui < (MODE == 1 ? 0x7fffffff : MAXGU); ++ui) {
        int idx;
        if (MODE == 1) {
            if (tid == 0) tab[300] = (int)__hip_atomic_fetch_add(qhead, 1u, RLX_AGENT);
            __syncthreads();
            idx = __builtin_amdgcn_readfirstlane(tab[300]); if (idx >= NU) break;
            if (wid == 0) { unsigned sp = 0;
                while (__hip_atomic_load(done + (idx >> 3) * DONE_STRIDE, RLX_AGENT) < 32u) { __builtin_amdgcn_s_sleep(1); if (++sp > (1u << 22)) { if (lane == 0) __hip_atomic_store(tmo, 1u, RLX_AGENT); break; } }
                __builtin_amdgcn_fence(__ATOMIC_ACQUIRE, "agent"); asm volatile("s_waitcnt vmcnt(0)" ::: "memory"); }
            __syncthreads();
        } else if (MODE == 2) { if (ui > 0) break; idx = (nround - 1) * G + (vcu >> 1); }
        else { idx = ui * G + vcu; if (ui >= nfull || idx >= NU) break; }
        const int pair = MODE == 1 ? (idx >> 3) : (idx >> 2), pn = MODE == 1 ? (idx & 7) : (idx & 3);
        const int pw = __builtin_amdgcn_readfirstlane(tab[TB_PAIR + pair]), rt0 = pw & 0xffff, nsub = pw >> 16, e = __builtin_amdgcn_readfirstlane(tab[rt0]), prow0 = rt0 * MOE_TR;
        int t1_ = threadIdx.x; asm volatile("" : "+v"(t1_));
        const int RA = t1_ >> 2, CA = 8 * ((t1_ & 3) ^ ((RA >> 2) & 3));
        const char* abase; unsigned va[2];
#pragma unroll
        for (int sb = 0; sb < 2; ++sb) va[sb] = GU ? toff[ui * 256 + 128 * sb + RA] + (unsigned)CA * 2u : (unsigned)((128 * sb + RA) * FE + CA) * 2u;
        if (GU) abase = (const char*)(a.ws + WS_XB) + khalf * (nk * 64); else abase = (const char*)(a.ws + WS_HP) + (size_t)prow0 * FE * 2;
        const float* wsrc;
        if (GU) wsrc = a.in[(wid & 1) ? I_WU : I_WG] + (size_t)(L * NX + e) * D * FE + 128 * pn + (size_t)(2 * (wid >> 1) + khalf * (nk * 32)) * ldb;
        else wsrc = a.in[I_WDN] + (size_t)(L * NX + e) * FE * D + 256 * pn + (size_t)wid * ldb;
        { const unsigned long long wq = (unsigned long long)wsrc; const unsigned wlo = __builtin_amdgcn_readfirstlane((unsigned)wq), whi = __builtin_amdgcn_readfirstlane((unsigned)(wq >> 32));
          wsrc = (const float*)(((unsigned long long)whi << 32) | wlo); }
        f32x4 acc[2][4][4];
#pragma unroll
        for (int sb = 0; sb < 2; ++sb)
#pragma unroll
            for (int m = 0; m < 4; ++m)
#pragma unroll
                for (int n = 0; n < 4; ++n) acc[sb][m][n] = (f32x4){0.f, 0.f, 0.f, 0.f};
        f32x4 br0[4], br1[4];
#define M3_LOADB(dst, kt) do { const float* _w = wsrc + (size_t)((kt) * 32) * ldb; asm volatile("" : "+s"(_w));     \
        _Pragma("unroll") for (int _i = 0; _i < 4; ++_i) { const float* _q = _w + (size_t)(8 * _i) * ldb; asm volatile("global_load_dwordx4 %0, %1, %2" : "=v"(dst[_i]) : "v"(bvoff), "s"(_q) : "memory"); } } while (0)
#define M3_WAIT(N, r) asm volatile("s_waitcnt vmcnt(" #N ") lgkmcnt(0)" : "+v"(r[0]), "+v"(r[1]), "+v"(r[2]), "+v"(r[3]) :: "memory")
#define M3_WRITEB(src, st) do { _Pragma("unroll") for (int _i = 0; _i < 4; ++_i) { u32x2 _w; _w.x = cvt_pk_bf16(src[_i].x, src[_i].y); _w.y = cvt_pk_bf16(src[_i].z, src[_i].w); \
        *(LAS u32x2*)(ring + BBASE + (st) * BSTG + _i * 4096 + ((_i & 1) ? (bw0 ^ 128u) : bw0)) = _w; } } while (0)
#define M3_DMAA(kt, st) do { _Pragma("unroll") for (int _s = 0; _s < 2; ++_s) \
        __builtin_amdgcn_global_load_lds((const unsigned*)(abase + (size_t)(kt) * 64 + va[_s]), (LAS unsigned*)(ring + (st) * ASTG + _s * ASUB + ldsw), 16, 0, 0); } while (0)
#define M3_BOFF(nt) (GU ? ((boffr0 ^ (32u * ((nt) & 1))) + 256u * ((nt) >> 1)) : (boffr0 ^ (32u * (nt))))
#define M3_READ(sa, sbf) do { \
        { const unsigned _b = (unsigned)(size_t)(ring + BBASE + (sbf) * BSTG); s16x4 _l0, _h0, _l1, _h1, _l2, _h2, _l3, _h3; \
            asm volatile("ds_read_b64_tr_b16 %0, %8\n\tds_read_b64_tr_b16 %1, %8 offset:2048\n\tds_read_b64_tr_b16 %2, %9\n\tds_read_b64_tr_b16 %3, %9 offset:2048\n\t" \
                         "ds_read_b64_tr_b16 %4, %10\n\tds_read_b64_tr_b16 %5, %10 offset:2048\n\tds_read_b64_tr_b16 %6, %11\n\tds_read_b64_tr_b16 %7, %11 offset:2048" \
                         : "=&v"(_l0), "=&v"(_h0), "=&v"(_l1), "=&v"(_h1), "=&v"(_l2), "=&v"(_h2), "=&v"(_l3), "=&v"(_h3) \
                         : "v"(_b + M3_BOFF(0)), "v"(_b + M3_BOFF(1)), "v"(_b + M3_BOFF(2)), "v"(_b + M3_BOFF(3)) : "memory"); \
            Bf[0] = __builtin_shufflevector(_l0, _h0, 0, 1, 2, 3, 4, 5, 6, 7); Bf[1] = __builtin_shufflevector(_l1, _h1, 0, 1, 2, 3, 4, 5, 6, 7); \
            Bf[2] = __builtin_shufflevector(_l2, _h2, 0, 1, 2, 3, 4, 5, 6, 7); Bf[3] = __builtin_shufflevector(_l3, _h3, 0, 1, 2, 3, 4, 5, 6, 7); } \
        _Pragma("unroll") for (int m = 0; m < 4; ++m) Af[m] = *(const LAS bf16x8*)(ring + (sa) * ASTG + aoff + m * 1024); \
        if (nsub == 2) { _Pragma("unroll") for (int m = 0; m < 4; ++m) Ag[m] = *(const LAS bf16x8*)(ring + (sa) * ASTG + ASUB + aoff + m * 1024); } } while (0)
#define M3_PIN() asm volatile("" : "+v"(Bf[0]), "+v"(Bf[1]), "+v"(Bf[2]), "+v"(Bf[3]), "+v"(Af[0]), "+v"(Af[1]), "+v"(Af[2]), "+v"(Af[3]), "+v"(Ag[0]), "+v"(Ag[1]), "+v"(Ag[2]), "+v"(Ag[3]) :: "memory")
#define M3_MMA() do { __builtin_amdgcn_s_setprio(1); \
        _Pragma("unroll") for (int m = 0; m < 4; ++m) _Pragma("unroll") for (int n = 0; n < 4; ++n) acc[0][m][n] = MFMA16(Bf[n], Af[m], acc[0][m][n]); \
        if (nsub == 2) { _Pragma("unroll") for (int m = 0; m < 4; ++m) _Pragma("unroll") for (int n = 0; n < 4; ++n) acc[1][m][n] = MFMA16(Bf[n], Ag[m], acc[1][m][n]); } \
        __builtin_amdgcn_s_setprio(0); } while (0)
#define M3_BAR() do { asm volatile("" ::: "memory"); __builtin_amdgcn_s_barrier(); asm volatile("" ::: "memory"); __builtin_amdgcn_sched_barrier(0); } while (0)
        bf16x8 Bf[4], Af[4], Ag[4];
#pragma unroll
        for (int m = 0; m < 4; ++m) Ag[m] = (bf16x8){0, 0, 0, 0, 0, 0, 0, 0};
        M3_LOADB(br0, 0); M3_LOADB(br1, 1); M3_DMAA(0, 0); M3_DMAA(1, 1);
        M3_WAIT(8, br0);
        M3_WRITEB(br0, 0);
        __builtin_amdgcn_sched_barrier(0);
        M3_LOADB(br0, 2);
        M3_WAIT(6, br1);
        M3_BAR();
        if (wr == 1) M3_BAR();
#pragma unroll
        for (int kt = 0; kt < nk; ++kt) {
            M3_READ(kt % NAST, kt & 1);
            if (kt + 1 < nk) { if ((kt & 1) == 0) M3_WRITEB(br1, 1); else M3_WRITEB(br0, 0); }
            if (kt + 2 < nk) M3_DMAA(kt + 2, (kt + 2) % NAST);
            __builtin_amdgcn_sched_barrier(0);
            if (kt + 3 < nk) { if ((kt & 1) == 0) M3_LOADB(br1, kt + 3); else M3_LOADB(br0, kt + 3); }
            __builtin_amdgcn_sched_barrier(0);
            if ((kt & 1) == 0) { if (kt + 3 < nk) M3_WAIT(6, br0); else if (kt + 2 < nk) M3_WAIT(2, br0); else M3_WAIT(0, br0); }
            else               { if (kt + 3 < nk) M3_WAIT(6, br1); else if (kt + 2 < nk) M3_WAIT(2, br1); else M3_WAIT(0, br1); }
            M3_PIN();
            M3_BAR();
            M3_MMA();
            M3_BAR();
        }
        if (wr == 0) M3_BAR();
#undef M3_LOADB
#undef M3_WAIT
#undef M3_WRITEB
#undef M3_DMAA
#undef M3_BOFF
#undef M3_READ
#undef M3_PIN
#undef M3_MMA
#undef M3_BAR
        int t2_ = threadIdx.x; asm volatile("" : "+v"(t2_)); const int fre = t2_ & 15, fqe = (t2_ & 63) >> 4;
        if (MODE == 2) {
            float* pbuf = (float*)(a.ws + WS_Z) + ((size_t)(vcu >> 1) * 8 + (t2_ >> 6)) * (32 * 256) + (t2_ & 63) * 4;
            gu32* pflag = (gu32*)(a.ws + WS_CTL) + CW_PFLAG + (L * 128 + (vcu >> 1)) * 32;
            if (khalf == 1) {
#pragma unroll
                for (int sb = 0; sb < 2; ++sb) if (sb < nsub) {
#pragma unroll
                    for (int m = 0; m < 4; ++m)
#pragma unroll
                        for (int n = 0; n < 4; ++n) { float* q_ = pbuf + ((sb * 4 + m) * 4 + n) * 256; asm volatile("global_store_dwordx4 %0, %1, off sc1\n\ts_nop 1" :: "v"(q_), "v"(acc[sb][m][n]) : "memory"); } }
                asm volatile("s_waitcnt vmcnt(0)" ::: "memory");
                if ((t2_ & 63) == 0) __hip_atomic_fetch_add(pflag, 1u, RLX_AGENT);
                break;
            }
            if ((t2_ >> 6) == 0) { unsigned sp = 0;
              while (__hip_atomic_load(pflag, RLX_AGENT) < 8u) { __builtin_amdgcn_s_sleep(1); if (++sp > (1u << 22)) { if ((t2_ & 63) == 0) __hip_atomic_store(tmo, 1u, RLX_AGENT); break; } }
              __builtin_amdgcn_fence(__ATOMIC_ACQUIRE, "agent"); asm volatile("s_waitcnt vmcnt(0)" ::: "memory"); }
            __syncthreads();
#pragma unroll
            for (int sb = 0; sb < 2; ++sb) if (sb < nsub) {
#pragma unroll
                for (int m = 0; m < 4; ++m)
#pragma unroll
                    for (int n = 0; n < 4; ++n) acc[sb][m][n] += *(const f32x4*)(pbuf + ((sb * 4 + m) * 4 + n) * 256); }
        }
#pragma unroll
        for (int sb = 0; sb < 2; ++sb) if (sb < nsub) {
            if (GU) {
                bf16* H = (bf16*)(a.ws + WS_HP);
#pragma unroll
                for (int m = 0; m < 4; ++m)
#pragma unroll
                    for (int nt = 0; nt < 2; ++nt) { const f32x4 g = acc[sb][m][nt], up = acc[sb][m][nt + 2]; f32x4 hh;
                        hh.x = g.x * fast_rcp(1.f + fast_exp2(g.x * -1.4426950408889634f)) * up.x; hh.y = g.y * fast_rcp(1.f + fast_exp2(g.y * -1.4426950408889634f)) * up.y;
                        hh.z = g.z * fast_rcp(1.f + fast_exp2(g.z * -1.4426950408889634f)) * up.z; hh.w = g.w * fast_rcp(1.f + fast_exp2(g.w * -1.4426950408889634f)) * up.w;
                        bf16* hp_ = H + (size_t)(prow0 + 128 * sb + 64 * wr + 16 * m + fre) * FE + 128 * pn + 32 * wc + 16 * nt + 4 * fqe;
                        const unsigned long long pk_ = (unsigned long long)cvt_pk_bf16(hh.x, hh.y) | ((unsigned long long)cvt_pk_bf16(hh.z, hh.w) << 32);
                        __hip_atomic_store((GAS unsigned long long*)hp_, pk_, RLX_AGENT); }
            } else {
                bf16* Y = (bf16*)(a.ws + WS_YP);
#pragma unroll
                for (int m = 0; m < 4; ++m)
#pragma unroll
                    for (int nt = 0; nt < 4; nt += 2) {
                        const f32x4 va_ = acc[sb][m][nt], vb_ = acc[sb][m][nt + 1];
                        const unsigned ax = cvt_pk_bf16(va_.x, va_.y), ay = cvt_pk_bf16(va_.z, va_.w), bx = cvt_pk_bf16(vb_.x, vb_.y), by = cvt_pk_bf16(vb_.z, vb_.w);
                        const auto sx = __builtin_amdgcn_permlane16_swap(ax, bx, false, false), sy = __builtin_amdgcn_permlane16_swap(ay, by, false, false);
                        u32x4 w; w.x = sx[0]; w.y = sy[0]; w.z = sx[1]; w.w = sy[1];
                        *(u32x4*)(Y + (size_t)(prow0 + 128 * sb + 64 * wr + 16 * m + fre) * D + 256 * pn + 64 * wc + 16 * (nt + (fqe & 1)) + 4 * (fqe & 2)) = w; }
            }
        }
        if (GU) { asm volatile("s_waitcnt vmcnt(0)" ::: "memory"); if ((t2_ & 63) == 0) __hip_atomic_fetch_add(done + pair * DONE_STRIDE, 1u, RLX_AGENT); }
    }
}
}

__device__ __forceinline__ void ln_finish(f32x4 (&v)[8], const float* g, const float* b, float* xo, bf16* xbo, int lane) {
    float s = 0.f;
#pragma unroll
    for (int j = 0; j < 8; ++j) s += (v[j].x + v[j].y) + (v[j].z + v[j].w);
    const float mean = wave_sum(s) * (1.f / D); float s2 = 0.f;
#pragma unroll
    for (int j = 0; j < 8; ++j) { v[j] = v[j] - mean; s2 += (v[j].x * v[j].x + v[j].y * v[j].y) + (v[j].z * v[j].z + v[j].w * v[j].w); }
    const float rstd = 1.f / sqrtf(wave_sum(s2) * (1.f / D) + LN_EPS);
#pragma unroll
    for (int j = 0; j < 8; ++j) {
        const f32x4 gg = *(const f32x4*)(g + 256 * j + 4 * lane), bb = *(const f32x4*)(b + 256 * j + 4 * lane);
        const f32x4 y = v[j] * rstd * gg + bb;
        if (xo) *(f32x4*)(xo + 256 * j + 4 * lane) = y;
        if (xbo) { u32x2 w; w.x = cvt_pk_bf16(y.x, y.y); w.y = cvt_pk_bf16(y.z, y.w); *(u32x2*)(xbo + 256 * j + 4 * lane) = w; }
    }
}
__device__ __forceinline__ void ln_finish_r(f32x4 (&v)[8], const f32x4 (&G)[8], const f32x4 (&B)[8], float* xo, bf16* xbo, int lane) {
    float s = 0.f;
#pragma unroll
    for (int j = 0; j < 8; ++j) s += (v[j].x + v[j].y) + (v[j].z + v[j].w);
    const float mean = wave_sum(s) * (1.f / D); float s2 = 0.f;
#pragma unroll
    for (int j = 0; j < 8; ++j) { v[j] = v[j] - mean; s2 += (v[j].x * v[j].x + v[j].y * v[j].y) + (v[j].z * v[j].z + v[j].w * v[j].w); }
    const float rstd = 1.f / sqrtf(wave_sum(s2) * (1.f / D) + LN_EPS);
#pragma unroll
    for (int j = 0; j < 8; ++j) {
        const f32x4 y = v[j] * rstd * G[j] + B[j];
        if (xo) *(f32x4*)(xo + 256 * j + 4 * lane) = y;
        if (xbo) { u32x2 w; w.x = cvt_pk_bf16(y.x, y.y); w.y = cvt_pk_bf16(y.z, y.w); *(u32x2*)(xbo + 256 * j + 4 * lane) = w; }
    }
}
__device__ __forceinline__ void ln_finish_r8(f32x4 (&v)[8], const f32x4 (&G)[8], const f32x4 (&B)[8], float* xo, bf16* xbo, int lane) {
    float s = 0.f;
#pragma unroll
    for (int j = 0; j < 8; ++j) s += (v[j].x + v[j].y) + (v[j].z + v[j].w);
    const float mean = wave_sum(s) * (1.f / D); float s2 = 0.f;
#pragma unroll
    for (int j = 0; j < 8; ++j) { v[j] = v[j] - mean; s2 += (v[j].x * v[j].x + v[j].y * v[j].y) + (v[j].z * v[j].z + v[j].w * v[j].w); }
    const float rstd = 1.f / sqrtf(wave_sum(s2) * (1.f / D) + LN_EPS);
#pragma unroll
    for (int j = 0; j < 4; ++j) {
        const f32x4 y0 = v[2 * j] * rstd * G[2 * j] + B[2 * j], y1 = v[2 * j + 1] * rstd * G[2 * j + 1] + B[2 * j + 1];
        if (xo) { *(f32x4*)(xo + 512 * j + 8 * lane) = y0; *(f32x4*)(xo + 512 * j + 8 * lane + 4) = y1; }
        if (xbo) { u32x4 w; w.x = cvt_pk_bf16(y0.x, y0.y); w.y = cvt_pk_bf16(y0.z, y0.w); w.z = cvt_pk_bf16(y1.x, y1.y); w.w = cvt_pk_bf16(y1.z, y1.w); *(u32x4*)(xbo + 512 * j + 8 * lane) = w; }
    }
}
__device__ __forceinline__ f32x4 ld_bf16x4(const bf16* p) { const u32x2 h = *(const u32x2*)p; return (f32x4){bf_lo(h.x), bf_hi(h.x), bf_lo(h.y), bf_hi(h.y)}; }

__device__ __forceinline__ void ln_mix(const ArgsP& a, const Ctx& c, int L) {
    const float* xin = (L == 0) ? a.in[I_X] : (const float*)(a.ws + WS_X);
    float* xout = (float*)(a.ws + WS_X); bf16* xb = (bf16*)(a.ws + WS_XB); const bf16* hm = (const bf16*)(a.ws + WS_HMIX);
    for (int row = c.gw; row < M; row += c.NGW) {
        f32x4 v[8];
#pragma unroll
        for (int j = 0; j < 8; ++j) { const size_t o = (size_t)row * D + 256 * j + 4 * c.lane; v[j] = ALPHA * *(const f32x4*)(xin + o) + ld_bf16x4(hm + o); }
        ln_finish(v, a.in[I_MLNG] + L * D, a.in[I_MLNB] + L * D, xout + (size_t)row * D, xb + (size_t)row * D, c.lane);
    }
}
__device__ __forceinline__ void ln_ffn(const ArgsP& a, const Ctx& c, int L) {
    LAS int* tab = (LAS int*)(c.lds + TAB_OFF);
    const float* xin = (const float*)(a.ws + WS_X); float* xout = (L == DEPTH - 1) ? (float*)a.out : (float*)(a.ws + WS_X);
    bf16* xb = (bf16*)(a.ws + WS_XB); const bf16* yp = (const bf16*)(a.ws + WS_YP);
    const int* te = (const int*)(a.ws + WS_TOK); const int* tp = te + 2 * M; const float* tw = (const float*)(tp + 2 * M);
#define LNF_IDX(r, E0, E1, P0, P1, W0, W1) do { E0 = te[2 * (r)]; E1 = te[2 * (r) + 1]; P0 = tp[2 * (r)]; P1 = tp[2 * (r) + 1]; W0 = tw[2 * (r)]; W1 = tw[2 * (r) + 1]; } while (0)
#define LNF_LOAD(r, E0, E1, P0, P1, XR, Y0, Y1) do { const size_t _r0 = (size_t)(MOE_TR * tab[TB_BASE + E0] + P0), _r1 = (size_t)(MOE_TR * tab[TB_BASE + E1] + P1); \
        _Pragma("unroll") for (int j = 0; j < 4; ++j) { const int o = 512 * j + 8 * c.lane; XR[j] = *(const u32x4*)(xb + (size_t)(r) * D + o); Y0[j] = *(const u32x4*)(yp + _r0 * D + o); Y1[j] = *(const u32x4*)(yp + _r1 * D + o); } } while (0)
    int row = c.gw;
    if (row >= M) return;
    f32x4 G[8], B[8];
#pragma unroll
    for (int j = 0; j < 8; ++j) { const int o = 512 * (j >> 1) + 8 * c.lane + 4 * (j & 1); G[j] = *(const f32x4*)(a.in[I_FLNG] + L * D + o); B[j] = *(const f32x4*)(a.in[I_FLNB] + L * D + o); }
    int e0, e1, p0, p1, ne0 = 0, ne1 = 0, np0 = 0, np1 = 0; float w0, w1, nw0 = 0.f, nw1 = 0.f;
    u32x4 X[4], Y0[4], Y1[4];
    LNF_IDX(row, e0, e1, p0, p1, w0, w1);
    LNF_LOAD(row, e0, e1, p0, p1, X, Y0, Y1);
    if (row + c.NGW < M) LNF_IDX(row + c.NGW, ne0, ne1, np0, np1, nw0, nw1);
    for (;;) {
        const int nrow = row + c.NGW; const bool hn = nrow < M;
        u32x4 NX_[4], NY0[4], NY1[4]; int fe0 = 0, fe1 = 0, fp0 = 0, fp1 = 0; float fw0 = 0.f, fw1 = 0.f;
        if (hn) { LNF_LOAD(nrow, ne0, ne1, np0, np1, NX_, NY0, NY1); if (nrow + c.NGW < M) LNF_IDX(nrow + c.NGW, fe0, fe1, fp0, fp1, fw0, fw1); }
        f32x4 v[8];
#pragma unroll
        for (int j = 0; j < 4; ++j) { const int o = 512 * j + 8 * c.lane;
            const f32x4 xa = RES_BF16 ? (f32x4){bf_lo(X[j].x), bf_hi(X[j].x), bf_lo(X[j].y), bf_hi(X[j].y)} : *(const f32x4*)(xin + (size_t)row * D + o);
            const f32x4 xc = RES_BF16 ? (f32x4){bf_lo(X[j].z), bf_hi(X[j].z), bf_lo(X[j].w), bf_hi(X[j].w)} : *(const f32x4*)(xin + (size_t)row * D + o + 4);
            v[2 * j] = ALPHA * xa + w0 * (f32x4){bf_lo(Y0[j].x), bf_hi(Y0[j].x), bf_lo(Y0[j].y), bf_hi(Y0[j].y)} + w1 * (f32x4){bf_lo(Y1[j].x), bf_hi(Y1[j].x), bf_lo(Y1[j].y), bf_hi(Y1[j].y)};
            v[2 * j + 1] = ALPHA * xc + w0 * (f32x4){bf_lo(Y0[j].z), bf_hi(Y0[j].z), bf_lo(Y0[j].w), bf_hi(Y0[j].w)} + w1 * (f32x4){bf_lo(Y1[j].z), bf_hi(Y1[j].z), bf_lo(Y1[j].w), bf_hi(Y1[j].w)}; }
        ln_finish_r8(v, G, B, (RES_BF16 && L != DEPTH - 1) ? (float*)nullptr : xout + (size_t)row * D, (L == DEPTH - 1) ? (bf16*)nullptr : xb + (size_t)row * D, c.lane);
        if (!hn) break;
        row = nrow; w0 = nw0; w1 = nw1; ne0 = fe0; ne1 = fe1; np0 = fp0; np1 = fp1; nw0 = fw0; nw1 = fw1;
#pragma unroll
        for (int j = 0; j < 4; ++j) { X[j] = NX_[j]; Y0[j] = NY0[j]; Y1[j] = NY1[j]; }
    }
#undef LNF_IDX
#undef LNF_LOAD
}

__device__ __forceinline__ void route_select(const ArgsP& a, int L, int tok, int fr, int fq, f32x4 a0, f32x4 a1, f32x4 a2) {
    int* te = (int*)(a.ws + WS_TOK); int* tp = te + 2 * M; float* tw = (float*)(tp + 2 * M); int* list = (int*)(a.ws + WS_LIST);
    gu32* cnt = (gu32*)(a.ws + WS_CTL) + CW_CNT + L * 32 * CNT_STRIDE;
    f32x4 acc[3] = {a0, a1, a2};
    const float* be = a.in[I_BER] + (L * NGRP + fq) * NEXP;
    float el[8];
    el[0] = acc[0].x + be[0]; el[1] = acc[0].y + be[1]; el[2] = acc[0].z + be[2]; el[3] = acc[0].w + be[3];
    el[4] = acc[1].x + be[4]; el[5] = acc[1].y + be[5]; el[6] = acc[1].z + be[6]; el[7] = acc[1].w + be[7];
    const float gl = acc[2].x + a.in[I_BGR][L * NGRP + fq];
    int i1 = 0; float v1 = el[0];
#pragma unroll
    for (int e = 1; e < 8; ++e) if (el[e] > v1) { v1 = el[e]; i1 = e; }
    int i2 = -1; float v2 = -INFINITY;
#pragma unroll
    for (int e = 0; e < 8; ++e) if (e != i1 && el[e] > v2) { v2 = el[e]; i2 = e; }
    float one_ = 1.f; asm volatile("" : "+v"(one_));
    const float tw1 = one_ / (one_ + __expf(v2 - v1)), tw2 = one_ - tw1;
    float gls[4];
#pragma unroll
    for (int r = 0; r < 4; ++r) gls[r] = __shfl(gl, fr + 16 * r);
    int gs = 0; float gm = gls[0];
#pragma unroll
    for (int r = 1; r < 4; ++r) if (gls[r] > gm) { gm = gls[r]; gs = r; }
    float den = 0.f;
#pragma unroll
    for (int r = 0; r < 4; ++r) den += __expf(gls[r] - gm);
    const float pg = 1.f / den;
    if (fq == gs) {
        const int e0 = 8 * gs + i1, e1 = 8 * gs + i2;
        const int p0 = (int)__hip_atomic_fetch_add(cnt + e0 * CNT_STRIDE, 1u, RLX_AGENT), p1 = (int)__hip_atomic_fetch_add(cnt + e1 * CNT_STRIDE, 1u, RLX_AGENT);
        list[e0 * M + p0] = 2 * tok; list[e1 * M + p1] = 2 * tok + 1;
        te[2 * tok] = e0; te[2 * tok + 1] = e1; tp[2 * tok] = p0; tp[2 * tok + 1] = p1; tw[2 * tok] = pg * tw1; tw[2 * tok + 1] = pg * tw2;
    }
}

constexpr int LNR_PITCH = 2 * D + 16, LNR_PART_OFF = 16 * LNR_PITCH;
__device__ __forceinline__ void ln_mix_router(const ArgsP& a, const Ctx& c, int L) {
    const float* xin = (L == 0) ? a.in[I_X] : (const float*)(a.ws + WS_X);
    float* xout = (float*)(a.ws + WS_X); bf16* xb = (bf16*)(a.ws + WS_XB); const bf16* hm = (const bf16*)(a.ws + WS_HMIX);
    const bf16* wr = (const bf16*)(a.ws + WS_WR) + (size_t)L * 48 * D;
    const float* g = a.in[I_MLNG] + L * D; const float* bta = a.in[I_MLNB] + L * D;
    LAS unsigned char* T = c.lds + RING_OFF; LAS f32x4* Pp = (LAS f32x4*)(c.lds + RING_OFF + LNR_PART_OFF);
    const int lane = c.lane, w = c.wave, fr = lane & 15, fq = lane >> 4;
    if ((int)blockIdx.x >= M / 16) return;
    LAS f32x4* GBl = (LAS f32x4*)(c.lds + RING_OFF + 98304);
    u32x2 RX[8], RH[8];
    { const size_t row = (size_t)16 * blockIdx.x + 2 * w;
#pragma unroll
      for (int j = 0; j < 8; ++j) { const size_t o = row * D + 256 * j + 4 * lane; RX[j] = *(const u32x2*)(xb + o); RH[j] = *(const u32x2*)(hm + o); } }
    for (int i = c.tid; i < D / 4; i += NTHREADS) { GBl[i] = ((const f32x4*)g)[i]; GBl[D / 4 + i] = ((const f32x4*)bta)[i]; }
    __syncthreads();
    for (int grp = blockIdx.x; grp < M / 16; grp += gridDim.x) {
#pragma unroll
        for (int rr = 0; rr < 2; ++rr) {
            const int rl = 2 * w + rr; const size_t row = (size_t)16 * grp + rl;
            const size_t nrow = rr == 0 ? row + 1 : (size_t)16 * (grp + gridDim.x) + 2 * w; const bool hn = rr == 0 || (grp + (int)gridDim.x) < M / 16;
            u32x2 NX_[8], NH[8];
            if (hn) {
#pragma unroll
                for (int j = 0; j < 8; ++j) { const size_t o = nrow * D + 256 * j + 4 * lane; NX_[j] = *(const u32x2*)(xb + o); NH[j] = *(const u32x2*)(hm + o); } }
            f32x4 v[8]; float s1 = 0.f;
#pragma unroll
            for (int j = 0; j < 8; ++j) { const size_t o = row * D + 256 * j + 4 * lane;
                const f32x4 xr = RES_BF16 ? (f32x4){bf_lo(RX[j].x), bf_hi(RX[j].x), bf_lo(RX[j].y), bf_hi(RX[j].y)} : *(const f32x4*)(xin + o);
                v[j] = ALPHA * xr + (f32x4){bf_lo(RH[j].x), bf_hi(RH[j].x), bf_lo(RH[j].y), bf_hi(RH[j].y)}; s1 += (v[j].x + v[j].y) + (v[j].z + v[j].w); }
            const float mean = wave_sum(s1) * (1.f / D); float s2 = 0.f;
#pragma unroll
            for (int j = 0; j < 8; ++j) { v[j] = v[j] - mean; s2 += (v[j].x * v[j].x + v[j].y * v[j].y) + (v[j].z * v[j].z + v[j].w * v[j].w); }
            const float rstd = 1.f / sqrtf(wave_sum(s2) * (1.f / D) + LN_EPS);
#pragma unroll
            for (int j = 0; j < 8; ++j) {
                const f32x4 gg = GBl[256 * j / 4 + lane], bb = GBl[D / 4 + 256 * j / 4 + lane];
                const f32x4 y = v[j] * rstd * gg + bb;
                if (!RES_BF16) *(f32x4*)(xout + row * D + 256 * j + 4 * lane) = y;
                u32x2 pk; pk.x = cvt_pk_bf16(y.x, y.y); pk.y = cvt_pk_bf16(y.z, y.w);
                *(u32x2*)(xb + row * D + 256 * j + 4 * lane) = pk;
                *(LAS u32x2*)(T + rl * LNR_PITCH + (256 * j + 4 * lane) * 2) = pk;
            }
            if (hn) {
#pragma unroll
                for (int j = 0; j < 8; ++j) { RX[j] = NX_[j]; RH[j] = NH[j]; } }
        }
        bf16x8 wa[3][8];
#pragma unroll
        for (int nt = 0; nt < 3; ++nt)
#pragma unroll
            for (int s_ = 0; s_ < 8; ++s_) wa[nt][s_] = *(const bf16x8*)(wr + (size_t)(16 * nt + fr) * D + 256 * w + 32 * s_ + 8 * fq);
        __syncthreads();
        f32x4 acc[3];
#pragma unroll
        for (int i = 0; i < 3; ++i) acc[i] = (f32x4){0.f, 0.f, 0.f, 0.f};
#pragma unroll
        for (int s_ = 0; s_ < 8; ++s_) {
            const bf16x8 fb = *(const LAS bf16x8*)(T + fr * LNR_PITCH + (256 * w + 32 * s_ + 8 * fq) * 2);
            acc[0] = MFMA16(wa[0][s_], fb, acc[0]); acc[1] = MFMA16(wa[1][s_], fb, acc[1]); acc[2] = MFMA16(wa[2][s_], fb, acc[2]);
        }
#pragma unroll
        for (int nt = 0; nt < 3; ++nt) Pp[(w * 3 + nt) * 64 + lane] = acc[nt];
        __syncthreads();
        if (w == 0) {
            f32x4 t0 = Pp[lane], t1 = Pp[64 + lane], t2 = Pp[128 + lane];
#pragma unroll
            for (int ww = 1; ww < 8; ++ww) { t0 += Pp[(ww * 3 + 0) * 64 + lane]; t1 += Pp[(ww * 3 + 1) * 64 + lane]; t2 += Pp[(ww * 3 + 2) * 64 + lane]; }
            route_select(a, L, 16 * grp + fr, fr, fq, t0, t1, t2);
        }
    }
}

__device__ __forceinline__ void router(const ArgsP& a, const Ctx& c, int L) {
    const bf16* xb = (const bf16*)(a.ws + WS_XB); const bf16* wr = (const bf16*)(a.ws + WS_WR) + (size_t)L * 48 * D;
    int* te = (int*)(a.ws + WS_TOK); int* tp = te + 2 * M; float* tw = (float*)(tp + 2 * M); int* list = (int*)(a.ws + WS_LIST);
    gu32* cnt = (gu32*)(a.ws + WS_CTL) + CW_CNT + L * 32 * CNT_STRIDE;
    const int fr = c.lane & 15, fq = c.lane >> 4;
    for (int task = c.gw; task < M / 16; task += c.NGW) {
        const int tok = task * 16 + fr;
        f32x4 acc[3];
#pragma unroll
        for (int i = 0; i < 3; ++i) acc[i] = (f32x4){0.f, 0.f, 0.f, 0.f};
        const bf16* bp = xb + (size_t)tok * D + 8 * fq; const bf16* ap = wr + (size_t)fr * D + 8 * fq;
        for (int k = 0; k < D; k += 32) {
            const bf16x8 fb = *(const bf16x8*)(bp + k);
            const bf16x8 a0 = *(const bf16x8*)(ap + k), a1 = *(const bf16x8*)(ap + (size_t)16 * D + k), a2 = *(const bf16x8*)(ap + (size_t)32 * D + k);
            acc[0] = MFMA16(a0, fb, acc[0]); acc[1] = MFMA16(a1, fb, acc[1]); acc[2] = MFMA16(a2, fb, acc[2]);
        }
        route_select(a, L, tok, fr, fq, acc[0], acc[1], acc[2]);
    }
}

__device__ __forceinline__ void gm_stats(const ArgsP& a, const Ctx& c) {
    const bf16* z = (const bf16*)(a.ws + WS_Z); f32x2* st = (f32x2*)(a.ws + WS_STAT);
    for (int row = c.gw; row < M; row += c.NGW) {
        const bf16* p = z + (size_t)row * GF + GH;
        u32x4 h[12]; float s = 0.f;
#pragma unroll
        for (int j = 0; j < 12; ++j) { h[j] = *(const u32x4*)(p + (j * 64 + c.lane) * 8);
            s += (bf_lo(h[j].x) + bf_hi(h[j].x)) + (bf_lo(h[j].y) + bf_hi(h[j].y)) + (bf_lo(h[j].z) + bf_hi(h[j].z)) + (bf_lo(h[j].w) + bf_hi(h[j].w)); }
        const float mean = wave_sum(s) * (1.f / GH); float q = 0.f;
#pragma unroll
        for (int j = 0; j < 12; ++j) {
            float d;
            d = bf_lo(h[j].x) - mean; q += d * d; d = bf_hi(h[j].x) - mean; q += d * d; d = bf_lo(h[j].y) - mean; q += d * d; d = bf_hi(h[j].y) - mean; q += d * d;
            d = bf_lo(h[j].z) - mean; q += d * d; d = bf_hi(h[j].z) - mean; q += d * d; d = bf_lo(h[j].w) - mean; q += d * d; d = bf_hi(h[j].w) - mean; q += d * d;
        }
        const float rstd = 1.f / sqrtf(wave_sum(q) * (1.f / GH) + LN_EPS);
        if (c.lane == 0) st[row] = (f32x2){mean, rstd};
    }
}
__device__ __forceinline__ void gm_spatial_simple(const ArgsP& a, const Ctx& c, int j) {
    const bf16* z = (const bf16*)(a.ws + WS_Z); const f32x2* st = (const f32x2*)(a.ws + WS_STAT); bf16* gt = (bf16*)(a.ws + WS_GATED);
    const float* wsp = a.in[I_WSP] + (size_t)j * GG * CH * CH; const float* bsp = a.in[I_BSP] + j * GG * CH;
    const float* lg = a.in[I_VLNG] + j * GH; const float* lb = a.in[I_VLNB] + j * GH;
    const int gtid = blockIdx.x * NTHREADS + c.tid, GT = gridDim.x * NTHREADS;
    for (int i = gtid; i < M * GH; i += GT) {
        const int row = i / GH, ch = i % GH, g = ch / GD, t = row & (CH - 1), cb = row - t;
        const float gam = lg[ch], bet = lb[ch]; const float* w = wsp + ((size_t)g * CH + t) * CH;
        float acc = 0.f;
        for (int s = 0; s <= t; ++s) { const f32x2 ms = st[cb + s]; const float vn = (bf2f(z[(size_t)(cb + s) * GF + GH + ch]) - ms.x) * ms.y * gam + bet; acc += w[s] * vn; }
        const float o = bf2f(z[(size_t)row * GF + ch]) * (acc + bsp[g * CH + t]);
        gt[i] = (bf16)(cvt_pk_bf16(o, 0.f) & 0xffffu);
    }
}

__device__ __forceinline__ void attn_simple(const ArgsP& a, const Ctx& c) {
    const bf16* Q = (const bf16*)(a.ws + WS_Q); const bf16* Kp = (const bf16*)(a.ws + WS_K); const bf16* V = (const bf16*)(a.ws + WS_V); bf16* O = (bf16*)(a.ws + WS_O);
    for (int task = c.gw; task < NB * NH * SEQ; task += c.NGW) {
        const int t = task % SEQ, h = (task / SEQ) % NH, b = task / (SEQ * NH);
        const size_t col = (size_t)h * HD + 2 * c.lane;
        const unsigned qq = *(const unsigned*)(Q + (size_t)(b * SEQ + t) * D + col); const float q0 = bf_lo(qq), q1 = bf_hi(qq);
        float C = 1.f, o0 = 0.f, o1 = 0.f;
        for (int s = t - 1; s >= 0; --s) {
            const size_t off = (size_t)(b * SEQ + s) * D + col;
            const unsigned kk = *(const unsigned*)(Kp + off), vv = *(const unsigned*)(V + off);
            float z = wave_sum(q0 * bf_lo(kk) + q1 * bf_hi(kk));
            z = fminf(fmaxf(z, -120.f), 120.f);
            const float e = fast_exp2(-z), beta = fast_rcp(1.f + e), P = beta * C;
            C *= e * beta;
            o0 += P * bf_lo(vv); o1 += P * bf_hi(vv);
        }
        *(unsigned*)(O + (size_t)(b * SEQ + t) * D + col) = cvt_pk_bf16(o0, o1);
    }
}

#ifndef ATT_EARLY_EXIT
#define ATT_EARLY_EXIT 1
#endif
typedef float f32x16 __attribute__((ext_vector_type(16)));
#define MFMA32(a, b, c) __builtin_amdgcn_mfma_f32_32x32x16_bf16((a), (b), (c), 0, 0, 0)
__device__ __forceinline__ int swz16(int row) { return ((row & 3) << 2) | ((row >> 2) & 3); }
__device__ __forceinline__ void attn_fast(const ArgsP& a, const Ctx& c) {
    const bf16* Q = (const bf16*)(a.ws + WS_Q); const bf16* Kp = (const bf16*)(a.ws + WS_K); const bf16* V = (const bf16*)(a.ws + WS_V); bf16* O = (bf16*)(a.ws + WS_O);
    LAS unsigned char* vbuf = c.lds + RING_OFF + c.wave * 16384;
    const int lane = c.lane, r32 = lane & 31, h = lane >> 5, l4 = lane >> 4, i16 = lane & 15, q4 = i16 >> 2, p4 = i16 & 3, colhalf = l4 & 1;
    const int G = gridDim.x, bx = blockIdx.x, vcu = (G % 8 == 0) ? (bx % 8) * (G / 8) + bx / 8 : bx;
    for (int u = vcu * NWAVES + c.wave; u < NB * NH * (SEQ / 32); u += c.NGW) {
        const int qb = u % (SEQ / 32), bh = u / (SEQ / 32), b = bh / NH, hd = bh % NH, q0 = qb * 32;
        const size_t rowbase = (size_t)b * SEQ;
        const bf16* Qp = Q + (rowbase + q0 + r32) * D + hd * HD + 8 * h;
        const bf16* Kb = Kp + rowbase * D + hd * HD + 8 * h;
        const bf16* Vb = V + rowbase * D + hd * HD;
        bf16x8 qf[8], kf[8];
#pragma unroll
        for (int s = 0; s < 8; ++s) qf[s] = *(const bf16x8*)(Qp + 16 * s);
        f32x16 oacc[4];
#pragma unroll
        for (int d = 0; d < 4; ++d)
#pragma unroll
            for (int i = 0; i < 16; ++i) oacc[d][i] = 0.f;
        float C = 1.f;
        int jt = qb;
#pragma unroll
        for (int s = 0; s < 8; ++s) kf[s] = *(const bf16x8*)(Kb + (size_t)(32 * jt + r32) * D + 16 * s);
#pragma unroll
        for (int i = 0; i < 8; ++i) { const int row = 4 * i + l4, ch = i16 ^ ((l4 << 2) | (i & 3));
            __builtin_amdgcn_global_load_lds((const unsigned*)(Vb + (size_t)(32 * jt + row) * D + 8 * ch), (LAS unsigned*)(vbuf + i * 1024), 16, 0, 0); }
        for (int it = 0;; ++it) {
            LAS unsigned char* vb = vbuf + (it & 1) * 8192;
            f32x16 p;
#pragma unroll
            for (int i = 0; i < 16; ++i) p[i] = 0.f;
#pragma unroll
            for (int s = 0; s < 8; ++s) p = MFMA32(kf[s], qf[s], p);
            const int jn = jt > 0 ? jt - 1 : 0;
#pragma unroll
            for (int s = 0; s < 8; ++s) kf[s] = *(const bf16x8*)(Kb + (size_t)(32 * jn + r32) * D + 16 * s);
            float bet[16], mm[16];
#pragma unroll
            for (int i = 0; i < 16; ++i) { const float e = fast_exp2(fminf(-p[i], 100.f)); const float bb = fast_rcp(1.f + e); bet[i] = bb; mm[i] = e * bb; }
            if (it == 0) {
#pragma unroll
                for (int i = 0; i < 16; ++i) { const bool valid = ((i & 3) + 8 * (i >> 2) + 4 * h) < r32; bet[i] = valid ? bet[i] : 0.f; mm[i] = valid ? mm[i] : 1.f; }
            }
            float gpp[4];
#pragma unroll
            for (int g = 0; g < 4; ++g) { const float gp = (mm[4 * g] * mm[4 * g + 1]) * (mm[4 * g + 2] * mm[4 * g + 3]); gpp[g] = __shfl_xor(gp, 32); }
            float E = C, P[16];
#pragma unroll
            for (int g = 3; g >= 0; --g) {
                const float E1 = (h == 0) ? E * gpp[g] : E;
                const float x3 = E1, x2 = x3 * mm[4 * g + 3], x1 = x2 * mm[4 * g + 2], x0 = x1 * mm[4 * g + 1];
                P[4 * g + 3] = bet[4 * g + 3] * x3; P[4 * g + 2] = bet[4 * g + 2] * x2; P[4 * g + 1] = bet[4 * g + 1] * x1; P[4 * g] = bet[4 * g] * x0;
                const float E2 = x0 * mm[4 * g];
                E = (h == 1) ? E2 * gpp[g] : E2;
            }
            C = E;
            bf16x8 pf[2];
#pragma unroll
            for (int s = 0; s < 2; ++s) { u32x4 w; w.x = cvt_pk_bf16(P[8 * s], P[8 * s + 1]); w.y = cvt_pk_bf16(P[8 * s + 2], P[8 * s + 3]); w.z = cvt_pk_bf16(P[8 * s + 4], P[8 * s + 5]); w.w = cvt_pk_bf16(P[8 * s + 6], P[8 * s + 7]);
                pf[s] = __builtin_bit_cast(bf16x8, w); }
            asm volatile("s_waitcnt vmcnt(0)" ::: "memory");
            s16x4 tlo[4][2], thi[4][2];
#pragma unroll
            for (int db = 0; db < 4; ++db)
#pragma unroll
                for (int s = 0; s < 2; ++s) {
                    { const int row = 16 * s + 4 * h + q4, ch = 4 * db + 2 * colhalf + (p4 >> 1); tlo[db][s] = lds_tr_asm(vb + 256 * row + 16 * (ch ^ swz16(row)) + 8 * (p4 & 1)); }
                    { const int row = 16 * s + 8 + 4 * h + q4, ch = 4 * db + 2 * colhalf + (p4 >> 1); thi[db][s] = lds_tr_asm(vb + 256 * row + 16 * (ch ^ swz16(row)) + 8 * (p4 & 1)); }
                }
            asm volatile("s_waitcnt lgkmcnt(0)" ::: "memory");
#pragma unroll
            for (int db = 0; db < 4; ++db)
#pragma unroll
                for (int s = 0; s < 2; ++s) { asm volatile("" : "+v"(tlo[db][s]), "+v"(thi[db][s]));
                    oacc[db] = MFMA32(__builtin_shufflevector(tlo[db][s], thi[db][s], 0, 1, 2, 3, 4, 5, 6, 7), pf[s], oacc[db]);
                }
            bool done = (jt == 0);
#if ATT_EARLY_EXIT
            done = done || __all(C < 1e-37f);
#endif
            if (done) break;
            jt = jn;
            asm volatile("s_waitcnt lgkmcnt(0)" ::: "memory");
            { LAS unsigned char* vn = vbuf + ((it + 1) & 1) * 8192;
#pragma unroll
              for (int i = 0; i < 8; ++i) { const int row = 4 * i + l4, ch = i16 ^ ((l4 << 2) | (i & 3));
                  __builtin_amdgcn_global_load_lds((const unsigned*)(Vb + (size_t)(32 * jt + row) * D + 8 * ch), (LAS unsigned*)(vn + i * 1024), 16, 0, 0); } }
        }
        asm volatile("s_waitcnt vmcnt(0) lgkmcnt(0)" ::: "memory");
        bf16* Op = O + (rowbase + q0 + r32) * D + hd * HD + 4 * h;
#pragma unroll
        for (int db = 0; db < 4; ++db)
#pragma unroll
            for (int g = 0; g < 4; ++g) { u32x2 w; w.x = cvt_pk_bf16(oacc[db][4 * g], oacc[db][4 * g + 1]); w.y = cvt_pk_bf16(oacc[db][4 * g + 2], oacc[db][4 * g + 3]); *(u32x2*)(Op + 32 * db + 8 * g) = w; }
    }
}

__device__ __forceinline__ void gm_spatial_fast(const ArgsP& a, const Ctx& c, int j) {
    const bf16* z = (const bf16*)(a.ws + WS_Z); bf16* gt = (bf16*)(a.ws + WS_GATED);
    const bf16* wsb = (const bf16*)(a.ws + WS_WSPB) + (size_t)j * GG * CH * CH; const float* bsp = a.in[I_BSP] + j * GG * CH;
    const float* lg = a.in[I_VLNG] + j * GH; const float* lb = a.in[I_VLNB] + j * GH;
    LAS unsigned char* img = c.lds + RING_OFF;
    LAS unsigned char* uo = c.lds + RING_OFF + 65536;
    LAS f32x2* srow = (LAS f32x2*)(c.lds + TOFF_OFF);
    const int lane = c.lane, r32 = lane & 31, h = lane >> 5, l4 = lane >> 4, i16 = lane & 15, q4 = i16 >> 2, p4 = i16 & 3, colhalf = l4 & 1, w = c.wave;
    const int NU = NB * (SEQ / CH) * GG, per = (NU + gridDim.x - 1) / gridDim.x;
    const int u0 = blockIdx.x * per, u1 = min(NU, u0 + per), nstep = 3 * (u1 - u0);
    if (nstep <= 0) return;
    const int tbA = w & 3, dqA = w >> 2, tbB = 3 - tbA, dqB = 2 + (w >> 2), nA = 2 * (tbA + 1), nB = 2 * (tbB + 1);
    const int scc = c.tid & 15, srow0 = c.tid >> 4;
    int last_bc = -1;
#define SP_LOADHV(HV, st_) do { const int un_ = u0 + (st_) / 3, pn_ = (st_) % 3, gn_ = un_ % GG; const size_t rown_ = (size_t)(un_ / GG) * CH; \
        _Pragma("unroll") for (int it = 0; it < 4; ++it) HV[it] = *(const u32x4*)(z + (rown_ + srow0 + 32 * it) * GF + GH + gn_ * GD + 128 * pn_ + 8 * scc); } while (0)
#define SP_LOADU(HU, st_) do { const int un_ = u0 + (st_) / 3, pn_ = (st_) % 3, gn_ = un_ % GG; const size_t rown_ = (size_t)(un_ / GG) * CH; \
        _Pragma("unroll") for (int it = 0; it < 4; ++it) HU[it] = *(const u32x4*)(z + (rown_ + srow0 + 32 * it) * GF + gn_ * GD + 128 * pn_ + 8 * scc); } while (0)
    u32x4 hv0[4], hv1[4], hu[4];
    SP_LOADHV(hv0, 0); if (nstep > 1) SP_LOADHV(hv1, 1);
    SP_LOADU(hu, 0);
    bf16x8 wf[10];
    for (int step2 = 0; step2 < nstep; step2 += 2) {
#pragma unroll
      for (int par = 0; par < 2; ++par) {
        const int step = step2 + par; if (step >= nstep) break;
        const int u = u0 + step / 3, p = step % 3, g = u % GG, bc = u / GG; const size_t row0 = (size_t)bc * CH;
        LAS unsigned char* pb = img + (step & 1) * 32768; LAS unsigned char* ub = uo + (step & 1) * 32768;
        if (bc != last_bc) {
            last_bc = bc;
            {
                const int rw = c.tid >> 2, qd = c.tid & 3; const f32x4* pp = (const f32x4*)((const f32x2*)(a.ws + WS_PART) + (row0 + rw) * 96 + 24 * qd);
                f32x4 t[12];
#pragma unroll
                for (int i = 0; i < 12; ++i) t[i] = pp[i];
                float s1 = 0.f, s2 = 0.f;
#pragma unroll
                for (int i = 0; i < 12; ++i) { s1 += t[i].x + t[i].z; s2 += t[i].y + t[i].w; }
                s1 += __shfl_xor(s1, 1); s2 += __shfl_xor(s2, 1); s1 += __shfl_xor(s1, 2); s2 += __shfl_xor(s2, 2);
                const float mean = s1 * (1.f / GH), var = fmaxf(s2 * (1.f / GH) - mean * mean, 0.f);
                if (qd == 0) srow[rw] = (f32x2){mean, 1.f / sqrtf(var + LN_EPS)}; }
            __syncthreads();
        }
        { const int ch0 = g * GD + 128 * p + 8 * scc;
          const f32x4 g0 = *(const f32x4*)(lg + ch0), g1 = *(const f32x4*)(lg + ch0 + 4), b0 = *(const f32x4*)(lb + ch0), b1 = *(const f32x4*)(lb + ch0 + 4);
#pragma unroll
          for (int it = 0; it < 4; ++it) {
              const int row = srow0 + 32 * it; const f32x2 ms = srow[row]; const u32x4 h_ = par == 0 ? hv0[it] : hv1[it]; u32x4 o;
              o.x = cvt_pk_bf16((bf_lo(h_.x) - ms.x) * ms.y * g0.x + b0.x, (bf_hi(h_.x) - ms.x) * ms.y * g0.y + b0.y);
              o.y = cvt_pk_bf16((bf_lo(h_.y) - ms.x) * ms.y * g0.z + b0.z, (bf_hi(h_.y) - ms.x) * ms.y * g0.w + b0.w);
              o.z = cvt_pk_bf16((bf_lo(h_.z) - ms.x) * ms.y * g1.x + b1.x, (bf_hi(h_.z) - ms.x) * ms.y * g1.y + b1.y);
              o.w = cvt_pk_bf16((bf_lo(h_.w) - ms.x) * ms.y * g1.z + b1.z, (bf_hi(h_.w) - ms.x) * ms.y * g1.w + b1.w);
              *(LAS u32x4*)(pb + 256 * row + 16 * (scc ^ swz16(row))) = o;
              *(LAS u32x4*)(ub + 256 * row + 16 * (scc ^ swz16(row))) = hu[it];
          } }
        if (step + 2 < nstep) { if (par == 0) SP_LOADHV(hv0, step + 2); else SP_LOADHV(hv1, step + 2); }
        if (p == 0) {
            const bf16* wg = wsb + (size_t)g * CH * CH;
#define SP_WLOAD(TBA) do { _Pragma("unroll") for (int ks = 0; ks < 2 * ((TBA) + 1); ++ks) wf[ks] = *(const bf16x8*)(wg + (size_t)(32 * (TBA) + r32) * CH + 16 * ks + 8 * h); \
                           _Pragma("unroll") for (int ks = 0; ks < 2 * (4 - (TBA)); ++ks) wf[2 * ((TBA) + 1) + ks] = *(const bf16x8*)(wg + (size_t)(32 * (3 - (TBA)) + r32) * CH + 16 * ks + 8 * h); } while (0)
            if (tbA == 0) SP_WLOAD(0); else if (tbA == 1) SP_WLOAD(1); else if (tbA == 2) SP_WLOAD(2); else SP_WLOAD(3);
#undef SP_WLOAD
        }
        const int tA = 32 * tbA + r32, tB = 32 * tbB + r32;
        const float btA = bsp[g * CH + tA], btB = bsp[g * CH + tB];
        __syncthreads();
        f32x16 accA, accB;
#pragma unroll
        for (int i = 0; i < 16; ++i) { accA[i] = 0.f; accB[i] = 0.f; }
#define SP_BLOCKS(TBA) do { constexpr int NA_ = 2 * ((TBA) + 1), NB_ = 2 * (4 - (TBA)); s16x4 ta[NA_][2], tb[NB_][2]; \
            _Pragma("unroll") for (int ks = 0; ks < NA_; ++ks) _Pragma("unroll") for (int hh = 0; hh < 2; ++hh) { const int row = 16 * ks + 8 * h + 4 * hh + q4, ch = 4 * dqA + 2 * colhalf + (p4 >> 1); ta[ks][hh] = lds_tr_asm(pb + 256 * row + 16 * (ch ^ swz16(row)) + 8 * (p4 & 1)); } \
            _Pragma("unroll") for (int ks = 0; ks < NB_; ++ks) _Pragma("unroll") for (int hh = 0; hh < 2; ++hh) { const int row = 16 * ks + 8 * h + 4 * hh + q4, ch = 4 * dqB + 2 * colhalf + (p4 >> 1); tb[ks][hh] = lds_tr_asm(pb + 256 * row + 16 * (ch ^ swz16(row)) + 8 * (p4 & 1)); } \
            asm volatile("s_waitcnt lgkmcnt(0)" ::: "memory"); \
            _Pragma("unroll") for (int ks = 0; ks < NA_; ++ks) { asm volatile("" : "+v"(ta[ks][0]), "+v"(ta[ks][1])); accA = MFMA32(__builtin_shufflevector(ta[ks][0], ta[ks][1], 0, 1, 2, 3, 4, 5, 6, 7), wf[ks], accA); } \
            _Pragma("unroll") for (int ks = 0; ks < NB_; ++ks) { asm volatile("" : "+v"(tb[ks][0]), "+v"(tb[ks][1])); accB = MFMA32(__builtin_shufflevector(tb[ks][0], tb[ks][1], 0, 1, 2, 3, 4, 5, 6, 7), wf[NA_ + ks], accB); } } while (0)
        if (tbA == 0) SP_BLOCKS(0); else if (tbA == 1) SP_BLOCKS(1); else if (tbA == 2) SP_BLOCKS(2); else SP_BLOCKS(3);
#undef SP_BLOCKS
        if (step + 1 < nstep) SP_LOADU(hu, step + 1);
#pragma unroll
        for (int gq = 0; gq < 4; ++gq) {
            LAS u32x2* pa = (LAS u32x2*)(ub + 256 * tA + 16 * ((4 * dqA + gq) ^ swz16(tA)) + 8 * h); LAS u32x2* pq = (LAS u32x2*)(ub + 256 * tB + 16 * ((4 * dqB + gq) ^ swz16(tB)) + 8 * h);
            const u32x2 ua = *pa, ubv = *pq; u32x2 oa, ob;
            oa.x = cvt_pk_bf16(bf_lo(ua.x) * (accA[4 * gq] + btA), bf_hi(ua.x) * (accA[4 * gq + 1] + btA)); oa.y = cvt_pk_bf16(bf_lo(ua.y) * (accA[4 * gq + 2] + btA), bf_hi(ua.y) * (accA[4 * gq + 3] + btA));
            ob.x = cvt_pk_bf16(bf_lo(ubv.x) * (accB[4 * gq] + btB), bf_hi(ubv.x) * (accB[4 * gq + 1] + btB)); ob.y = cvt_pk_bf16(bf_lo(ubv.y) * (accB[4 * gq + 2] + btB), bf_hi(ubv.y) * (accB[4 * gq + 3] + btB));
            *pa = oa; *pq = ob;
        }
        __syncthreads();
#pragma unroll
        for (int it = 0; it < 4; ++it) { const int row = srow0 + 32 * it;
            *(u32x4*)(gt + (row0 + row) * GH + g * GD + 128 * p + 8 * scc) = *(const LAS u32x4*)(ub + 256 * row + 16 * (scc ^ swz16(row))); }
      }
    }
#undef SP_LOADHV
#undef SP_LOADU
    __syncthreads();
}

constexpr int NPHASE = 1 + 9 * DEPTH;
__global__ void __launch_bounds__(NTHREADS, 2) mk_fwd(Args a) {
    extern __shared__ __attribute__((aligned(16))) unsigned char lds_raw[];
    Ctx c0;
    const ArgsP ap{};
    c0.lds = (LAS unsigned char*)lds_raw; c0.ws = nullptr;
    c0.tid = threadIdx.x; c0.lane = c0.tid & 63; c0.wave = __builtin_amdgcn_readfirstlane(c0.tid >> 6);
    c0.gw = blockIdx.x * NWAVES + c0.wave; c0.NGW = gridDim.x * NWAVES;
    volatile LAS unsigned* MISC = (volatile LAS unsigned*)(c0.lds + MISC_OFF);
    for (int u = c0.tid; u < (LDS_BYTES - LDSCTL_OFF) / 4; u += NTHREADS) ((LAS unsigned*)(c0.lds + LDSCTL_OFF))[u] = 0u;
    __syncthreads();
    unsigned* barw = (unsigned*)((gu32*)(ap.ws + WS_CTL) + CW_BAR);
    XcdBarrier bar; bar.bar = barw; bar.x = 0; bar.st = nullptr;
    if (!MK_PER_PHASE) bar = xcd_barrier_post(barw, MISC + 8);
    const int lo = a.ph_lo, hi = a.ph_hi;
#define IN(k) (lo <= (k) && (k) < hi)
#define PC phase_ctx(c0)
#define SEAM(k) do { if (!MK_PER_PHASE && (k) + 1 < hi) xcd_barrier(bar); } while (0)

    if (IN(0)) { for (int rep = 0; rep < REP_PRO; ++rep) p0_prologue(ap, PC); SEAM(0); }
    for (int L = 0; L < DEPTH; ++L) {
        const int pb = 1 + 9 * L, j = L >> 1;
        if ((L & 1) == 0) {
            if (IN(pb + 0)) {
#if FAST_DENSE
                for (int rep = 0; rep < REP_DENSE; ++rep)
                dense_fast<0>(PC, (const bf16*)(ap.ws + WS_XB), (const bf16*)(ap.ws + WS_WQKV) + (size_t)j * 3 * D * D, 3 * D, D, (bf16*)(ap.ws + WS_Q), D, (WS_K - WS_Q) / 2);
#else
                sg_dense<1>(PC, (const bf16*)(ap.ws + WS_XB), (const bf16*)(ap.ws + WS_WQKV) + (size_t)j * 3 * D * D, M, 3 * D, D, (bf16*)(ap.ws + WS_Q));
#endif
                SEAM(pb + 0); }
#if FAST_ATTN
            if (IN(pb + 1)) { for (int rep = 0; rep < REP_MIX; ++rep) attn_fast(ap, PC); SEAM(pb + 2); }
#else
            if (IN(pb + 1)) { attn_simple(ap, PC); SEAM(pb + 2); }
#endif
            if (IN(pb + 3)) {
#if FAST_DENSE
                for (int rep = 0; rep < REP_DENSE; ++rep)
                dense_fast<0>(PC, (const bf16*)(ap.ws + WS_O), (const bf16*)(ap.ws + WS_WO) + (size_t)j * D * D, D, D, (bf16*)(ap.ws + WS_HMIX), 0, 0);
#else
                sg_dense<0>(PC, (const bf16*)(ap.ws + WS_O), (const bf16*)(ap.ws + WS_WO) + (size_t)j * D * D, M, D, D, (bf16*)(ap.ws + WS_HMIX));
#endif
                SEAM(pb + 3); }
        } else {
            if (IN(pb + 0)) {
#if FAST_DENSE
                for (int rep = 0; rep < REP_DENSE; ++rep)
                dense_fast<2>(PC, (const bf16*)(ap.ws + WS_XB), (const bf16*)(ap.ws + WS_WIN) + (size_t)j * GF * D, GF, D, (bf16*)(ap.ws + WS_Z), 0, 0, FUSE_STATS ? (f32x2*)(ap.ws + WS_PART) : (f32x2*)nullptr, GH / 256);
#else
                sg_dense<2>(PC, (const bf16*)(ap.ws + WS_XB), (const bf16*)(ap.ws + WS_WIN) + (size_t)j * GF * D, M, GF, D, (bf16*)(ap.ws + WS_Z));
#endif
                SEAM(pb + 0); }
#if !(FUSE_STATS && FAST_DENSE && FAST_SPATIAL)
            if (IN(pb + 1)) { for (int rep = 0; rep < REP_MIX; ++rep) gm_stats(ap, PC); SEAM(pb + 1); }
#endif
#if FAST_SPATIAL
            if (IN(pb + 2)) { for (int rep = 0; rep < REP_MIX; ++rep) gm_spatial_fast(ap, PC, j); SEAM(pb + 2); }
#else
            if (IN(pb + 2)) { gm_spatial_simple(ap, PC, j); SEAM(pb + 2); }
#endif
            if (IN(pb + 3)) {
#if FAST_DENSE
                for (int rep = 0; rep < REP_DENSE; ++rep)
                dense_fast<0>(PC, (const bf16*)(ap.ws + WS_GATED), (const bf16*)(ap.ws + WS_WOUT) + (size_t)j * D * GH, D, GH, (bf16*)(ap.ws + WS_HMIX), 0, 0);
#else
                sg_dense<0>(PC, (const bf16*)(ap.ws + WS_GATED), (const bf16*)(ap.ws + WS_WOUT) + (size_t)j * D * GH, M, D, GH, (bf16*)(ap.ws + WS_HMIX));
#endif
                SEAM(pb + 3); }
        }
#if FUSE_ROUTER
        if (IN(pb + 4)) { ln_mix_router(ap, PC, L); SEAM(pb + 5); }
#else
        if (IN(pb + 4)) { ln_mix(ap, PC, L); SEAM(pb + 4); }
        if (IN(pb + 5)) { router(ap, PC, L); SEAM(pb + 5); }
#endif
#if FAST_MOE && MOE_DIRECT
#ifndef DBG_GU_SIMPLE
#define DBG_GU_SIMPLE 0
#endif
#ifndef DBG_DN_SIMPLE
#define DBG_DN_SIMPLE 0
#endif
#if MOE_MERGE
#if MOE_PAIRS
        if (IN(pb + 6)) { moe_tables(ap, PC, L); mg3::moe_pairs<0>(ap, PC, L); mg3::moe_pairs<2>(ap, PC, L); mg3::moe_pairs<1>(ap, PC, L); SEAM(pb + 7); }
#else
        if (IN(pb + 6)) { moe_tables(ap, PC, L); mg::moe_direct<0, 0, true>(ap, PC, L); mg::moe_direct<1, 0, true>(ap, PC, L); SEAM(pb + 7); }
#endif
#else
        if (IN(pb + 6)) { moe_tables(ap, PC, L); if (DBG_GU_SIMPLE) sg_moe_gu(ap, PC, L); else for (int rep = 0; rep < REP_MOE; ++rep) mg::moe_direct<0>(ap, PC, L);
            if (PROBE_GU) mg::moe_direct<0, PROBE_GU>(ap, PC, L); SEAM(pb + 6); }
        if (IN(pb + 7)) { moe_tables(ap, PC, L); if (DBG_DN_SIMPLE) sg_moe_dn(ap, PC, L); else for (int rep = 0; rep < REP_MOE; ++rep) mg::moe_direct<1>(ap, PC, L);
            if (PROBE_DN) mg::moe_direct<1, PROBE_DN>(ap, PC, L); SEAM(pb + 7); }
#endif
#elif FAST_MOE
        if (IN(pb + 6)) { moe_tables(ap, PC, L); for (int rep = 0; rep < REP_MOE; ++rep) moe_gu_fast(ap, PC, L); SEAM(pb + 6); }
        if (IN(pb + 7)) { moe_tables(ap, PC, L); for (int rep = 0; rep < REP_MOE; ++rep) moe_dn_fast(ap, PC, L); SEAM(pb + 7); }
#else
        if (IN(pb + 6)) { moe_tables(ap, PC, L); sg_moe_gu(ap, PC, L); SEAM(pb + 6); }
        if (IN(pb + 7)) { moe_tables(ap, PC, L); sg_moe_dn(ap, PC, L); SEAM(pb + 7); }
#endif
        if (IN(pb + 8)) { moe_tables(ap, PC, L); ln_ffn(ap, PC, L); SEAM(pb + 8); }
    }
#undef IN
#undef SEAM
}

extern "C" void kernel_launch(void* const* d_in, const int* in_sizes, int n_in, void* d_out, int out_size, void* d_ws, size_t ws_size, hipStream_t stream) {
    static int grid = 0;
    if (grid == 0) {
        if (n_in != 20 || in_sizes[0] != M * D || out_size != M * D || ws_size < WS_END) { fprintf(stderr, "kernel_launch: unexpected problem shape / workspace (%d inputs, ws %zu)\n", n_in, ws_size); grid = -1; return; }
        int dev = 0, cus = 0, per_cu = 0;
        if (hipGetDevice(&dev) != hipSuccess || hipDeviceGetAttribute(&cus, hipDeviceAttributeMultiprocessorCount, dev) != hipSuccess) { grid = -1; return; }
        if (hipFuncSetAttribute((const void*)mk_fwd, hipFuncAttributeMaxDynamicSharedMemorySize, LDS_BYTES) != hipSuccess) { fprintf(stderr, "kernel_launch: hipFuncSetAttribute failed\n"); grid = -1; return; }
        if (hipOccupancyMaxActiveBlocksPerMultiprocessor(&per_cu, (const void*)mk_fwd, NTHREADS, LDS_BYTES) != hipSuccess || per_cu < 1) { fprintf(stderr, "kernel_launch: occupancy query reports %d\n", per_cu); }
        (void)hipGetLastError();
        grid = cus;
    }
    if (grid < 0) return;
    if (hipMemsetAsync((char*)d_ws + WS_CTL, 0, CTL_ZERO_BYTES, stream) != hipSuccess) return;
    Args a{};
    for (int i = 0; i < 20; ++i) a.in[i] = (const float*)d_in[i];
    a.out = (float*)d_out; a.ws = (unsigned char*)d_ws;
#if MK_PER_PHASE
    for (int p = 0; p < NPHASE; ++p) {
        if (p >= 1) { const int L = (p - 1) / 9, s = (p - 1) % 9; if ((L & 1) == 0 && s == 2) continue; if (FUSE_ROUTER && s == 5) continue; if (MOE_MERGE && FAST_MOE && MOE_DIRECT && s == 7) continue; if (FUSE_STATS && FAST_DENSE && FAST_SPATIAL && (L & 1) == 1 && s == 1) continue; }
        a.ph_lo = p; a.ph_hi = p + 1;
        hipLaunchKernelGGL(mk_fwd, dim3(grid), dim3(NTHREADS), LDS_BYTES, stream, a);
    }
#else
    a.ph_lo = 0; a.ph_hi = NPHASE;
    hipLaunchKernelGGL(mk_fwd, dim3(grid), dim3(NTHREADS), LDS_BYTES, stream, a);
#endif
}
```

```cpp
#include <hip/hip_runtime.h>
#include <cstdint>
#include <cstdio>

#ifndef MK_PER_PHASE
#define MK_PER_PHASE 0
#endif
#ifndef FAST_DENSE
#define FAST_DENSE 1
#endif
#ifndef REP_DENSE
#define REP_DENSE 1
#endif
#ifndef REP_PRO
#define REP_PRO 1
#endif
#ifndef REP_MOE
#define REP_MOE 1
#endif
#ifndef REP_MIX
#define REP_MIX 1
#endif
#ifndef PROBE_GU
#define PROBE_GU 0
#endif
#ifndef PROBE_DN
#define PROBE_DN 0
#endif
#ifndef DBG_KEEP_CONV
#define DBG_KEEP_CONV 0
#endif
#ifndef RES_BF16
#define RES_BF16 1
#endif
#ifndef MOE_PAIRS
#define MOE_PAIRS 1
#endif
#ifndef MOE_MERGE
#define MOE_MERGE 1
#endif
#ifndef MOE_DIRECT
#define MOE_DIRECT 1
#endif
#ifndef FUSE_STATS
#define FUSE_STATS 1
#endif
#ifndef FUSE_ROUTER
#define FUSE_ROUTER 1
#endif
#ifndef FAST_ATTN
#define FAST_ATTN 1
#endif
#ifndef FAST_SPATIAL
#define FAST_SPATIAL 1
#endif
#ifndef FAST_MOE
#define FAST_MOE 1
#endif

#define GAS __attribute__((address_space(1)))
#define LAS __attribute__((address_space(3)))
typedef unsigned short bf16;
typedef float f32x4 __attribute__((ext_vector_type(4)));
typedef float f32x2 __attribute__((ext_vector_type(2)));
typedef short bf16x8 __attribute__((ext_vector_type(8)));
typedef short s16x4 __attribute__((ext_vector_type(4)));
typedef unsigned u32x4 __attribute__((ext_vector_type(4)));
typedef unsigned u32x2 __attribute__((ext_vector_type(2)));
typedef GAS unsigned gu32;
#define RLX_AGENT __ATOMIC_RELAXED, __HIP_MEMORY_SCOPE_AGENT

constexpr int NB = 2, SEQ = 4096, M = NB * SEQ, D = 2048, NH = 16, HD = 128;
constexpr int GF = 12288, GH = 6144, GG = 16, GD = 384, CH = 128;
constexpr int NGRP = 4, NEXP = 8, NX = 32, FE = 512, DEPTH = 4;
constexpr float LN_EPS = 1e-5f;
constexpr float ALPHA = 1.6817928305074290f;
constexpr float QSCALE = 0.08838834764831845f * 1.4426950408889634f;
constexpr int NWAVES = 8, NTHREADS = NWAVES * 64;

constexpr size_t MiB = 1u << 20;
constexpr size_t WS_CTL = 0, CTL_ZERO_BYTES = 1 * MiB;
constexpr size_t WS_WR = 1 * MiB;
constexpr size_t WS_WQKV = 2 * MiB;
constexpr size_t WS_WO = 50 * MiB;
constexpr size_t WS_WIN = 66 * MiB;
constexpr size_t WS_WOUT = 162 * MiB;
constexpr size_t WS_WGU = 210 * MiB;
constexpr size_t WS_WD = 722 * MiB;
constexpr size_t WS_X = 978 * MiB;
constexpr size_t WS_XB = 1042 * MiB;
constexpr size_t WS_Q = 1074 * MiB, WS_K = 1106 * MiB, WS_V = 1138 * MiB, WS_O = 1170 * MiB;
constexpr size_t WS_Z = 1202 * MiB;
constexpr size_t WS_GATED = 1394 * MiB;
constexpr size_t WS_HMIX = 1490 * MiB;
constexpr size_t WS_HP = 1522 * MiB;
constexpr size_t WS_YP = 1546 * MiB;
constexpr size_t WS_LIST = 1642 * MiB;
constexpr size_t WS_TOK = 1643 * MiB;
constexpr size_t WS_STAT = 1644 * MiB;
constexpr size_t WS_WSPB = 1645 * MiB;
constexpr size_t WS_PART = 1646 * MiB;
constexpr size_t WS_END = 1654 * MiB;
constexpr int CNT_STRIDE = 64, DONE_STRIDE = 32;
constexpr int CW_TMO = 0, CW_CODE = 1, CW_CNT = 8192  , CW_DONE = 32768  , CW_QDN = 2048  , CW_BAR = 4096, CW_PFLAG = 131072  ;

constexpr int RING_OFF = 0, RING_BYTES = 131072;
constexpr int TAB_OFF = RING_BYTES;
constexpr int TOFF_OFF = TAB_OFF + 2048, MAXGU = 8;
constexpr int TB_BASE = 192, TB_CNT = 232, TB_NP = 318, TB_PAIR = 320;
constexpr int MOE_TSH = MOE_DIRECT ? 7 : 8, MOE_TR = 1 << MOE_TSH;
constexpr int LDSCTL_OFF = RING_BYTES + 12288, MISC_OFF = LDSCTL_OFF + 320;
constexpr int LDS_BYTES = 147456;

__device__ __forceinline__ unsigned cvt_pk_bf16(float lo, float hi) { unsigned r; asm("v_cvt_pk_bf16_f32 %0, %1, %2" : "=v"(r) : "v"(lo), "v"(hi)); return r; }
__device__ __forceinline__ float bf_lo(unsigned u) { return __uint_as_float(u << 16); }
__device__ __forceinline__ float bf_hi(unsigned u) { return __uint_as_float(u & 0xffff0000u); }
__device__ __forceinline__ float bf2f(bf16 b) { return __uint_as_float((unsigned)b << 16); }
__device__ __forceinline__ float wave_sum(float v) {
#pragma unroll
    for (int o = 1; o < 64; o <<= 1) v += __shfl_xor(v, o);
    return v;
}
__device__ __forceinline__ float fast_exp2(float x) { return __builtin_amdgcn_exp2f(x); }
__device__ __forceinline__ float fast_rcp(float x) { return __builtin_amdgcn_rcpf(x); }
__device__ __forceinline__ float gelu_tanh(float x) {
    const float u = 0.7978845608028654f * (x + 0.044715f * x * x * x);
    const float t = fminf(fmaxf(-2.0f * 1.4426950408889634f * u, -120.f), 120.f);
    return x * fast_rcp(1.0f + fast_exp2(t));
}
__device__ __forceinline__ float silu(float x) {
    const float t = fminf(fmaxf(-1.4426950408889634f * x, -120.f), 120.f);
    return x * fast_rcp(1.0f + fast_exp2(t));
}

#define XB_TMO      128
#define XB_XCNT(j)  (256  + 64 * (j))
#define XB_XSUB(j)  (1280 + 64 * (j))
#define XB_XGEN(j)  (2304 + 64 * (j))
#define XB_TOP      3328
#define XB_TOPGEN   3392
#define XCD_BAR_WORDS 3456
#define XB_SPIN_CAP (1u << 22)

__device__ __forceinline__ unsigned xb_ld(unsigned* p)              { return __hip_atomic_load(p, __ATOMIC_RELAXED, __HIP_MEMORY_SCOPE_AGENT); }
__device__ __forceinline__ unsigned xb_add(unsigned* p, unsigned v) { return __hip_atomic_fetch_add(p, v, __ATOMIC_RELAXED, __HIP_MEMORY_SCOPE_AGENT); }
__device__ __forceinline__ unsigned xb_xcc_id() { return (unsigned)__builtin_amdgcn_s_getreg((3 << 11) | 20) & 0xFu; }
#define XB_SPIN(cond, bar) do { unsigned _sp = 0; while (cond) { __builtin_amdgcn_s_sleep(1); \
    if ((++_sp & 255u) == 0u) { if (xb_ld(&(bar)[XB_TMO])) break; if (_sp > XB_SPIN_CAP) { atomicAdd(&(bar)[XB_TMO], 1u); break; } } } } while (0)

struct XcdBarrier { unsigned* bar; unsigned x; volatile LAS unsigned* st; };

__device__ __forceinline__ XcdBarrier xcd_barrier_post(unsigned* bar, volatile LAS unsigned* st) {
    XcdBarrier b; b.bar = bar; b.x = xb_xcc_id(); b.st = st;
    if (threadIdx.x == 0) (void)xb_add(&bar[XB_XCNT(b.x)], 1u);
    return b;
}
__device__ __forceinline__ void xcd_barrier_complete(unsigned* bar, unsigned x, unsigned& nloc, unsigned& nx) {
    const unsigned G = gridDim.x * gridDim.y * gridDim.z;
    unsigned sum, cnt, mine, sp = 0u;
    for (;;) {
        sum = 0u; cnt = 0u; mine = 0u;
#pragma unroll
        for (unsigned j = 0; j < 16; ++j) { const unsigned c = xb_ld(&bar[XB_XCNT(j)]); sum += c; cnt += (c > 0u) ? 1u : 0u; mine = (j == x) ? c : mine; }
        if (sum == G) break;
        __builtin_amdgcn_s_sleep(1);
        if ((++sp & 255u) == 0u) { if (xb_ld(&bar[XB_TMO])) break; if (sp > XB_SPIN_CAP) { atomicAdd(&bar[XB_TMO], 1u); break; } }
    }
    nloc = mine > 0u ? mine : 1u; nx = cnt > 0u ? cnt : 1u;
}
__device__ __forceinline__ void xcd_barrier(const XcdBarrier& b) {
    asm volatile("s_waitcnt vmcnt(0)" ::: "memory");
    __syncthreads();
    if (threadIdx.x == 0) {
        unsigned* bar = b.bar;
        __builtin_amdgcn_s_waitcnt(0);
        unsigned nloc = b.st[0], nx = b.st[1];
        if (nloc == 0u) { xcd_barrier_complete(bar, b.x, nloc, nx); b.st[0] = nloc; b.st[1] = nx; }
        const unsigned old = xb_add(&bar[XB_XSUB(b.x)], 1u);
        const unsigned gen = old / nloc;
        if (old + 1u == (gen + 1u) * nloc) {
            __builtin_amdgcn_fence(__ATOMIC_RELEASE, "agent");
            asm volatile("s_waitcnt vmcnt(0)" ::: "memory");
            const unsigned og = xb_add(&bar[XB_TOP], 1u);
            const unsigned tg = og / nx;
            if (og + 1u == (tg + 1u) * nx) xb_add(&bar[XB_TOPGEN], 1u);
            else XB_SPIN(xb_ld(&bar[XB_TOPGEN]) == tg, bar);
            __builtin_amdgcn_fence(__ATOMIC_ACQUIRE, "agent");
            xb_add(&bar[XB_XGEN(b.x)], 1u);
            asm volatile("s_waitcnt vmcnt(0)" ::: "memory");
        } else {
            XB_SPIN(xb_ld(&bar[XB_XGEN(b.x)]) == gen, bar);
            __builtin_amdgcn_fence(__ATOMIC_ACQUIRE, "agent");
            asm volatile("s_waitcnt vmcnt(0)" ::: "memory");
        }
    }
    __syncthreads();
}

namespace pg8 {
constexpr int BM = 256, BK = 64, HALF = 128, HTB = HALF * BK * 2, STAGE_BYTES = 8 * HTB, NXCD = 8, WGM = 8;
__host__ __device__ __forceinline__ int lds_byte(int r, int c) { const int st = (r >> 4) * 2 + (c >> 5), rr = r & 15, cc = c & 31, ob = rr * 64 + cc * 2; return st * 1024 + (ob ^ (((ob >> 9) & 1) << 5)); }
__host__ __device__ __forceinline__ void stage_rc(int b, int& R, int& C) { const int st = b / 1024, sb = b % 1024, swz = sb ^ (((sb >> 9) & 1) << 5); R = (st >> 1) * 16 + swz / 64; C = (st & 1) * 32 + (swz % 64) / 2; }
__host__ __device__ __forceinline__ int perm32(int rho) { const int n = rho >> 4, i = rho & 15; return 8 * (i >> 2) + 4 * n + (i & 3); }

struct Unit { int pm, pn, e; };

struct DenseOrder {
    static constexpr bool GATHER = false;
    const bf16* A; const bf16* Bt; int K; int nM, nN, nwg, G, c;
    __device__ void init(const bf16* A_, const bf16* Bt_, int M_, int N_, int K_, int G_, int c_) { A = A_; Bt = Bt_; K = K_; nM = M_ / BM; nN = N_ / BM; nwg = nM * nN; G = G_; c = c_; }
    __device__ bool next(int i, Unit& u) const {
        const long L = (long)i * G + c; if (L >= nwg) return false;
        int wgid = (int)L; { const int q = nwg / NXCD, r = nwg % NXCD, xcd = wgid % NXCD, off = wgid / NXCD; wgid = (xcd < r ? xcd * (q + 1) : r * (q + 1) + (xcd - r) * q) + off; }
        const int nig = WGM * nN, gid = wgid / nig, fm = gid * WGM, gsz = (nM - fm) < WGM ? (nM - fm) : WGM;
        u.pm = fm + ((wgid % nig) % gsz); u.pn = (wgid % nig) / gsz; u.e = 0; return true;
    }
    __device__ __forceinline__ const char* abase(const Unit& u) const { return (const char*)A + (size_t)u.pm * BM * K * 2; }
    __device__ __forceinline__ const char* bbase(const Unit& u) const { return (const char*)Bt + (size_t)u.pn * BM * K * 2; }
    __device__ __forceinline__ unsigned aoff(int, int) const { return 0u; }
};
template <bool GATHER_, int NPN>
struct MoeOrder {
    static constexpr bool GATHER = GATHER_;
    const bf16* A; const bf16* W; int K; size_t wstride; int T, G, vcu; const LAS int* tab; const LAS unsigned* toff;
    __device__ bool next(int i, Unit& u) const {
        const int idx = i * G + vcu; if (idx >= T * NPN || (GATHER && i >= MAXGU)) return false;
        u.pm = idx / NPN; u.pn = idx % NPN; u.e = tab[u.pm]; return true;
    }
    __device__ __forceinline__ const char* abase(const Unit& u) const { return GATHER ? (const char*)A : (const char*)A + (size_t)u.pm * BM * K * 2; }
    __device__ __forceinline__ const char* bbase(const Unit& u) const { return (const char*)W + ((size_t)u.e * wstride + (size_t)u.pn * BM * K) * 2; }
    __device__ __forceinline__ unsigned aoff(int ui, int r) const { return toff[ui * 256 + r]; }
};

__device__ __forceinline__ f32x2 gelu_tanh2(f32x2 v) {
    const f32x2 u = (v * v * 0.044715f + 1.0f) * v * (-2.0f * 0.7978845608028654f * 1.4426950408889634f);
    f32x2 e; e.x = __builtin_amdgcn_exp2f(u.x); e.y = __builtin_amdgcn_exp2f(u.y);
    const f32x2 d = e + 1.0f; f32x2 r; r.x = __builtin_amdgcn_rcpf(d.x); r.y = __builtin_amdgcn_rcpf(d.y);
    return v * r;
}
template <int ACT  > struct EpiBf16 {
    bf16* O; int ldc; int split_cols; size_t split_stride; f32x2* part; int part_pn0;
    __device__ __forceinline__ void operator()(const f32x4 (&acc)[2][2][4][2], const Unit& u, int wr, int wc, int fr, int fq) const {
        const int row0 = u.pm * BM + wr * 64 + fr; int colt = u.pn * BM; bf16* base = O;
        if (split_cols) { const int t = colt / split_cols; base += (size_t)t * split_stride; colt -= t * split_cols; }
        const int col0 = colt + wc * 32 + 8 * fq;
#pragma unroll
        for (int ai = 0; ai < 2; ++ai)
#pragma unroll
            for (int m = 0; m < 4; ++m) { bf16* rowp = base + (size_t)(row0 + ai * HALF + m * 16) * ldc + col0; float ps = 0.f, pq = 0.f;
#pragma unroll
                for (int bj = 0; bj < 2; ++bj) { f32x4 v0 = acc[ai][bj][m][0], v1 = acc[ai][bj][m][1];
                    if (ACT == 2) { const f32x2 a = gelu_tanh2((f32x2){v0[0], v0[1]}), b = gelu_tanh2((f32x2){v0[2], v0[3]}), c = gelu_tanh2((f32x2){v1[0], v1[1]}), d = gelu_tanh2((f32x2){v1[2], v1[3]});
                        v0 = (f32x4){a.x, a.y, b.x, b.y}; v1 = (f32x4){c.x, c.y, d.x, d.y}; }
                    u32x4 w; w.x = cvt_pk_bf16(v0[0], v0[1]); w.y = cvt_pk_bf16(v0[2], v0[3]); w.z = cvt_pk_bf16(v1[0], v1[1]); w.w = cvt_pk_bf16(v1[2], v1[3]);
                    *(u32x4*)(rowp + bj * HALF) = w;
                    if (ACT == 2) { ps += (bf_lo(w.x) + bf_hi(w.x)) + (bf_lo(w.y) + bf_hi(w.y)) + (bf_lo(w.z) + bf_hi(w.z)) + (bf_lo(w.w) + bf_hi(w.w));
                        pq += (bf_lo(w.x) * bf_lo(w.x) + bf_hi(w.x) * bf_hi(w.x)) + (bf_lo(w.y) * bf_lo(w.y) + bf_hi(w.y) * bf_hi(w.y)) + (bf_lo(w.z) * bf_lo(w.z) + bf_hi(w.z) * bf_hi(w.z)) + (bf_lo(w.w) * bf_lo(w.w) + bf_hi(w.w) * bf_hi(w.w)); } }
                if (ACT == 2 && part && u.pn >= part_pn0) {
                    ps += __shfl_xor(ps, 16); ps += __shfl_xor(ps, 32); pq += __shfl_xor(pq, 16); pq += __shfl_xor(pq, 32);
                    if (fq == 0) part[(size_t)(row0 + ai * HALF + m * 16) * 96 + (u.pn - part_pn0) * 4 + wc] = (f32x2){ps, pq}; } }
    }
};
struct EpiSwiglu {
    bf16* H;
    __device__ __forceinline__ void operator()(const f32x4 (&acc)[2][2][4][2], const Unit& u, int wr, int wc, int fr, int fq) const {
        const int row0 = u.pm * BM + wr * 64 + fr, col0 = u.pn * HALF + wc * 32 + 8 * fq;
#pragma unroll
        for (int ai = 0; ai < 2; ++ai)
#pragma unroll
            for (int m = 0; m < 4; ++m) {
                f32x4 h[2];
#pragma unroll
                for (int n = 0; n < 2; ++n) { const f32x4 g = acc[ai][0][m][n], up = acc[ai][1][m][n];
                    f32x4 e; e.x = __builtin_amdgcn_exp2f(g.x * -1.4426950408889634f); e.y = __builtin_amdgcn_exp2f(g.y * -1.4426950408889634f); e.z = __builtin_amdgcn_exp2f(g.z * -1.4426950408889634f); e.w = __builtin_amdgcn_exp2f(g.w * -1.4426950408889634f);
                    e = e + 1.0f; f32x4 r; r.x = __builtin_amdgcn_rcpf(e.x); r.y = __builtin_amdgcn_rcpf(e.y); r.z = __builtin_amdgcn_rcpf(e.z); r.w = __builtin_amdgcn_rcpf(e.w);
                    h[n] = g * r * up; }
                u32x4 w; w.x = cvt_pk_bf16(h[0][0], h[0][1]); w.y = cvt_pk_bf16(h[0][2], h[0][3]); w.z = cvt_pk_bf16(h[1][0], h[1][1]); w.w = cvt_pk_bf16(h[1][2], h[1][3]);
                *(u32x4*)(H + (size_t)(row0 + ai * HALF + m * 16) * FE + col0) = w;
            }
    }
};

template <class Epi, class Sched, bool ALIGN_EPI>
__device__ __forceinline__ void gemm_phase(LAS unsigned char* lds, const int K, const Sched& S, const Epi& E) {
    int tid_ = threadIdx.x; asm volatile("" : "+v"(tid_));
    const int tid = tid_, wid = __builtin_amdgcn_readfirstlane(tid >> 6), lane = tid & 63, wr = wid >> 2, wc = wid & 3, fr = lane & 15, fq = lane >> 4;
    const int nt = K / BK;
    int RA[2], CA[2]; unsigned voffB[2];
#pragma unroll
    for (int i = 0; i < 2; ++i) { int R, C; stage_rc(tid * 16 + i * 8192, R, C); const int Rb = (R & ~31) + perm32(R & 31); RA[i] = R; CA[i] = C; voffB[i] = (unsigned)(Rb * K + C) * 2u; }
    const size_t kstep = (size_t)(BK * 2);
    const size_t hstep = (size_t)HALF * K * 2;
    const unsigned ldsw = (unsigned)wid * 1024u;
    const int aoff = lds_byte(wr * 64 + fr, fq * 8), boff = lds_byte(wc * 32 + fr, fq * 8);
#define PG8_SA(b, h) (((b) * 2 + (h)) * HTB)
#define PG8_SB(b, h) ((4 + (b) * 2 + (h)) * HTB)
#define PG8_STAGE(bufoff, gbase, voff) do { _Pragma("unroll") for (int _i = 0; _i < 2; ++_i) \
        __builtin_amdgcn_global_load_lds((const unsigned*)((const char*)(gbase) + (voff)[_i]), (LAS unsigned*)(lds + (bufoff) + ldsw + _i * 8192), 16, 0, 0); } while (0)
#define PG8_LDA(dst, b, h) do { _Pragma("unroll") for (int m = 0; m < 4; ++m) _Pragma("unroll") for (int k = 0; k < 2; ++k) dst[m][k] = *(const LAS bf16x8*)(lds + PG8_SA(b, h) + aoff + m * 2048 + k * 1024); } while (0)
#define PG8_LDB(dst, b, h) do { _Pragma("unroll") for (int n = 0; n < 2; ++n) _Pragma("unroll") for (int k = 0; k < 2; ++k) dst[n][k] = *(const LAS bf16x8*)(lds + PG8_SB(b, h) + boff + n * 2048 + k * 1024); } while (0)
#define PG8_MMA(ai, bj, At, Bt) do { __builtin_amdgcn_s_setprio(1); _Pragma("unroll") for (int m = 0; m < 4; ++m) _Pragma("unroll") for (int n = 0; n < 2; ++n) _Pragma("unroll") for (int k = 0; k < 2; ++k) \
        acc[ai][bj][m][n] = __builtin_amdgcn_mfma_f32_16x16x32_bf16(Bt[n][k], At[m][k], acc[ai][bj][m][n], 0, 0, 0); __builtin_amdgcn_s_setprio(0); } while (0)
#define PG8_WAIT_V(n) asm volatile("s_waitcnt vmcnt(" #n ")" ::: "memory")
#define PG8_WAIT_L(n) asm volatile("s_waitcnt lgkmcnt(" #n ")" ::: "memory")
#define PG8_BAR __builtin_amdgcn_s_barrier()
#define PG8_SCHED __builtin_amdgcn_sched_barrier(0)
#define PG8_AVOFF(dst, uu, uidx) do { _Pragma("unroll") for (int _h = 0; _h < 2; ++_h) _Pragma("unroll") for (int _i = 0; _i < 2; ++_i) \
        dst[_h][_i] = Sched::GATHER ? S.aoff(uidx, _h * HALF + RA[_i]) + (unsigned)CA[_i] * 2u : (unsigned)((_h * HALF + RA[_i]) * K + CA[_i]) * 2u; } while (0)
    Unit cur, nxt; int ui = 0;
    if (!S.next(0, cur)) return;
    f32x4 acc[2][2][4][2];
#pragma unroll
    for (int a = 0; a < 2; ++a)
#pragma unroll
        for (int b = 0; b < 2; ++b)
#pragma unroll
            for (int m = 0; m < 4; ++m)
#pragma unroll
                for (int n = 0; n < 2; ++n) acc[a][b][m][n] = (f32x4){0.f, 0.f, 0.f, 0.f};
    bf16x8 At[4][2], B0[2][2], B1[2][2];
    unsigned vA[2][2], vN[2][2];
    PG8_AVOFF(vA, cur, 0);
    const char* cA = S.abase(cur); const char* cB = S.bbase(cur);
    PG8_STAGE(PG8_SB(0, 0), cB, voffB); PG8_STAGE(PG8_SB(0, 1), cB + hstep, voffB); PG8_STAGE(PG8_SA(0, 0), cA, vA[0]); PG8_STAGE(PG8_SA(0, 1), cA, vA[1]);
    if (wr == 1) PG8_BAR;
    PG8_WAIT_V(2); PG8_BAR;
    PG8_STAGE(PG8_SB(1, 0), cB + kstep, voffB); PG8_STAGE(PG8_SA(1, 0), cA + kstep, vA[0]); PG8_STAGE(PG8_SB(1, 1), cB + hstep + kstep, voffB);
    PG8_WAIT_V(6); PG8_BAR;
    for (;;) {
        const bool has_next = S.next(ui + 1, nxt);
        const char* nA = has_next ? S.abase(nxt) : cA; const char* nB = has_next ? S.bbase(nxt) : cB;
        if (Sched::GATHER) { if (has_next) { PG8_AVOFF(vN, nxt, ui + 1); } else {
#pragma unroll
            for (int h = 0; h < 2; ++h)
#pragma unroll
                for (int i = 0; i < 2; ++i) vN[h][i] = vA[h][i]; } }
        for (int t = 0; t < nt; t += 2) {
            const bool last = (t == nt - 2);
            const char* a1 = cA + (size_t)(t + 1) * kstep;
            const char* a2 = last ? nA : cA + (size_t)(t + 2) * kstep; const char* b2 = last ? nB : cB + (size_t)(t + 2) * kstep;
            const char* a3 = a2 + kstep; const char* b3 = b2 + kstep;
            unsigned v2[2][2];
#pragma unroll
            for (int h = 0; h < 2; ++h)
#pragma unroll
                for (int i = 0; i < 2; ++i) v2[h][i] = (Sched::GATHER && last) ? vN[h][i] : vA[h][i];
            PG8_LDB(B0, 0, 0); PG8_LDB(B1, 0, 1); PG8_SCHED; PG8_LDA(At, 0, 0); PG8_STAGE(PG8_SA(1, 1), a1, vA[1]);
            PG8_WAIT_V(8); PG8_WAIT_L(0); PG8_BAR; PG8_MMA(0, 0, At, B0); PG8_MMA(0, 1, At, B1); PG8_BAR; PG8_SCHED;
            PG8_LDA(At, 0, 1); PG8_STAGE(PG8_SB(0, 0), b2, voffB); PG8_STAGE(PG8_SB(0, 1), b2 + hstep, voffB); PG8_STAGE(PG8_SA(0, 0), a2, v2[0]);
            PG8_WAIT_V(8); PG8_WAIT_L(0); PG8_BAR; PG8_MMA(1, 0, At, B0); PG8_MMA(1, 1, At, B1); PG8_BAR; PG8_SCHED;
            PG8_LDB(B0, 1, 0); PG8_LDB(B1, 1, 1); PG8_SCHED; PG8_LDA(At, 1, 0); PG8_STAGE(PG8_SA(0, 1), a2, v2[1]);
            PG8_WAIT_V(8); PG8_WAIT_L(0); PG8_BAR; PG8_MMA(0, 0, At, B0); PG8_MMA(0, 1, At, B1); PG8_BAR; PG8_SCHED;
            PG8_LDA(At, 1, 1); PG8_STAGE(PG8_SB(1, 0), b3, voffB); PG8_STAGE(PG8_SB(1, 1), b3 + hstep, voffB); PG8_STAGE(PG8_SA(1, 0), a3, v2[0]);
            PG8_WAIT_V(8); PG8_WAIT_L(0); PG8_BAR; PG8_MMA(1, 0, At, B0); PG8_MMA(1, 1, At, B1); PG8_BAR; PG8_SCHED;
        }
        if constexpr (ALIGN_EPI) { if (wr == 0) PG8_BAR; }
        E(acc, cur, wr, wc, fr, fq);
        if (!has_next) break;
#pragma unroll
        for (int a = 0; a < 2; ++a)
#pragma unroll
            for (int b = 0; b < 2; ++b)
#pragma unroll
                for (int m = 0; m < 4; ++m)
#pragma unroll
                    for (int n = 0; n < 2; ++n) acc[a][b][m][n] = (f32x4){0.f, 0.f, 0.f, 0.f};
        cur = nxt; cA = nA; cB = nB; ++ui;
        if (Sched::GATHER) {
#pragma unroll
            for (int h = 0; h < 2; ++h)
#pragma unroll
                for (int i = 0; i < 2; ++i) vA[h][i] = vN[h][i]; }
        if constexpr (ALIGN_EPI) { if (wr == 1) PG8_BAR; }
    }
    PG8_WAIT_V(0);
    if constexpr (!ALIGN_EPI) { if (wr == 0) PG8_BAR; }
    PG8_BAR;
#undef PG8_SA
#undef PG8_SB
#undef PG8_STAGE
#undef PG8_LDA
#undef PG8_LDB
#undef PG8_MMA
#undef PG8_WAIT_V
#undef PG8_WAIT_L
#undef PG8_BAR
#undef PG8_SCHED
#undef PG8_AVOFF
}
}

struct Args { const float* in[20]; float* out; unsigned char* ws; int ph_lo, ph_hi; };
typedef __attribute__((address_space(4))) const unsigned char* kargp_t;
__device__ __forceinline__ kargp_t karg_base() { kargp_t k = (kargp_t)__builtin_amdgcn_kernarg_segment_ptr(); asm volatile("" : "+s"(k)); return k; }
struct ArgsP {
    struct InP { __device__ __forceinline__ const float* operator[](int i) const { return *(const float* const __attribute__((address_space(4)))*)(karg_base() + 8 * i); } } in;
    struct WsP { __device__ __forceinline__ operator unsigned char*() const { return *(unsigned char* const __attribute__((address_space(4)))*)(karg_base() + 168); }
                 __device__ __forceinline__ unsigned char* operator+(size_t o) const { return (unsigned char*)(*this) + o; } } ws;
    struct OutP { __device__ __forceinline__ operator float*() const { return *(float* const __attribute__((address_space(4)))*)(karg_base() + 160); } } out;
};
static_assert(sizeof(Args) == 184, "kernarg layout: in[20] | out @160 | ws @168 | ph_lo @176 | ph_hi @180");
enum { I_X = 0, I_WQKV, I_WO, I_WIN, I_VLNG, I_VLNB, I_WSP, I_BSP, I_WOUT, I_MLNG, I_MLNB, I_WGR, I_BGR, I_WER, I_BER, I_WG, I_WU, I_WDN, I_FLNG, I_FLNB };

struct Ctx { int tid, lane, wave, gw, NGW; LAS unsigned char* lds; unsigned char* ws; };
__device__ __forceinline__ Ctx phase_ctx(const Ctx& c) { Ctx d = c; int t = c.tid; asm volatile("" : "+v"(t)); d.tid = t; d.lane = t & 63; return d; }

typedef short v4i16_t __attribute__((ext_vector_type(4)));
__device__ __forceinline__ s16x4 lds_tr(LAS const unsigned char* p) { return __builtin_bit_cast(s16x4, __builtin_amdgcn_ds_read_tr16_b64_v4i16((LAS v4i16_t*)p)); }
__device__ __forceinline__ s16x4 lds_tr_asm(LAS const unsigned char* p) { s16x4 r; asm volatile("ds_read_b64_tr_b16 %0, %1" : "=v"(r) : "v"((unsigned)(size_t)p) : "memory"); return r; }

constexpr int TRP = 136;
__device__ __forceinline__ void tr_item(const float* __restrict__ src, int N, int k0, int n0, bf16* __restrict__ dst, int Kd, int drow0, float scale, LAS unsigned char* scr, int lane) {
    const int lk = lane >> 4, ln4 = (lane & 15) * 4;
    f32x4 v[16];
#pragma unroll
    for (int i = 0; i < 16; ++i) v[i] = *(const f32x4*)(src + (size_t)(k0 + 4 * i + lk) * N + n0 + ln4);
#pragma unroll
    for (int i = 0; i < 16; ++i) {
        u32x2 w; w.x = cvt_pk_bf16(v[i].x * scale, v[i].y * scale); w.y = cvt_pk_bf16(v[i].z * scale, v[i].w * scale);
        *(LAS u32x2*)(scr + (4 * i + lk) * TRP + ln4 * 2) = w;
    }
    asm volatile("s_waitcnt lgkmcnt(0)" ::: "memory");
    const int g = lane >> 4, i16 = lane & 15, q = i16 >> 2, p = i16 & 3;
#pragma unroll
    for (int t = 0; t < 8; ++t) {
        const int nb = 16 * (t >> 1), oct = (t & 1) * 4 + g;
        LAS const unsigned char* ad = scr + (8 * oct + q) * TRP + (nb + 4 * p) * 2;
        const s16x4 lo = lds_tr(ad), hi = lds_tr(ad + 4 * TRP);
        const bf16x8 o = __builtin_shufflevector(lo, hi, 0, 1, 2, 3, 4, 5, 6, 7);
        *(bf16x8*)(dst + (size_t)(drow0 + nb + i16) * Kd + k0 + 8 * oct) = o;
    }
    asm volatile("s_waitcnt lgkmcnt(0)" ::: "memory");
}

__device__ __forceinline__ void p0_prologue(const ArgsP& a, const Ctx& c) {
    LAS unsigned char* scr = c.lds + RING_OFF + c.wave * 16384;
    constexpr int T_QKV = 2 * (D / 64) * (3 * D / 64), T_WO = 2 * (D / 64) * (D / 64), T_WIN = 2 * (D / 64) * (GF / 64), T_WOUT = 2 * (GH / 64) * (D / 64);
    constexpr int T_G = DEPTH * NX * (D / 64) * (FE / 64), T_DN = DEPTH * NX * (FE / 64) * (D / 64);
    constexpr int NITEMS = T_QKV + T_WO + T_WIN + T_WOUT + ((MOE_DIRECT && FAST_MOE && !DBG_KEEP_CONV) ? 0 : 2 * T_G + T_DN);
    for (int it = c.gw; it < NITEMS; it += c.NGW) {
        int r = it;
        if (r < T_QKV) { const int per = (D / 64) * (3 * D / 64), j = r / per; r %= per; const int kb = r / (3 * D / 64), nb = r % (3 * D / 64);
            tr_item(a.in[I_WQKV] + (size_t)j * D * 3 * D, 3 * D, kb * 64, nb * 64, (bf16*)(a.ws + WS_WQKV) + (size_t)j * 3 * D * D, D, nb * 64, nb * 64 < D ? QSCALE : 1.0f, scr, c.lane); continue; }
        r -= T_QKV;
        if (r < T_WO) { const int per = (D / 64) * (D / 64), j = r / per; r %= per; const int kb = r / (D / 64), nb = r % (D / 64);
            tr_item(a.in[I_WO] + (size_t)j * D * D, D, kb * 64, nb * 64, (bf16*)(a.ws + WS_WO) + (size_t)j * D * D, D, nb * 64, 1.0f, scr, c.lane); continue; }
        r -= T_WO;
        if (r < T_WIN) { const int per = (D / 64) * (GF / 64), j = r / per; r %= per; const int kb = r / (GF / 64), nb = r % (GF / 64);
            tr_item(a.in[I_WIN] + (size_t)j * D * GF, GF, kb * 64, nb * 64, (bf16*)(a.ws + WS_WIN) + (size_t)j * GF * D, D, nb * 64, 1.0f, scr, c.lane); continue; }
        r -= T_WIN;
        if (r < T_WOUT) { const int per = (GH / 64) * (D / 64), j = r / per; r %= per; const int kb = r / (D / 64), nb = r % (D / 64);
            tr_item(a.in[I_WOUT] + (size_t)j * GH * D, D, kb * 64, nb * 64, (bf16*)(a.ws + WS_WOUT) + (size_t)j * D * GH, GH, nb * 64, 1.0f, scr, c.lane); continue; }
        r -= T_WOUT;
        if (r < 2 * T_G) { const int up = r >= T_G; if (up) r -= T_G; const int per = (D / 64) * (FE / 64), x = r / per; r %= per; const int kb = r / (FE / 64), nb = r % (FE / 64);
            const int f0 = nb * 64, drow = 256 * (f0 >> 7) + 128 * up + (f0 & 127);
            tr_item(a.in[up ? I_WU : I_WG] + (size_t)x * D * FE, FE, kb * 64, f0, (bf16*)(a.ws + WS_WGU) + (size_t)x * 1024 * D, D, drow, 1.0f, scr, c.lane); continue; }
        r -= 2 * T_G;
        { const int per = (FE / 64) * (D / 64), x = r / per; r %= per; const int kb = r / (D / 64), nb = r % (D / 64);
            tr_item(a.in[I_WDN] + (size_t)x * FE * D, D, kb * 64, nb * 64, (bf16*)(a.ws + WS_WD) + (size_t)x * D * FE, FE, nb * 64, 1.0f, scr, c.lane); }
    }
    {
        const int gt = blockIdx.x * NTHREADS + c.tid, GT = gridDim.x * NTHREADS;
        bf16* wr = (bf16*)(a.ws + WS_WR);
        for (int i = gt; i < DEPTH * 48 * D; i += GT) {
            const int k = i % D, rho = (i / D) % 48, L = i / (48 * D), nt = rho >> 4, g = (rho >> 2) & 3, ii = rho & 3;
            float v = 0.f;
            if (nt < 2) v = a.in[I_WER][((size_t)(L * NGRP + g) * D + k) * NEXP + 4 * nt + ii];
            else if (ii == 0) v = a.in[I_WGR][((size_t)L * D + k) * NGRP + g];
            wr[i] = (bf16)(cvt_pk_bf16(v, 0.f) & 0xffffu);
        }
        bf16* wsb = (bf16*)(a.ws + WS_WSPB);
        for (int i = gt; i < 2 * GG * CH * CH; i += GT) { const int s_ = i % CH, t_ = (i / CH) % CH; wsb[i] = (bf16)(cvt_pk_bf16(s_ <= t_ ? a.in[I_WSP][i] : 0.f, 0.f) & 0xffffu); }
        const f32x4* x4 = (const f32x4*)a.in[I_X]; u32x2* xb = (u32x2*)(a.ws + WS_XB);
        for (int i = gt; i < M * D / 4; i += GT) { const f32x4 v = x4[i]; u32x2 w; w.x = cvt_pk_bf16(v.x, v.y); w.y = cvt_pk_bf16(v.z, v.w); xb[i] = w; }
    }
}

#define MFMA16(a, b, c) __builtin_amdgcn_mfma_f32_16x16x32_bf16((a), (b), (c), 0, 0, 0)
__device__ __forceinline__ void sg_tile(const bf16* a0, const bf16* a1, const bf16* b0, const bf16* b1, const bf16* b2, const bf16* b3, int K, f32x4 (&acc)[2][4]) {
#pragma unroll
    for (int i = 0; i < 2; ++i)
#pragma unroll
        for (int j = 0; j < 4; ++j) acc[i][j] = (f32x4){0.f, 0.f, 0.f, 0.f};
    for (int k = 0; k < K; k += 32) {
        const bf16x8 fa0 = *(const bf16x8*)(a0 + k), fa1 = *(const bf16x8*)(a1 + k);
        const bf16x8 fb0 = *(const bf16x8*)(b0 + k), fb1 = *(const bf16x8*)(b1 + k), fb2 = *(const bf16x8*)(b2 + k), fb3 = *(const bf16x8*)(b3 + k);
        acc[0][0] = MFMA16(fb0, fa0, acc[0][0]); acc[0][1] = MFMA16(fb1, fa0, acc[0][1]); acc[0][2] = MFMA16(fb2, fa0, acc[0][2]); acc[0][3] = MFMA16(fb3, fa0, acc[0][3]);
        acc[1][0] = MFMA16(fb0, fa1, acc[1][0]); acc[1][1] = MFMA16(fb1, fa1, acc[1][1]); acc[1][2] = MFMA16(fb2, fa1, acc[1][2]); acc[1][3] = MFMA16(fb3, fa1, acc[1][3]);
    }
}
__device__ __forceinline__ void st_bf16x4(bf16* p, f32x4 v) { u32x2 w; w.x = cvt_pk_bf16(v.x, v.y); w.y = cvt_pk_bf16(v.z, v.w); *(u32x2*)p = w; }

template <int EPI>
__device__ __forceinline__ void sg_dense(const Ctx& c, const bf16* A, const bf16* Bt, int Mr, int N, int K, bf16* O) {
    const int fr = c.lane & 15, fq = c.lane >> 4, ntn = N / 64, ntiles = (Mr / 32) * ntn;
    for (int t = c.gw; t < ntiles; t += c.NGW) {
        const int m0 = (t / ntn) * 32, n0 = (t % ntn) * 64;
        f32x4 acc[2][4];
        const bf16* ap = A + (size_t)(m0 + fr) * K + 8 * fq; const bf16* bp = Bt + (size_t)(n0 + fr) * K + 8 * fq;
        sg_tile(ap, ap + (size_t)16 * K, bp, bp + (size_t)16 * K, bp + (size_t)32 * K, bp + (size_t)48 * K, K, acc);
#pragma unroll
        for (int mt = 0; mt < 2; ++mt)
#pragma unroll
            for (int nt = 0; nt < 4; ++nt) {
                const int row = m0 + 16 * mt + fr, col = n0 + 16 * nt + 4 * fq; f32x4 v = acc[mt][nt];
                if (EPI == 0) st_bf16x4(O + (size_t)row * N + col, v);
                if (EPI == 1) { const int w = col / D, cc = col % D; st_bf16x4(O + (size_t)w * ((WS_K - WS_Q) / 2) + (size_t)row * D + cc, v); }
                if (EPI == 2) { v.x = gelu_tanh(v.x); v.y = gelu_tanh(v.y); v.z = gelu_tanh(v.z); v.w = gelu_tanh(v.w); st_bf16x4(O + (size_t)row * N + col, v); }
            }
    }
}

__device__ __forceinline__ void moe_tables(const ArgsP& a, const Ctx& c, int L) {
    LAS int* tab = (LAS int*)(c.lds + TAB_OFF);
    if (c.tid < 64) {
        gu32* cnt = (gu32*)(a.ws + WS_CTL) + CW_CNT + L * 32 * CNT_STRIDE;
        const int e = c.lane & 31;
        const int cj = (int)__hip_atomic_load(cnt + e * CNT_STRIDE, RLX_AGENT), n = (cj + MOE_TR - 1) >> MOE_TSH;
        int incl = n;
#pragma unroll
        for (int o = 1; o < 32; o <<= 1) { const int t = __shfl_up(incl, o, 32); if (e >= o) incl += t; }
        const int base = incl - n;
        if (c.lane < 32) { tab[TB_BASE + e] = base; tab[TB_CNT + e] = cj; if (e == 31) tab[TB_BASE + 32] = incl; for (int i = 0; i < n; ++i) tab[base + i] = e; }
        const int np = (n + 1) >> 1; int pincl = np;
#pragma unroll
        for (int o = 1; o < 32; o <<= 1) { const int t = __shfl_up(pincl, o, 32); if (e >= o) pincl += t; }
        if (c.lane < 32) { const int pb = pincl - np; if (e == 31) tab[TB_NP] = pincl; for (int i = 0; i < np; ++i) tab[TB_PAIR + pb + i] = (base + 2 * i) | ((2 * i + 1 < n ? 2 : 1) << 16); }
    }
    __syncthreads();
}

__device__ __forceinline__ void sg_moe_gu(const ArgsP& a, const Ctx& c, int L) {
    LAS int* tab = (LAS int*)(c.lds + TAB_OFF);
    const int T = tab[TB_BASE + 32], fr = c.lane & 15, fq = c.lane >> 4, ntiles = T * (MOE_TR / 32) * 16;
    const bf16* xb = (const bf16*)(a.ws + WS_XB); const int* list = (const int*)(a.ws + WS_LIST); bf16* hp = (bf16*)(a.ws + WS_HP);
    for (int t = c.gw; t < ntiles; t += c.NGW) {
        const int rt = t / 16, fb = t % 16, prow0 = rt * 32, e = tab[prow0 >> MOE_TSH], ebase = MOE_TR * tab[TB_BASE + e], ecnt = tab[TB_CNT + e];
        const int p0 = prow0 - ebase + fr, p1 = p0 + 16;
        const int tok0 = p0 < ecnt ? (list[e * M + p0] >> 1) : 0, tok1 = p1 < ecnt ? (list[e * M + p1] >> 1) : 0;
        const bf16* w = (const bf16*)(a.ws + WS_WGU) + (size_t)(L * NX + e) * 1024 * D;
        const int vb = 256 * (fb >> 2) + 32 * (fb & 3);
        const bf16* bp = w + (size_t)(vb + fr) * D + 8 * fq;
        f32x4 acc[2][4];
        sg_tile(xb + (size_t)tok0 * D + 8 * fq, xb + (size_t)tok1 * D + 8 * fq, bp, bp + (size_t)16 * D, bp + (size_t)128 * D, bp + (size_t)144 * D, D, acc);
#pragma unroll
        for (int mt = 0; mt < 2; ++mt)
#pragma unroll
            for (int nt = 0; nt < 2; ++nt) {
                const f32x4 g = acc[mt][nt], u = acc[mt][nt + 2]; f32x4 h;
                h.x = silu(g.x) * u.x; h.y = silu(g.y) * u.y; h.z = silu(g.z) * u.z; h.w = silu(g.w) * u.w;
                st_bf16x4(hp + (size_t)(prow0 + 16 * mt + fr) * FE + 128 * (fb >> 2) + 32 * (fb & 3) + 16 * nt + 4 * fq, h);
            }
    }
}
__device__ __forceinline__ void sg_moe_dn(const ArgsP& a, const Ctx& c, int L) {
    LAS int* tab = (LAS int*)(c.lds + TAB_OFF);
    const int T = tab[TB_BASE + 32], fr = c.lane & 15, fq = c.lane >> 4, ntiles = T * (MOE_TR / 32) * (D / 64);
    const bf16* hp = (const bf16*)(a.ws + WS_HP); bf16* yp = (bf16*)(a.ws + WS_YP);
    for (int t = c.gw; t < ntiles; t += c.NGW) {
        const int rt = t / (D / 64), nb = t % (D / 64), prow0 = rt * 32, n0 = nb * 64, e = tab[prow0 >> MOE_TSH];
        const bf16* w = (const bf16*)(a.ws + WS_WD) + (size_t)(L * NX + e) * D * FE;
        const bf16* ap = hp + (size_t)(prow0 + fr) * FE + 8 * fq; const bf16* bp = w + (size_t)(n0 + fr) * FE + 8 * fq;
        f32x4 acc[2][4];
        sg_tile(ap, ap + (size_t)16 * FE, bp, bp + (size_t)16 * FE, bp + (size_t)32 * FE, bp + (size_t)48 * FE, FE, acc);
#pragma unroll
        for (int mt = 0; mt < 2; ++mt)
#pragma unroll
            for (int nt = 0; nt < 4; ++nt) st_bf16x4(yp + (size_t)(prow0 + 16 * mt + fr) * D + n0 + 16 * nt + 4 * fq, acc[mt][nt]);
    }
}

__device__ __forceinline__ void moe_gu_fast(const ArgsP& a, const Ctx& c, int L) {
    LAS int* tab = (LAS int*)(c.lds + TAB_OFF); LAS unsigned* toff = (LAS unsigned*)(c.lds + TOFF_OFF);
    const int G = gridDim.x, bx = blockIdx.x, vcu = (G % 8 == 0) ? (bx % 8) * (G / 8) + bx / 8 : bx;
    pg8::MoeOrder<true, 4> S; S.A = (const bf16*)(a.ws + WS_XB); S.W = (const bf16*)(a.ws + WS_WGU) + (size_t)L * NX * 1024 * D; S.K = D; S.wstride = (size_t)1024 * D;
    S.T = tab[TB_BASE + 32]; S.G = G; S.vcu = vcu; S.tab = tab; S.toff = toff;
    const int* list = (const int*)(a.ws + WS_LIST);
    pg8::Unit u;
    for (int i = 0; i < MAXGU && S.next(i, u); ++i)
        for (int r = c.tid; r < 256; r += NTHREADS) {
            const int pos = MOE_TR * (u.pm - tab[TB_BASE + u.e]) + r;
            const int tok = pos < tab[TB_CNT + u.e] ? (list[u.e * M + pos] >> 1) : 0;
            toff[i * 256 + r] = (unsigned)tok * (unsigned)(D * 2);
        }
    __syncthreads();
    pg8::EpiSwiglu E{(bf16*)(a.ws + WS_HP)};
    pg8::gemm_phase<pg8::EpiSwiglu, pg8::MoeOrder<true, 4>, true>(c.lds + RING_OFF, D, S, E);
}
__device__ __forceinline__ void moe_dn_fast(const ArgsP& a, const Ctx& c, int L) {
    LAS int* tab = (LAS int*)(c.lds + TAB_OFF);
    const int G = gridDim.x, bx = blockIdx.x, vcu = (G % 8 == 0) ? (bx % 8) * (G / 8) + bx / 8 : bx;
    pg8::MoeOrder<false, 8> S; S.A = (const bf16*)(a.ws + WS_HP); S.W = (const bf16*)(a.ws + WS_WD) + (size_t)L * NX * D * FE; S.K = FE; S.wstride = (size_t)D * FE;
    S.T = tab[TB_BASE + 32]; S.G = G; S.vcu = vcu; S.tab = tab; S.toff = nullptr;
    pg8::EpiBf16<0> E{(bf16*)(a.ws + WS_YP), D, 0, 0, nullptr, 0};
    pg8::gemm_phase<pg8::EpiBf16<0>, pg8::MoeOrder<false, 8>, true>(c.lds + RING_OFF, FE, S, E);
}
template <int ACT>
__device__ __forceinline__ void dense_fast(const Ctx& c, const bf16* A, const bf16* Bt, int N, int K, bf16* O, int split_cols, size_t split_stride, f32x2* part = nullptr, int part_pn0 = 0) {
    pg8::DenseOrder S; S.init(A, Bt, M, N, K, gridDim.x, blockIdx.x);
    pg8::EpiBf16<ACT> E{O, split_cols ? split_cols : N, split_cols, split_stride, part, part_pn0};
    pg8::gemm_phase<pg8::EpiBf16<ACT>, pg8::DenseOrder, true>(c.lds + RING_OFF, K, S, E);
}

namespace mg {
constexpr int ASTG = 16384, NAST = 4, BBASE = NAST * ASTG, BSTG = 32768;
template <int MODE  , int VAR = 0  , bool DYN = false  >
__device__ __forceinline__ void moe_direct(const ArgsP& a, const Ctx& c, int L) {
    LAS int* tab = (LAS int*)(c.lds + TAB_OFF); LAS unsigned* toff = (LAS unsigned*)(c.lds + TOFF_OFF);
    LAS unsigned char* ring = c.lds + RING_OFF;
    int tid_ = threadIdx.x; asm volatile("" : "+v"(tid_));
    const int tid = tid_, wid = __builtin_amdgcn_readfirstlane(tid >> 6), lane = tid & 63, wr = wid >> 2, wc = wid & 3, fr = lane & 15, fq = lane >> 4;
    constexpr int K = MODE == 0 ? D : FE, nk = K / 64, NPN = MODE == 0 ? 4 : 8, ldb = MODE == 0 ? FE : D;
    const int T = __builtin_amdgcn_readfirstlane(tab[TB_BASE + 32]), G = gridDim.x, bx = blockIdx.x, vcu = (G % 8 == 0) ? (bx % 8) * (G / 8) + bx / 8 : bx, NU = T * NPN;
    if (MODE == 0) {
        const int* list = (const int*)(a.ws + WS_LIST);
        for (int i = 0; i < 16; ++i) { const int idx = i * G + vcu; if (idx >= NU) break;
            const int rt = DYN ? (idx >> 2) : idx % T, e = tab[rt];
            if (tid < 128) { const int pos = MOE_TR * (rt - tab[TB_BASE + e]) + tid; const int tok = pos < tab[TB_CNT + e] ? (list[e * M + pos] >> 1) : 0; toff[i * 128 + tid] = (unsigned)tok * (unsigned)(D * 2); } }
        __syncthreads();
    }
    int RA[2], CA[2];
#pragma unroll
    for (int i = 0; i < 2; ++i) pg8::stage_rc(tid * 16 + i * 8192, RA[i], CA[i]);
    const int aoff = pg8::lds_byte(wr * 64 + fr, fq * 8);
    const int n4 = MODE == 0 ? (lane & 31) + 32 * (wid & 1) : lane, kr = MODE == 0 ? 2 * (wid >> 1) + (lane >> 5) : wid;
    const unsigned bvoff = MODE == 0 ? (unsigned)(((lane >> 5) * ldb + 4 * (lane & 31)) * 4) : (unsigned)(lane * 16);
    const unsigned bw0 = (unsigned)(kr * 512 + ((n4 ^ ((kr & 3) << 2)) << 3)), bw1 = (unsigned)(kr * 512 + ((n4 ^ (((kr & 3) | 4) << 2)) << 3));
    const int kq = lane >> 4, q4 = (lane & 15) >> 2, p4 = lane & 3, fxl = (q4 | ((kq & 1) << 2)) << 2;
    unsigned boffr[4];
#pragma unroll
    for (int nt = 0; nt < 4; ++nt) { const int g0 = MODE == 0 ? (nt < 2 ? 8 * wc + 4 * nt : 32 + 8 * wc + 4 * (nt - 2)) : 16 * wc + 4 * nt; boffr[nt] = (unsigned)((8 * kq + q4) * 512 + (((g0 + p4) ^ fxl) << 3)); }
    const unsigned ldsw = (unsigned)wid * 1024u;
    gu32* done = (gu32*)(a.ws + WS_CTL) + CW_DONE + L * 256 * DONE_STRIDE; gu32* qhead = (gu32*)(a.ws + WS_CTL) + CW_QDN + L * 64; gu32* tmo = (gu32*)(a.ws + WS_CTL) + CW_TMO;
    for (int ui = 0; ui < (DYN && MODE == 1 ? 0x7fffffff : 16); ++ui) {
        int idx;
        if (DYN && MODE == 1) {
            if (tid == 0) tab[300] = (int)__hip_atomic_fetch_add(qhead, 1u, RLX_AGENT);
            __syncthreads();
            idx = __builtin_amdgcn_readfirstlane(tab[300]); if (idx >= NU) break;
            if (wid == 0) { unsigned sp = 0;
                while (__hip_atomic_load(done + (idx >> 3) * DONE_STRIDE, RLX_AGENT) < 32u) { __builtin_amdgcn_s_sleep(1); if (++sp > (1u << 22)) { if (lane == 0) __hip_atomic_store(tmo, 1u, RLX_AGENT); break; } }
                __builtin_amdgcn_fence(__ATOMIC_ACQUIRE, "agent"); asm volatile("s_waitcnt vmcnt(0)" ::: "memory"); }
            __syncthreads();
        } else { idx = ui * G + vcu; if (idx >= NU) break; }
        const int pn = (DYN && MODE == 1) ? (idx & 7) : (DYN ? (idx & 3) : idx / T), rt = (DYN && MODE == 1) ? (idx >> 3) : (DYN ? (idx >> 2) : idx % T), e = __builtin_amdgcn_readfirstlane(tab[rt]), prow0 = rt * MOE_TR;
        const char* abase; unsigned va[2];
        if (MODE == 0) { abase = (const char*)(a.ws + WS_XB); va[0] = toff[ui * 128 + RA[0]] + (unsigned)CA[0] * 2u; va[1] = toff[ui * 128 + RA[1]] + (unsigned)CA[1] * 2u; }
        else { abase = (const char*)(a.ws + WS_HP) + (size_t)prow0 * FE * 2; va[0] = (unsigned)(RA[0] * FE + CA[0]) * 2u; va[1] = (unsigned)(RA[1] * FE + CA[1]) * 2u; }
        const float* wsrc;
        if (MODE == 0) wsrc = a.in[(wid & 1) ? I_WU : I_WG] + (size_t)(L * NX + e) * D * FE + 128 * pn + (size_t)(2 * (wid >> 1)) * ldb;
        else wsrc = a.in[I_WDN] + (size_t)(L * NX + e) * FE * D + 256 * pn + (size_t)wid * ldb;
        { const unsigned long long wq = (unsigned long long)wsrc; const unsigned wlo = __builtin_amdgcn_readfirstlane((unsigned)wq), whi = __builtin_amdgcn_readfirstlane((unsigned)(wq >> 32));
          wsrc = (const float*)(((unsigned long long)whi << 32) | wlo); }
        f32x4 acc[4][4];
#pragma unroll
        for (int m = 0; m < 4; ++m)
#pragma unroll
            for (int n = 0; n < 4; ++n) acc[m][n] = (f32x4){0.f, 0.f, 0.f, 0.f};
        f32x4 br0[8], br1[8];
#define MG_LOADB(dst, kt) do { if (VAR & 1) break; _Pragma("unroll") for (int _i = 0; _i < 8; ++_i) { const float* _q = wsrc + (size_t)((kt) * 64 + 8 * _i) * ldb; asm volatile("global_load_dwordx4 %0, %1, %2" : "=v"(dst[_i]) : "v"(bvoff), "s"(_q) : "memory"); } } while (0)
#define MG_WAIT(N, r) asm volatile("s_waitcnt vmcnt(" #N ") lgkmcnt(0)" : "+v"(r[0]), "+v"(r[1]), "+v"(r[2]), "+v"(r[3]), "+v"(r[4]), "+v"(r[5]), "+v"(r[6]), "+v"(r[7]) :: "memory")
#define MG_WRITEB(src, st) do { if (VAR & 8) break; _Pragma("unroll") for (int _i = 0; _i < 8; ++_i) { u32x2 _w; _w.x = cvt_pk_bf16(src[_i].x, src[_i].y); _w.y = cvt_pk_bf16(src[_i].z, src[_i].w); \
        *(LAS u32x2*)(ring + BBASE + (st) * BSTG + _i * 4096 + ((_i & 1) ? bw1 : bw0)) = _w; } } while (0)
#define MG_DMAA(kt, st) do { if (VAR & 2) break; _Pragma("unroll") for (int _i = 0; _i < 2; ++_i) \
        __builtin_amdgcn_global_load_lds((const unsigned*)(abase + (size_t)(kt) * 128 + va[_i]), (LAS unsigned*)(ring + (st) * ASTG + ldsw + _i * 8192), 16, 0, 0); } while (0)
#define MG_READ(sb) do { \
        _Pragma("unroll") for (int kk = 0; kk < 2; ++kk) { const unsigned _b = (unsigned)(size_t)(ring + BBASE + (sb) * BSTG + kk * 16384); s16x4 _l0, _h0, _l1, _h1, _l2, _h2, _l3, _h3; \
            asm volatile("ds_read_b64_tr_b16 %0, %8\n\tds_read_b64_tr_b16 %1, %8 offset:2048\n\tds_read_b64_tr_b16 %2, %9\n\tds_read_b64_tr_b16 %3, %9 offset:2048\n\t" \
                         "ds_read_b64_tr_b16 %4, %10\n\tds_read_b64_tr_b16 %5, %10 offset:2048\n\tds_read_b64_tr_b16 %6, %11\n\tds_read_b64_tr_b16 %7, %11 offset:2048" \
                         : "=&v"(_l0), "=&v"(_h0), "=&v"(_l1), "=&v"(_h1), "=&v"(_l2), "=&v"(_h2), "=&v"(_l3), "=&v"(_h3) \
                         : "v"(_b + boffr[0]), "v"(_b + boffr[1]), "v"(_b + boffr[2]), "v"(_b + boffr[3]) : "memory"); \
            Bf[kk][0] = __builtin_shufflevector(_l0, _h0, 0, 1, 2, 3, 4, 5, 6, 7); Bf[kk][1] = __builtin_shufflevector(_l1, _h1, 0, 1, 2, 3, 4, 5, 6, 7); \
            Bf[kk][2] = __builtin_shufflevector(_l2, _h2, 0, 1, 2, 3, 4, 5, 6, 7); Bf[kk][3] = __builtin_shufflevector(_l3, _h3, 0, 1, 2, 3, 4, 5, 6, 7); } } while (0)
#define MG_PIN() asm volatile("" : "+v"(Bf[0][0]), "+v"(Bf[0][1]), "+v"(Bf[0][2]), "+v"(Bf[0][3]), "+v"(Bf[1][0]), "+v"(Bf[1][1]), "+v"(Bf[1][2]), "+v"(Bf[1][3]) :: "memory")
#define MG_MMA(sa) do { bf16x8 Af[2][4]; \
        _Pragma("unroll") for (int kk = 0; kk < 2; ++kk) _Pragma("unroll") for (int m = 0; m < 4; ++m) Af[kk][m] = *(const LAS bf16x8*)(ring + (sa) * ASTG + aoff + m * 2048 + kk * 1024); \
        __builtin_amdgcn_s_setprio(1); \
        _Pragma("unroll") for (int kk = 0; kk < 2; ++kk) _Pragma("unroll") for (int m = 0; m < 4; ++m) _Pragma("unroll") for (int n = 0; n < 4; ++n) { if (!(VAR & 4)) acc[m][n] = MFMA16(Bf[kk][n], Af[kk][m], acc[m][n]); else acc[m][n][0] += __builtin_bit_cast(float, (int)Bf[kk][n][0] + (int)Af[kk][m][0]); } \
        __builtin_amdgcn_s_setprio(0); } while (0)
#define MG_BAR() do { asm volatile("" ::: "memory"); __builtin_amdgcn_s_barrier(); asm volatile("" ::: "memory"); __builtin_amdgcn_sched_barrier(0); } while (0)
        bf16x8 Bf[2][4];
        MG_LOADB(br0, 0); MG_LOADB(br1, 1); MG_DMAA(0, 0); MG_DMAA(1, 1);
        MG_WAIT(12, br0);
        MG_WRITEB(br0, 0);
        __builtin_amdgcn_sched_barrier(0);
        MG_LOADB(br0, 2);
        MG_WAIT(10, br1);
        MG_BAR();
        if (wr == 1) MG_BAR();
#pragma unroll
        for (int kt = 0; kt < nk; ++kt) {
            MG_READ(kt & 1);
            if (kt + 1 < nk) { if ((kt & 1) == 0) MG_WRITEB(br1, 1); else MG_WRITEB(br0, 0); }
            if (kt + 2 < nk) MG_DMAA(kt + 2, (kt + 2) % NAST);
            __builtin_amdgcn_sched_barrier(0);
            if (kt + 3 < nk) { if ((kt & 1) == 0) MG_LOADB(br1, kt + 3); else MG_LOADB(br0, kt + 3); }
            __builtin_amdgcn_sched_barrier(0);
            if ((kt & 1) == 0) { if (kt + 3 < nk) MG_WAIT(10, br0); else if (kt + 2 < nk) MG_WAIT(2, br0); else MG_WAIT(0, br0); }
            else               { if (kt + 3 < nk) MG_WAIT(10, br1); else if (kt + 2 < nk) MG_WAIT(2, br1); else MG_WAIT(0, br1); }
            MG_PIN();
            MG_BAR();
            MG_MMA(kt % NAST);
            MG_BAR();
        }
        if (wr == 0) MG_BAR();
#undef MG_READ
#undef MG_PIN
#undef MG_MMA
#undef MG_BAR
#undef MG_LOADB
#undef MG_WAIT
#undef MG_WRITEB
#undef MG_DMAA
        if (MODE == 0) {
            bf16* H = VAR ? (bf16*)(a.ws + WS_Z) : (bf16*)(a.ws + WS_HP);
#pragma unroll
            for (int m = 0; m < 4; ++m)
#pragma unroll
                for (int nt = 0; nt < 2; ++nt) { const f32x4 g = acc[m][nt], up = acc[m][nt + 2]; f32x4 hh;
                    hh.x = g.x * fast_rcp(1.f + fast_exp2(g.x * -1.4426950408889634f)) * up.x; hh.y = g.y * fast_rcp(1.f + fast_exp2(g.y * -1.4426950408889634f)) * up.y;
                    hh.z = g.z * fast_rcp(1.f + fast_exp2(g.z * -1.4426950408889634f)) * up.z; hh.w = g.w * fast_rcp(1.f + fast_exp2(g.w * -1.4426950408889634f)) * up.w;
                    bf16* hp_ = H + (size_t)(prow0 + 64 * wr + 16 * m + fr) * FE + 128 * pn + 32 * wc + 16 * nt + 4 * fq;
                    if (DYN) { const unsigned long long pk_ = (unsigned long long)cvt_pk_bf16(hh.x, hh.y) | ((unsigned long long)cvt_pk_bf16(hh.z, hh.w) << 32);
                        __hip_atomic_store((GAS unsigned long long*)hp_, pk_, RLX_AGENT); }
                    else st_bf16x4(hp_, hh); }
            if (DYN) { asm volatile("s_waitcnt vmcnt(0)" ::: "memory"); if (lane == 0) __hip_atomic_fetch_add(done + rt * DONE_STRIDE, 1u, RLX_AGENT); }
        } else {
            bf16* Y = VAR ? (bf16*)(a.ws + WS_Z) + 16 * 1048576 : (bf16*)(a.ws + WS_YP);
#pragma unroll
            for (int m = 0; m < 4; ++m)
#pragma unroll
                for (int nt = 0; nt < 4; ++nt) st_bf16x4(Y + (size_t)(prow0 + 64 * wr + 16 * m + fr) * D + 256 * pn + 64 * wc + 16 * nt + 4 * fq, acc[m][nt]);
        }
    }
}
}

namespace mg3 {
constexpr int ASUB = 8192, ASTG = 16384, NAST = 3, BBASE = NAST * ASTG, BSTG = 16384;
template <int MODE  >
__device__ __forceinline__ void moe_pairs(const ArgsP& a, const Ctx& c, int L) {
    constexpr bool GU = MODE != 1;
    LAS int* tab = (LAS int*)(c.lds + TAB_OFF); LAS unsigned* toff = (LAS unsigned*)(c.lds + TOFF_OFF);
    LAS unsigned char* ring = c.lds + RING_OFF;
    int tid_ = threadIdx.x; asm volatile("" : "+v"(tid_));
    const int tid = tid_, wid = __builtin_amdgcn_readfirstlane(tid >> 6), lane = tid & 63, wr = wid >> 2, wc = wid & 3, fr = lane & 15, fq = lane >> 4;
    constexpr int nk = MODE == 0 ? D / 32 : MODE == 2 ? D / 64 : FE / 32, NPN = GU ? 4 : 8, ldb = GU ? FE : D;
    const int NP = __builtin_amdgcn_readfirstlane(tab[TB_NP]), G = gridDim.x, bx = blockIdx.x, vcu = (G % 8 == 0) ? (bx % 8) * (G / 8) + bx / 8 : bx, NU = NP * NPN;
    const int nround = (NU + 255) >> 8, rlast = NU - ((nround - 1) << 8); const bool ksplit = GU && G == 256 && nround >= 2 && rlast <= 128;
    const int nfull = nround - (ksplit ? 1 : 0);
    if (MODE == 2 && (!ksplit || vcu >= 2 * rlast)) return;
    const int khalf = MODE == 2 ? (vcu & 1) : 0;
    if (GU) {
        const int* list = (const int*)(a.ws + WS_LIST);
        for (int i = 0; i < (MODE == 2 ? 1 : MAXGU); ++i) { const int idx = MODE == 2 ? (nround - 1) * G + (vcu >> 1) : i * G + vcu; if (MODE == 0 && (i >= nfull || idx >= NU)) break;
            const int pw = tab[TB_PAIR + (idx >> 2)], rt0 = pw & 0xffff, e = tab[rt0];
            if (tid < 256) { const int pos = MOE_TR * (rt0 - tab[TB_BASE + e]) + tid; const int tok = pos < tab[TB_CNT + e] ? (list[e * M + pos] >> 1) : 0; toff[i * 256 + tid] = (unsigned)tok * (unsigned)(D * 2); } }
        __syncthreads();
    }
    const int aoff = (wr * 64 + fr) * 64 + 16 * (fq ^ ((fr >> 2) & 3));
    const int n4 = GU ? (lane & 31) + 32 * (wid & 1) : lane, kr = GU ? 2 * (wid >> 1) + (lane >> 5) : wid;
    const unsigned bvoff = GU ? (unsigned)(((lane >> 5) * ldb + 4 * (lane & 31)) * 4) : (unsigned)(lane * 16);
    const unsigned bw0 = (unsigned)(kr * 512 + ((n4 ^ ((kr & 3) << 2)) << 3));
    const int kq = lane >> 4, q4 = (lane & 15) >> 2, p4 = lane & 3, fxl = (q4 | ((kq & 1) << 2)) << 2;
    const int g00 = GU ? 8 * wc : 16 * wc;
    const unsigned boffr0 = (unsigned)((8 * kq + q4) * 512 + (((g00 + p4) ^ fxl) << 3));
    const unsigned ldsw = (unsigned)wid * 1024u;
    gu32* done = (gu32*)(a.ws + WS_CTL) + CW_DONE + L * 256 * DONE_STRIDE; gu32* qhead = (gu32*)(a.ws + WS_CTL) + CW_QDN + L * 64; gu32* tmo = (gu32*)(a.ws + WS_CTL) + CW_TMO;
    for (int ui = 0; ui < (MODE == 1 ? 0x7fffffff : MAXGU); ++ui) {
        int idx;
        if (MODE == 1) {
            if (tid == 0) tab[300] = (int)__hip_atomic_fetch_add(qhead, 1u, RLX_AGENT);
            __syncthreads();
            idx = __builtin_amdgcn_readfirstlane(tab[300]); if (idx >= NU) break;
            if (wid == 0) { unsigned sp = 0;
                while (__hip_atomic_load(done + (idx >> 3) * DONE_STRIDE, RLX_AGENT) < 32u) { __builtin_amdgcn_s_sleep(1); if (++sp > (1u << 22)) { if (lane == 0) __hip_atomic_store(tmo, 1u, RLX_AGENT); break; } }
                __builtin_amdgcn_fence(__ATOMIC_ACQUIRE, "agent"); asm volatile("s_waitcnt vmcnt(0)" ::: "memory"); }
            __syncthreads();
        } else if (MODE == 2) { if (ui > 0) break; idx = (nround - 1) * G + (vcu >> 1); }
        else { idx = ui * G + vcu; if (ui >= nfull || idx >= NU) break; }
        const int pair = MODE == 1 ? (idx >> 3) : (idx >> 2), pn = MODE == 1 ? (idx & 7) : (idx & 3);
        const int pw = __builtin_amdgcn_readfirstlane(tab[TB_PAIR + pair]), rt0 = pw & 0xffff, nsub = pw >> 16, e = __builtin_amdgcn_readfirstlane(tab[rt0]), prow0 = rt0 * MOE_TR;
        int t1_ = threadIdx.x; asm volatile("" : "+v"(t1_));
        const int RA = t1_ >> 2, CA = 8 * ((t1_ & 3) ^ ((RA >> 2) & 3));
        const char* abase; unsigned va[2];
#pragma unroll
        for (int sb = 0; sb < 2; ++sb) va[sb] = GU ? toff[ui * 256 + 128 * sb + RA] + (unsigned)CA * 2u : (unsigned)((128 * sb + RA) * FE + CA) * 2u;
        if (GU) abase = (const char*)(a.ws + WS_XB) + khalf * (nk * 64); else abase = (const char*)(a.ws + WS_HP) + (size_t)prow0 * FE * 2;
        const float* wsrc;
        if (GU) wsrc = a.in[(wid & 1) ? I_WU : I_WG] + (size_t)(L * NX + e) * D * FE + 128 * pn + (size_t)(2 * (wid >> 1) + khalf * (nk * 32)) * ldb;
        else wsrc = a.in[I_WDN] + (size_t)(L * NX + e) * FE * D + 256 * pn + (size_t)wid * ldb;
        { const unsigned long long wq = (unsigned long long)wsrc; const unsigned wlo = __builtin_amdgcn_readfirstlane((unsigned)wq), whi = __builtin_amdgcn_readfirstlane((unsigned)(wq >> 32));
          wsrc = (const float*)(((unsigned long long)whi << 32) | wlo); }
        f32x4 acc[2][4][4];
#pragma unroll
        for (int sb = 0; sb < 2; ++sb)
#pragma unroll
            for (int m = 0; m < 4; ++m)
#pragma unroll
                for (int n = 0; n < 4; ++n) acc[sb][m][n] = (f32x4){0.f, 0.f, 0.f, 0.f};
        f32x4 br0[4], br1[4];
#define M3_LOADB(dst, kt) do { const float* _w = wsrc + (size_t)((kt) * 32) * ldb; asm volatile("" : "+s"(_w));     \
        _Pragma("unroll") for (int _i = 0; _i < 4; ++_i) { const float* _q = _w + (size_t)(8 * _i) * ldb; asm volatile("global_load_dwordx4 %0, %1, %2" : "=v"(dst[_i]) : "v"(bvoff), "s"(_q) : "memory"); } } while (0)
#define M3_WAIT(N, r) asm volatile("s_waitcnt vmcnt(" #N ") lgkmcnt(0)" : "+v"(r[0]), "+v"(r[1]), "+v"(r[2]), "+v"(r[3]) :: "memory")
#define M3_WRITEB(src, st) do { _Pragma("unroll") for (int _i = 0; _i < 4; ++_i) { u32x2 _w; _w.x = cvt_pk_bf16(src[_i].x, src[_i].y); _w.y = cvt_pk_bf16(src[_i].z, src[_i].w); \
        *(LAS u32x2*)(ring + BBASE + (st) * BSTG + _i * 4096 + ((_i & 1) ? (bw0 ^ 128u) : bw0)) = _w; } } while (0)
#define M3_DMAA(kt, st) do { _Pragma("unroll") for (int _s = 0; _s < 2; ++_s) \
        __builtin_amdgcn_global_load_lds((const unsigned*)(abase + (size_t)(kt) * 64 + va[_s]), (LAS unsigned*)(ring + (st) * ASTG + _s * ASUB + ldsw), 16, 0, 0); } while (0)
#define M3_BOFF(nt) (GU ? ((boffr0 ^ (32u * ((nt) & 1))) + 256u * ((nt) >> 1)) : (boffr0 ^ (32u * (nt))))
#define M3_READ(sa, sbf) do { \
        { const unsigned _b = (unsigned)(size_t)(ring + BBASE + (sbf) * BSTG); s16x4 _l0, _h0, _l1, _h1, _l2, _h2, _l3, _h3; \
            asm volatile("ds_read_b64_tr_b16 %0, %8\n\tds_read_b64_tr_b16 %1, %8 offset:2048\n\tds_read_b64_tr_b16 %2, %9\n\tds_read_b64_tr_b16 %3, %9 offset:2048\n\t" \
                         "ds_read_b64_tr_b16 %4, %10\n\tds_read_b64_tr_b16 %5, %10 offset:2048\n\tds_read_b64_tr_b16 %6, %11\n\tds_read_b64_tr_b16 %7, %11 offset:2048" \
                         : "=&v"(_l0), "=&v"(_h0), "=&v"(_l1), "=&v"(_h1), "=&v"(_l2), "=&v"(_h2), "=&v"(_l3), "=&v"(_h3) \
                         : "v"(_b + M3_BOFF(0)), "v"(_b + M3_BOFF(1)), "v"(_b + M3_BOFF(2)), "v"(_b + M3_BOFF(3)) : "memory"); \
            Bf[0] = __builtin_shufflevector(_l0, _h0, 0, 1, 2, 3, 4, 5, 6, 7); Bf[1] = __builtin_shufflevector(_l1, _h1, 0, 1, 2, 3, 4, 5, 6, 7); \
            Bf[2] = __builtin_shufflevector(_l2, _h2, 0, 1, 2, 3, 4, 5, 6, 7); Bf[3] = __builtin_shufflevector(_l3, _h3, 0, 1, 2, 3, 4, 5, 6, 7); } \
        _Pragma("unroll") for (int m = 0; m < 4; ++m) Af[m] = *(const LAS bf16x8*)(ring + (sa) * ASTG + aoff + m * 1024); \
        if (nsub == 2) { _Pragma("unroll") for (int m = 0; m < 4; ++m) Ag[m] = *(const LAS bf16x8*)(ring + (sa) * ASTG + ASUB + aoff + m * 1024); } } while (0)
#define M3_PIN() asm volatile("" : "+v"(Bf[0]), "+v"(Bf[1]), "+v"(Bf[2]), "+v"(Bf[3]), "+v"(Af[0]), "+v"(Af[1]), "+v"(Af[2]), "+v"(Af[3]), "+v"(Ag[0]), "+v"(Ag[1]), "+v"(Ag[2]), "+v"(Ag[3]) :: "memory")
#define M3_MMA() do { __builtin_amdgcn_s_setprio(1); \
        _Pragma("unroll") for (int m = 0; m < 4; ++m) _Pragma("unroll") for (int n = 0; n < 4; ++n) acc[0][m][n] = MFMA16(Bf[n], Af[m], acc[0][m][n]); \
        if (nsub == 2) { _Pragma("unroll") for (int m = 0; m < 4; ++m) _Pragma("unroll") for (int n = 0; n < 4; ++n) acc[1][m][n] = MFMA16(Bf[n], Ag[m], acc[1][m][n]); } \
        __builtin_amdgcn_s_setprio(0); } while (0)
#define M3_BAR() do { asm volatile("" ::: "memory"); __builtin_amdgcn_s_barrier(); asm volatile("" ::: "memory"); __builtin_amdgcn_sched_barrier(0); } while (0)
        bf16x8 Bf[4], Af[4], Ag[4];
#pragma unroll
        for (int m = 0; m < 4; ++m) Ag[m] = (bf16x8){0, 0, 0, 0, 0, 0, 0, 0};
        M3_LOADB(br0, 0); M3_LOADB(br1, 1); M3_DMAA(0, 0); M3_DMAA(1, 1);
        M3_WAIT(8, br0);
        M3_WRITEB(br0, 0);
        __builtin_amdgcn_sched_barrier(0);
        M3_LOADB(br0, 2);
        M3_WAIT(6, br1);
        M3_BAR();
        if (wr == 1) M3_BAR();
#pragma unroll
        for (int kt = 0; kt < nk; ++kt) {
            M3_READ(kt % NAST, kt & 1);
            if (kt + 1 < nk) { if ((kt & 1) == 0) M3_WRITEB(br1, 1); else M3_WRITEB(br0, 0); }
            if (kt + 2 < nk) M3_DMAA(kt + 2, (kt + 2) % NAST);
            __builtin_amdgcn_sched_barrier(0);
            if (kt + 3 < nk) { if ((kt & 1) == 0) M3_LOADB(br1, kt + 3); else M3_LOADB(br0, kt + 3); }
            __builtin_amdgcn_sched_barrier(0);
            if ((kt & 1) == 0) { if (kt + 3 < nk) M3_WAIT(6, br0); else if (kt + 2 < nk) M3_WAIT(2, br0); else M3_WAIT(0, br0); }
            else               { if (kt + 3 < nk) M3_WAIT(6, br1); else if (kt + 2 < nk) M3_WAIT(2, br1); else M3_WAIT(0, br1); }
            M3_PIN();
            M3_BAR();
            M3_MMA();
            M3_BAR();
        }
        if (wr == 0) M3_BAR();
#undef M3_LOADB
#undef M3_WAIT
#undef M3_WRITEB
#undef M3_DMAA
#undef M3_BOFF
#undef M3_READ
#undef M3_PIN
#undef M3_MMA
#undef M3_BAR
        int t2_ = threadIdx.x; asm volatile("" : "+v"(t2_)); const int fre = t2_ & 15, fqe = (t2_ & 63) >> 4;
        if (MODE == 2) {
            float* pbuf = (float*)(a.ws + WS_Z) + ((size_t)(vcu >> 1) * 8 + (t2_ >> 6)) * (32 * 256) + (t2_ & 63) * 4;
            gu32* pflag = (gu32*)(a.ws + WS_CTL) + CW_PFLAG + (L * 128 + (vcu >> 1)) * 32;
            if (khalf == 1) {
#pragma unroll
                for (int sb = 0; sb < 2; ++sb) if (sb < nsub) {
#pragma unroll
                    for (int m = 0; m < 4; ++m)
#pragma unroll
                        for (int n = 0; n < 4; ++n) { float* q_ = pbuf + ((sb * 4 + m) * 4 + n) * 256; asm volatile("global_store_dwordx4 %0, %1, off sc1\n\ts_nop 1" :: "v"(q_), "v"(acc[sb][m][n]) : "memory"); } }
                asm volatile("s_waitcnt vmcnt(0)" ::: "memory");
                if ((t2_ & 63) == 0) __hip_atomic_fetch_add(pflag, 1u, RLX_AGENT);
                break;
            }
            if ((t2_ >> 6) == 0) { unsigned sp = 0;
              while (__hip_atomic_load(pflag, RLX_AGENT) < 8u) { __builtin_amdgcn_s_sleep(1); if (++sp > (1u << 22)) { if ((t2_ & 63) == 0) __hip_atomic_store(tmo, 1u, RLX_AGENT); break; } }
              __builtin_amdgcn_fence(__ATOMIC_ACQUIRE, "agent"); asm volatile("s_waitcnt vmcnt(0)" ::: "memory"); }
            __syncthreads();
#pragma unroll
            for (int sb = 0; sb < 2; ++sb) if (sb < nsub) {
#pragma unroll
                for (int m = 0; m < 4; ++m)
#pragma unroll
                    for (int n = 0; n < 4; ++n) acc[sb][m][n] += *(const f32x4*)(pbuf + ((sb * 4 + m) * 4 + n) * 256); }
        }
#pragma unroll
        for (int sb = 0; sb < 2; ++sb) if (sb < nsub) {
            if (GU) {
                bf16* H = (bf16*)(a.ws + WS_HP);
#pragma unroll
                for (int m = 0; m < 4; ++m)
                    { unsigned hx_[2], hy_[2];
#pragma unroll
                      for (int nt = 0; nt < 2; ++nt) { const f32x4 g = acc[sb][m][nt], up = acc[sb][m][nt + 2]; f32x4 hh;
                        hh.x = g.x * fast_rcp(1.f + fast_exp2(g.x * -1.4426950408889634f)) * up.x; hh.y = g.y * fast_rcp(1.f + fast_exp2(g.y * -1.4426950408889634f)) * up.y;
                        hh.z = g.z * fast_rcp(1.f + fast_exp2(g.z * -1.4426950408889634f)) * up.z; hh.w = g.w * fast_rcp(1.f + fast_exp2(g.w * -1.4426950408889634f)) * up.w;
                        hx_[nt] = cvt_pk_bf16(hh.x, hh.y); hy_[nt] = cvt_pk_bf16(hh.z, hh.w); }
                      const auto sx_ = __builtin_amdgcn_permlane16_swap(hx_[0], hx_[1], false, false), sy_ = __builtin_amdgcn_permlane16_swap(hy_[0], hy_[1], false, false);
                      u32x4 w_; w_.x = sx_[0]; w_.y = sy_[0]; w_.z = sx_[1]; w_.w = sy_[1];
                      bf16* hp_ = H + (size_t)(prow0 + 128 * sb + 64 * wr + 16 * m + fre) * FE + 128 * pn + 32 * wc + 16 * (fqe & 1) + 4 * (fqe & 2);
                      asm volatile("global_store_dwordx4 %0, %1, off sc1\n\ts_nop 1" :: "v"(hp_), "v"(w_) : "memory"); }
            } else {
                bf16* Y = (bf16*)(a.ws + WS_YP);
#pragma unroll
                for (int m = 0; m < 4; ++m)
#pragma unroll
                    for (int nt = 0; nt < 4; nt += 2) {
                        const f32x4 va_ = acc[sb][m][nt], vb_ = acc[sb][m][nt + 1];
                        const unsigned ax = cvt_pk_bf16(va_.x, va_.y), ay = cvt_pk_bf16(va_.z, va_.w), bx = cvt_pk_bf16(vb_.x, vb_.y), by = cvt_pk_bf16(vb_.z, vb_.w);
                        const auto sx = __builtin_amdgcn_permlane16_swap(ax, bx, false, false), sy = __builtin_amdgcn_permlane16_swap(ay, by, false, false);
                        u32x4 w; w.x = sx[0]; w.y = sy[0]; w.z = sx[1]; w.w = sy[1];
                        *(u32x4*)(Y + (size_t)(prow0 + 128 * sb + 64 * wr + 16 * m + fre) * D + 256 * pn + 64 * wc + 16 * (nt + (fqe & 1)) + 4 * (fqe & 2)) = w; }
            }
        }
        if (GU) { asm volatile("s_waitcnt vmcnt(0)" ::: "memory"); if ((t2_ & 63) == 0) __hip_atomic_fetch_add(done + pair * DONE_STRIDE, 1u, RLX_AGENT); }
    }
}
}

__device__ __forceinline__ void ln_finish(f32x4 (&v)[8], const float* g, const float* b, float* xo, bf16* xbo, int lane) {
    float s = 0.f;
#pragma unroll
    for (int j = 0; j < 8; ++j) s += (v[j].x + v[j].y) + (v[j].z + v[j].w);
    const float mean = wave_sum(s) * (1.f / D); float s2 = 0.f;
#pragma unroll
    for (int j = 0; j < 8; ++j) { v[j] = v[j] - mean; s2 += (v[j].x * v[j].x + v[j].y * v[j].y) + (v[j].z * v[j].z + v[j].w * v[j].w); }
    const float rstd = 1.f / sqrtf(wave_sum(s2) * (1.f / D) + LN_EPS);
#pragma unroll
    for (int j = 0; j < 8; ++j) {
        const f32x4 gg = *(const f32x4*)(g + 256 * j + 4 * lane), bb = *(const f32x4*)(b + 256 * j + 4 * lane);
        const f32x4 y = v[j] * rstd * gg + bb;
        if (xo) *(f32x4*)(xo + 256 * j + 4 * lane) = y;
        if (xbo) { u32x2 w; w.x = cvt_pk_bf16(y.x, y.y); w.y = cvt_pk_bf16(y.z, y.w); *(u32x2*)(xbo + 256 * j + 4 * lane) = w; }
    }
}
__device__ __forceinline__ void ln_finish_r(f32x4 (&v)[8], const f32x4 (&G)[8], const f32x4 (&B)[8], float* xo, bf16* xbo, int lane) {
    float s = 0.f;
#pragma unroll
    for (int j = 0; j < 8; ++j) s += (v[j].x + v[j].y) + (v[j].z + v[j].w);
    const float mean = wave_sum(s) * (1.f / D); float s2 = 0.f;
#pragma unroll
    for (int j = 0; j < 8; ++j) { v[j] = v[j] - mean; s2 += (v[j].x * v[j].x + v[j].y * v[j].y) + (v[j].z * v[j].z + v[j].w * v[j].w); }
    const float rstd = 1.f / sqrtf(wave_sum(s2) * (1.f / D) + LN_EPS);
#pragma unroll
    for (int j = 0; j < 8; ++j) {
        const f32x4 y = v[j] * rstd * G[j] + B[j];
        if (xo) *(f32x4*)(xo + 256 * j + 4 * lane) = y;
        if (xbo) { u32x2 w; w.x = cvt_pk_bf16(y.x, y.y); w.y = cvt_pk_bf16(y.z, y.w); *(u32x2*)(xbo + 256 * j + 4 * lane) = w; }
    }
}
__device__ __forceinline__ void ln_finish_r8(f32x4 (&v)[8], const f32x4 (&G)[8], const f32x4 (&B)[8], float* xo, bf16* xbo, int lane) {
    float s = 0.f;
#pragma unroll
    for (int j = 0; j < 8; ++j) s += (v[j].x + v[j].y) + (v[j].z + v[j].w);
    const float mean = wave_sum(s) * (1.f / D); float s2 = 0.f;
#pragma unroll
    for (int j = 0; j < 8; ++j) { v[j] = v[j] - mean; s2 += (v[j].x * v[j].x + v[j].y * v[j].y) + (v[j].z * v[j].z + v[j].w * v[j].w); }
    const float rstd = 1.f / sqrtf(wave_sum(s2) * (1.f / D) + LN_EPS);
#pragma unroll
    for (int j = 0; j < 4; ++j) {
        const f32x4 y0 = v[2 * j] * rstd * G[2 * j] + B[2 * j], y1 = v[2 * j + 1] * rstd * G[2 * j + 1] + B[2 * j + 1];
        if (xo) { *(f32x4*)(xo + 512 * j + 8 * lane) = y0; *(f32x4*)(xo + 512 * j + 8 * lane + 4) = y1; }
        if (xbo) { u32x4 w; w.x = cvt_pk_bf16(y0.x, y0.y); w.y = cvt_pk_bf16(y0.z, y0.w); w.z = cvt_pk_bf16(y1.x, y1.y); w.w = cvt_pk_bf16(y1.z, y1.w); *(u32x4*)(xbo + 512 * j + 8 * lane) = w; }
    }
}
__device__ __forceinline__ f32x4 ld_bf16x4(const bf16* p) { const u32x2 h = *(const u32x2*)p; return (f32x4){bf_lo(h.x), bf_hi(h.x), bf_lo(h.y), bf_hi(h.y)}; }

__device__ __forceinline__ void ln_mix(const ArgsP& a, const Ctx& c, int L) {
    const float* xin = (L == 0) ? a.in[I_X] : (const float*)(a.ws + WS_X);
    float* xout = (float*)(a.ws + WS_X); bf16* xb = (bf16*)(a.ws + WS_XB); const bf16* hm = (const bf16*)(a.ws + WS_HMIX);
    for (int row = c.gw; row < M; row += c.NGW) {
        f32x4 v[8];
#pragma unroll
        for (int j = 0; j < 8; ++j) { const size_t o = (size_t)row * D + 256 * j + 4 * c.lane; v[j] = ALPHA * *(const f32x4*)(xin + o) + ld_bf16x4(hm + o); }
        ln_finish(v, a.in[I_MLNG] + L * D, a.in[I_MLNB] + L * D, xout + (size_t)row * D, xb + (size_t)row * D, c.lane);
    }
}
__device__ __forceinline__ void ln_ffn(const ArgsP& a, const Ctx& c, int L) {
    LAS int* tab = (LAS int*)(c.lds + TAB_OFF);
    const float* xin = (const float*)(a.ws + WS_X); float* xout = (L == DEPTH - 1) ? (float*)a.out : (float*)(a.ws + WS_X);
    bf16* xb = (bf16*)(a.ws + WS_XB); const bf16* yp = (const bf16*)(a.ws + WS_YP);
    const int* te = (const int*)(a.ws + WS_TOK); const int* tp = te + 2 * M; const float* tw = (const float*)(tp + 2 * M);
#define LNF_IDX(r, E0, E1, P0, P1, W0, W1) do { E0 = te[2 * (r)]; E1 = te[2 * (r) + 1]; P0 = tp[2 * (r)]; P1 = tp[2 * (r) + 1]; W0 = tw[2 * (r)]; W1 = tw[2 * (r) + 1]; } while (0)
#define LNF_LOAD(r, E0, E1, P0, P1, XR, Y0, Y1) do { const size_t _r0 = (size_t)(MOE_TR * tab[TB_BASE + E0] + P0), _r1 = (size_t)(MOE_TR * tab[TB_BASE + E1] + P1); \
        _Pragma("unroll") for (int j = 0; j < 4; ++j) { const int o = 512 * j + 8 * c.lane; XR[j] = *(const u32x4*)(xb + (size_t)(r) * D + o); Y0[j] = *(const u32x4*)(yp + _r0 * D + o); Y1[j] = *(const u32x4*)(yp + _r1 * D + o); } } while (0)
    int row = c.gw;
    if (row >= M) return;
    f32x4 G[8], B[8];
#pragma unroll
    for (int j = 0; j < 8; ++j) { const int o = 512 * (j >> 1) + 8 * c.lane + 4 * (j & 1); G[j] = *(const f32x4*)(a.in[I_FLNG] + L * D + o); B[j] = *(const f32x4*)(a.in[I_FLNB] + L * D + o); }
    int e0, e1, p0, p1, ne0 = 0, ne1 = 0, np0 = 0, np1 = 0; float w0, w1, nw0 = 0.f, nw1 = 0.f;
    u32x4 X[4], Y0[4], Y1[4];
    LNF_IDX(row, e0, e1, p0, p1, w0, w1);
    LNF_LOAD(row, e0, e1, p0, p1, X, Y0, Y1);
    if (row + c.NGW < M) LNF_IDX(row + c.NGW, ne0, ne1, np0, np1, nw0, nw1);
    for (;;) {
        const int nrow = row + c.NGW; const bool hn = nrow < M;
        u32x4 NX_[4], NY0[4], NY1[4]; int fe0 = 0, fe1 = 0, fp0 = 0, fp1 = 0; float fw0 = 0.f, fw1 = 0.f;
        if (hn) { LNF_LOAD(nrow, ne0, ne1, np0, np1, NX_, NY0, NY1); if (nrow + c.NGW < M) LNF_IDX(nrow + c.NGW, fe0, fe1, fp0, fp1, fw0, fw1); }
        f32x4 v[8];
#pragma unroll
        for (int j = 0; j < 4; ++j) { const int o = 512 * j + 8 * c.lane;
            const f32x4 xa = RES_BF16 ? (f32x4){bf_lo(X[j].x), bf_hi(X[j].x), bf_lo(X[j].y), bf_hi(X[j].y)} : *(const f32x4*)(xin + (size_t)row * D + o);
            const f32x4 xc = RES_BF16 ? (f32x4){bf_lo(X[j].z), bf_hi(X[j].z), bf_lo(X[j].w), bf_hi(X[j].w)} : *(const f32x4*)(xin + (size_t)row * D + o + 4);
            v[2 * j] = ALPHA * xa + w0 * (f32x4){bf_lo(Y0[j].x), bf_hi(Y0[j].x), bf_lo(Y0[j].y), bf_hi(Y0[j].y)} + w1 * (f32x4){bf_lo(Y1[j].x), bf_hi(Y1[j].x), bf_lo(Y1[j].y), bf_hi(Y1[j].y)};
            v[2 * j + 1] = ALPHA * xc + w0 * (f32x4){bf_lo(Y0[j].z), bf_hi(Y0[j].z), bf_lo(Y0[j].w), bf_hi(Y0[j].w)} + w1 * (f32x4){bf_lo(Y1[j].z), bf_hi(Y1[j].z), bf_lo(Y1[j].w), bf_hi(Y1[j].w)}; }
        ln_finish_r8(v, G, B, (RES_BF16 && L != DEPTH - 1) ? (float*)nullptr : xout + (size_t)row * D, (L == DEPTH - 1) ? (bf16*)nullptr : xb + (size_t)row * D, c.lane);
        if (!hn) break;
        row = nrow; w0 = nw0; w1 = nw1; ne0 = fe0; ne1 = fe1; np0 = fp0; np1 = fp1; nw0 = fw0; nw1 = fw1;
#pragma unroll
        for (int j = 0; j < 4; ++j) { X[j] = NX_[j]; Y0[j] = NY0[j]; Y1[j] = NY1[j]; }
    }
#undef LNF_IDX
#undef LNF_LOAD
}

__device__ __forceinline__ void route_select(const ArgsP& a, int L, int tok, int fr, int fq, f32x4 a0, f32x4 a1, f32x4 a2) {
    int* te = (int*)(a.ws + WS_TOK); int* tp = te + 2 * M; float* tw = (float*)(tp + 2 * M); int* list = (int*)(a.ws + WS_LIST);
    gu32* cnt = (gu32*)(a.ws + WS_CTL) + CW_CNT + L * 32 * CNT_STRIDE;
    f32x4 acc[3] = {a0, a1, a2};
    const float* be = a.in[I_BER] + (L * NGRP + fq) * NEXP;
    float el[8];
    el[0] = acc[0].x + be[0]; el[1] = acc[0].y + be[1]; el[2] = acc[0].z + be[2]; el[3] = acc[0].w + be[3];
    el[4] = acc[1].x + be[4]; el[5] = acc[1].y + be[5]; el[6] = acc[1].z + be[6]; el[7] = acc[1].w + be[7];
    const float gl = acc[2].x + a.in[I_BGR][L * NGRP + fq];
    int i1 = 0; float v1 = el[0];
#pragma unroll
    for (int e = 1; e < 8; ++e) if (el[e] > v1) { v1 = el[e]; i1 = e; }
    int i2 = -1; float v2 = -INFINITY;
#pragma unroll
    for (int e = 0; e < 8; ++e) if (e != i1 && el[e] > v2) { v2 = el[e]; i2 = e; }
    float one_ = 1.f; asm volatile("" : "+v"(one_));
    const float tw1 = one_ / (one_ + __expf(v2 - v1)), tw2 = one_ - tw1;
    float gls[4];
#pragma unroll
    for (int r = 0; r < 4; ++r) gls[r] = __shfl(gl, fr + 16 * r);
    int gs = 0; float gm = gls[0];
#pragma unroll
    for (int r = 1; r < 4; ++r) if (gls[r] > gm) { gm = gls[r]; gs = r; }
    float den = 0.f;
#pragma unroll
    for (int r = 0; r < 4; ++r) den += __expf(gls[r] - gm);
    const float pg = 1.f / den;
    if (fq == gs) {
        const int e0 = 8 * gs + i1, e1 = 8 * gs + i2;
        const int p0 = (int)__hip_atomic_fetch_add(cnt + e0 * CNT_STRIDE, 1u, RLX_AGENT), p1 = (int)__hip_atomic_fetch_add(cnt + e1 * CNT_STRIDE, 1u, RLX_AGENT);
        list[e0 * M + p0] = 2 * tok; list[e1 * M + p1] = 2 * tok + 1;
        te[2 * tok] = e0; te[2 * tok + 1] = e1; tp[2 * tok] = p0; tp[2 * tok + 1] = p1; tw[2 * tok] = pg * tw1; tw[2 * tok + 1] = pg * tw2;
    }
}

constexpr int LNR_PITCH = 2 * D + 16, LNR_PART_OFF = 16 * LNR_PITCH;
__device__ __forceinline__ void ln_mix_router(const ArgsP& a, const Ctx& c, int L) {
    const float* xin = (L == 0) ? a.in[I_X] : (const float*)(a.ws + WS_X);
    float* xout = (float*)(a.ws + WS_X); bf16* xb = (bf16*)(a.ws + WS_XB); const bf16* hm = (const bf16*)(a.ws + WS_HMIX);
    const bf16* wr = (const bf16*)(a.ws + WS_WR) + (size_t)L * 48 * D;
    const float* g = a.in[I_MLNG] + L * D; const float* bta = a.in[I_MLNB] + L * D;
    LAS unsigned char* T = c.lds + RING_OFF; LAS f32x4* Pp = (LAS f32x4*)(c.lds + RING_OFF + LNR_PART_OFF);
    const int lane = c.lane, w = c.wave, fr = lane & 15, fq = lane >> 4;
    if ((int)blockIdx.x >= M / 16) return;
    LAS f32x4* GBl = (LAS f32x4*)(c.lds + RING_OFF + 98304);
    u32x2 RX[8], RH[8];
    { const size_t row = (size_t)16 * blockIdx.x + 2 * w;
#pragma unroll
      for (int j = 0; j < 8; ++j) { const size_t o = row * D + 256 * j + 4 * lane; RX[j] = *(const u32x2*)(xb + o); RH[j] = *(const u32x2*)(hm + o); } }
    for (int i = c.tid; i < D / 4; i += NTHREADS) { GBl[i] = ((const f32x4*)g)[i]; GBl[D / 4 + i] = ((const f32x4*)bta)[i]; }
    __syncthreads();
    for (int grp = blockIdx.x; grp < M / 16; grp += gridDim.x) {
#pragma unroll
        for (int rr = 0; rr < 2; ++rr) {
            const int rl = 2 * w + rr; const size_t row = (size_t)16 * grp + rl;
            const size_t nrow = rr == 0 ? row + 1 : (size_t)16 * (grp + gridDim.x) + 2 * w; const bool hn = rr == 0 || (grp + (int)gridDim.x) < M / 16;
            u32x2 NX_[8], NH[8];
            if (hn) {
#pragma unroll
                for (int j = 0; j < 8; ++j) { const size_t o = nrow * D + 256 * j + 4 * lane; NX_[j] = *(const u32x2*)(xb + o); NH[j] = *(const u32x2*)(hm + o); } }
            f32x4 v[8]; float s1 = 0.f;
#pragma unroll
            for (int j = 0; j < 8; ++j) { const size_t o = row * D + 256 * j + 4 * lane;
                const f32x4 xr = RES_BF16 ? (f32x4){bf_lo(RX[j].x), bf_hi(RX[j].x), bf_lo(RX[j].y), bf_hi(RX[j].y)} : *(const f32x4*)(xin + o);
                v[j] = ALPHA * xr + (f32x4){bf_lo(RH[j].x), bf_hi(RH[j].x), bf_lo(RH[j].y), bf_hi(RH[j].y)}; s1 += (v[j].x + v[j].y) + (v[j].z + v[j].w); }
            const float mean = wave_sum(s1) * (1.f / D); float s2 = 0.f;
#pragma unroll
            for (int j = 0; j < 8; ++j) { v[j] = v[j] - mean; s2 += (v[j].x * v[j].x + v[j].y * v[j].y) + (v[j].z * v[j].z + v[j].w * v[j].w); }
            const float rstd = 1.f / sqrtf(wave_sum(s2) * (1.f / D) + LN_EPS);
#pragma unroll
            for (int j = 0; j < 8; ++j) {
                const f32x4 gg = GBl[256 * j / 4 + lane], bb = GBl[D / 4 + 256 * j / 4 + lane];
                const f32x4 y = v[j] * rstd * gg + bb;
                if (!RES_BF16) *(f32x4*)(xout + row * D + 256 * j + 4 * lane) = y;
                u32x2 pk; pk.x = cvt_pk_bf16(y.x, y.y); pk.y = cvt_pk_bf16(y.z, y.w);
                *(u32x2*)(xb + row * D + 256 * j + 4 * lane) = pk;
                *(LAS u32x2*)(T + rl * LNR_PITCH + (256 * j + 4 * lane) * 2) = pk;
            }
            if (hn) {
#pragma unroll
                for (int j = 0; j < 8; ++j) { RX[j] = NX_[j]; RH[j] = NH[j]; } }
        }
        bf16x8 wa[3][8];
#pragma unroll
        for (int nt = 0; nt < 3; ++nt)
#pragma unroll
            for (int s_ = 0; s_ < 8; ++s_) wa[nt][s_] = *(const bf16x8*)(wr + (size_t)(16 * nt + fr) * D + 256 * w + 32 * s_ + 8 * fq);
        __syncthreads();
        f32x4 acc[3];
#pragma unroll
        for (int i = 0; i < 3; ++i) acc[i] = (f32x4){0.f, 0.f, 0.f, 0.f};
#pragma unroll
        for (int s_ = 0; s_ < 8; ++s_) {
            const bf16x8 fb = *(const LAS bf16x8*)(T + fr * LNR_PITCH + (256 * w + 32 * s_ + 8 * fq) * 2);
            acc[0] = MFMA16(wa[0][s_], fb, acc[0]); acc[1] = MFMA16(wa[1][s_], fb, acc[1]); acc[2] = MFMA16(wa[2][s_], fb, acc[2]);
        }
#pragma unroll
        for (int nt = 0; nt < 3; ++nt) Pp[(w * 3 + nt) * 64 + lane] = acc[nt];
        __syncthreads();
        if (w == 0) {
            f32x4 t0 = Pp[lane], t1 = Pp[64 + lane], t2 = Pp[128 + lane];
#pragma unroll
            for (int ww = 1; ww < 8; ++ww) { t0 += Pp[(ww * 3 + 0) * 64 + lane]; t1 += Pp[(ww * 3 + 1) * 64 + lane]; t2 += Pp[(ww * 3 + 2) * 64 + lane]; }
            route_select(a, L, 16 * grp + fr, fr, fq, t0, t1, t2);
        }
    }
}

__device__ __forceinline__ void router(const ArgsP& a, const Ctx& c, int L) {
    const bf16* xb = (const bf16*)(a.ws + WS_XB); const bf16* wr = (const bf16*)(a.ws + WS_WR) + (size_t)L * 48 * D;
    int* te = (int*)(a.ws + WS_TOK); int* tp = te + 2 * M; float* tw = (float*)(tp + 2 * M); int* list = (int*)(a.ws + WS_LIST);
    gu32* cnt = (gu32*)(a.ws + WS_CTL) + CW_CNT + L * 32 * CNT_STRIDE;
    const int fr = c.lane & 15, fq = c.lane >> 4;
    for (int task = c.gw; task < M / 16; task += c.NGW) {
        const int tok = task * 16 + fr;
        f32x4 acc[3];
#pragma unroll
        for (int i = 0; i < 3; ++i) acc[i] = (f32x4){0.f, 0.f, 0.f, 0.f};
        const bf16* bp = xb + (size_t)tok * D + 8 * fq; const bf16* ap = wr + (size_t)fr * D + 8 * fq;
        for (int k = 0; k < D; k += 32) {
            const bf16x8 fb = *(const bf16x8*)(bp + k);
            const bf16x8 a0 = *(const bf16x8*)(ap + k), a1 = *(const bf16x8*)(ap + (size_t)16 * D + k), a2 = *(const bf16x8*)(ap + (size_t)32 * D + k);
            acc[0] = MFMA16(a0, fb, acc[0]); acc[1] = MFMA16(a1, fb, acc[1]); acc[2] = MFMA16(a2, fb, acc[2]);
        }
        route_select(a, L, tok, fr, fq, acc[0], acc[1], acc[2]);
    }
}

__device__ __forceinline__ void gm_stats(const ArgsP& a, const Ctx& c) {
    const bf16* z = (const bf16*)(a.ws + WS_Z); f32x2* st = (f32x2*)(a.ws + WS_STAT);
    for (int row = c.gw; row < M; row += c.NGW) {
        const bf16* p = z + (size_t)row * GF + GH;
        u32x4 h[12]; float s = 0.f;
#pragma unroll
        for (int j = 0; j < 12; ++j) { h[j] = *(const u32x4*)(p + (j * 64 + c.lane) * 8);
            s += (bf_lo(h[j].x) + bf_hi(h[j].x)) + (bf_lo(h[j].y) + bf_hi(h[j].y)) + (bf_lo(h[j].z) + bf_hi(h[j].z)) + (bf_lo(h[j].w) + bf_hi(h[j].w)); }
        const float mean = wave_sum(s) * (1.f / GH); float q = 0.f;
#pragma unroll
        for (int j = 0; j < 12; ++j) {
            float d;
            d = bf_lo(h[j].x) - mean; q += d * d; d = bf_hi(h[j].x) - mean; q += d * d; d = bf_lo(h[j].y) - mean; q += d * d; d = bf_hi(h[j].y) - mean; q += d * d;
            d = bf_lo(h[j].z) - mean; q += d * d; d = bf_hi(h[j].z) - mean; q += d * d; d = bf_lo(h[j].w) - mean; q += d * d; d = bf_hi(h[j].w) - mean; q += d * d;
        }
        const float rstd = 1.f / sqrtf(wave_sum(q) * (1.f / GH) + LN_EPS);
        if (c.lane == 0) st[row] = (f32x2){mean, rstd};
    }
}
__device__ __forceinline__ void gm_spatial_simple(const ArgsP& a, const Ctx& c, int j) {
    const bf16* z = (const bf16*)(a.ws + WS_Z); const f32x2* st = (const f32x2*)(a.ws + WS_STAT); bf16* gt = (bf16*)(a.ws + WS_GATED);
    const float* wsp = a.in[I_WSP] + (size_t)j * GG * CH * CH; const float* bsp = a.in[I_BSP] + j * GG * CH;
    const float* lg = a.in[I_VLNG] + j * GH; const float* lb = a.in[I_VLNB] + j * GH;
    const int gtid = blockIdx.x * NTHREADS + c.tid, GT = gridDim.x * NTHREADS;
    for (int i = gtid; i < M * GH; i += GT) {
        const int row = i / GH, ch = i % GH, g = ch / GD, t = row & (CH - 1), cb = row - t;
        const float gam = lg[ch], bet = lb[ch]; const float* w = wsp + ((size_t)g * CH + t) * CH;
        float acc = 0.f;
        for (int s = 0; s <= t; ++s) { const f32x2 ms = st[cb + s]; const float vn = (bf2f(z[(size_t)(cb + s) * GF + GH + ch]) - ms.x) * ms.y * gam + bet; acc += w[s] * vn; }
        const float o = bf2f(z[(size_t)row * GF + ch]) * (acc + bsp[g * CH + t]);
        gt[i] = (bf16)(cvt_pk_bf16(o, 0.f) & 0xffffu);
    }
}

__device__ __forceinline__ void attn_simple(const ArgsP& a, const Ctx& c) {
    const bf16* Q = (const bf16*)(a.ws + WS_Q); const bf16* Kp = (const bf16*)(a.ws + WS_K); const bf16* V = (const bf16*)(a.ws + WS_V); bf16* O = (bf16*)(a.ws + WS_O);
    for (int task = c.gw; task < NB * NH * SEQ; task += c.NGW) {
        const int t = task % SEQ, h = (task / SEQ) % NH, b = task / (SEQ * NH);
        const size_t col = (size_t)h * HD + 2 * c.lane;
        const unsigned qq = *(const unsigned*)(Q + (size_t)(b * SEQ + t) * D + col); const float q0 = bf_lo(qq), q1 = bf_hi(qq);
        float C = 1.f, o0 = 0.f, o1 = 0.f;
        for (int s = t - 1; s >= 0; --s) {
            const size_t off = (size_t)(b * SEQ + s) * D + col;
            const unsigned kk = *(const unsigned*)(Kp + off), vv = *(const unsigned*)(V + off);
            float z = wave_sum(q0 * bf_lo(kk) + q1 * bf_hi(kk));
            z = fminf(fmaxf(z, -120.f), 120.f);
            const float e = fast_exp2(-z), beta = fast_rcp(1.f + e), P = beta * C;
            C *= e * beta;
            o0 += P * bf_lo(vv); o1 += P * bf_hi(vv);
        }
        *(unsigned*)(O + (size_t)(b * SEQ + t) * D + col) = cvt_pk_bf16(o0, o1);
    }
}

#ifndef ATT_EARLY_EXIT
#define ATT_EARLY_EXIT 1
#endif
typedef float f32x16 __attribute__((ext_vector_type(16)));
#define MFMA32(a, b, c) __builtin_amdgcn_mfma_f32_32x32x16_bf16((a), (b), (c), 0, 0, 0)
__device__ __forceinline__ int swz16(int row) { return ((row & 3) << 2) | ((row >> 2) & 3); }
__device__ __forceinline__ void attn_fast(const ArgsP& a, const Ctx& c) {
    const bf16* Q = (const bf16*)(a.ws + WS_Q); const bf16* Kp = (const bf16*)(a.ws + WS_K); const bf16* V = (const bf16*)(a.ws + WS_V); bf16* O = (bf16*)(a.ws + WS_O);
    LAS unsigned char* vbuf = c.lds + RING_OFF + c.wave * 16384;
    const int lane = c.lane, r32 = lane & 31, h = lane >> 5, l4 = lane >> 4, i16 = lane & 15, q4 = i16 >> 2, p4 = i16 & 3, colhalf = l4 & 1;
    const int G = gridDim.x, bx = blockIdx.x, vcu = (G % 8 == 0) ? (bx % 8) * (G / 8) + bx / 8 : bx;
    for (int u = vcu * NWAVES + c.wave; u < NB * NH * (SEQ / 32); u += c.NGW) {
        const int qb = u % (SEQ / 32), bh = u / (SEQ / 32), b = bh / NH, hd = bh % NH, q0 = qb * 32;
        const size_t rowbase = (size_t)b * SEQ;
        const bf16* Qp = Q + (rowbase + q0 + r32) * D + hd * HD + 8 * h;
        const bf16* Kb = Kp + rowbase * D + hd * HD + 8 * h;
        const bf16* Vb = V + rowbase * D + hd * HD;
        bf16x8 qf[8], kf[8];
#pragma unroll
        for (int s = 0; s < 8; ++s) qf[s] = *(const bf16x8*)(Qp + 16 * s);
        f32x16 oacc[4];
#pragma unroll
        for (int d = 0; d < 4; ++d)
#pragma unroll
            for (int i = 0; i < 16; ++i) oacc[d][i] = 0.f;
        float C = 1.f;
        int jt = qb;
#pragma unroll
        for (int s = 0; s < 8; ++s) kf[s] = *(const bf16x8*)(Kb + (size_t)(32 * jt + r32) * D + 16 * s);
#pragma unroll
        for (int i = 0; i < 8; ++i) { const int row = 4 * i + l4, ch = i16 ^ ((l4 << 2) | (i & 3));
            __builtin_amdgcn_global_load_lds((const unsigned*)(Vb + (size_t)(32 * jt + row) * D + 8 * ch), (LAS unsigned*)(vbuf + i * 1024), 16, 0, 0); }
        for (int it = 0;; ++it) {
            LAS unsigned char* vb = vbuf + (it & 1) * 8192;
            f32x16 p;
#pragma unroll
            for (int i = 0; i < 16; ++i) p[i] = 0.f;
#pragma unroll
            for (int s = 0; s < 8; ++s) p = MFMA32(kf[s], qf[s], p);
            const int jn = jt > 0 ? jt - 1 : 0;
#pragma unroll
            for (int s = 0; s < 8; ++s) kf[s] = *(const bf16x8*)(Kb + (size_t)(32 * jn + r32) * D + 16 * s);
            float bet[16], mm[16];
#pragma unroll
            for (int i = 0; i < 16; ++i) { const float e = fast_exp2(fminf(-p[i], 100.f)); const float bb = fast_rcp(1.f + e); bet[i] = bb; mm[i] = e * bb; }
            if (it == 0) {
#pragma unroll
                for (int i = 0; i < 16; ++i) { const bool valid = ((i & 3) + 8 * (i >> 2) + 4 * h) < r32; bet[i] = valid ? bet[i] : 0.f; mm[i] = valid ? mm[i] : 1.f; }
            }
            float gpp[4];
#pragma unroll
            for (int g = 0; g < 4; ++g) { const float gp = (mm[4 * g] * mm[4 * g + 1]) * (mm[4 * g + 2] * mm[4 * g + 3]); gpp[g] = __shfl_xor(gp, 32); }
            float E = C, P[16];
#pragma unroll
            for (int g = 3; g >= 0; --g) {
                const float E1 = (h == 0) ? E * gpp[g] : E;
                const float x3 = E1, x2 = x3 * mm[4 * g + 3], x1 = x2 * mm[4 * g + 2], x0 = x1 * mm[4 * g + 1];
                P[4 * g + 3] = bet[4 * g + 3] * x3; P[4 * g + 2] = bet[4 * g + 2] * x2; P[4 * g + 1] = bet[4 * g + 1] * x1; P[4 * g] = bet[4 * g] * x0;
                const float E2 = x0 * mm[4 * g];
                E = (h == 1) ? E2 * gpp[g] : E2;
            }
            C = E;
            bf16x8 pf[2];
#pragma unroll
            for (int s = 0; s < 2; ++s) { u32x4 w; w.x = cvt_pk_bf16(P[8 * s], P[8 * s + 1]); w.y = cvt_pk_bf16(P[8 * s + 2], P[8 * s + 3]); w.z = cvt_pk_bf16(P[8 * s + 4], P[8 * s + 5]); w.w = cvt_pk_bf16(P[8 * s + 6], P[8 * s + 7]);
                pf[s] = __builtin_bit_cast(bf16x8, w); }
            asm volatile("s_waitcnt vmcnt(0)" ::: "memory");
            s16x4 tlo[4][2], thi[4][2];
#pragma unroll
            for (int db = 0; db < 4; ++db)
#pragma unroll
                for (int s = 0; s < 2; ++s) {
                    { const int row = 16 * s + 4 * h + q4, ch = 4 * db + 2 * colhalf + (p4 >> 1); tlo[db][s] = lds_tr_asm(vb + 256 * row + 16 * (ch ^ swz16(row)) + 8 * (p4 & 1)); }
                    { const int row = 16 * s + 8 + 4 * h + q4, ch = 4 * db + 2 * colhalf + (p4 >> 1); thi[db][s] = lds_tr_asm(vb + 256 * row + 16 * (ch ^ swz16(row)) + 8 * (p4 & 1)); }
                }
            asm volatile("s_waitcnt lgkmcnt(0)" ::: "memory");
#pragma unroll
            for (int db = 0; db < 4; ++db)
#pragma unroll
                for (int s = 0; s < 2; ++s) { asm volatile("" : "+v"(tlo[db][s]), "+v"(thi[db][s]));
                    oacc[db] = MFMA32(__builtin_shufflevector(tlo[db][s], thi[db][s], 0, 1, 2, 3, 4, 5, 6, 7), pf[s], oacc[db]);
                }
            bool done = (jt == 0);
#if ATT_EARLY_EXIT
            done = done || __all(C < 1e-37f);
#endif
            if (done) break;
            jt = jn;
            asm volatile("s_waitcnt lgkmcnt(0)" ::: "memory");
            { LAS unsigned char* vn = vbuf + ((it + 1) & 1) * 8192;
#pragma unroll
              for (int i = 0; i < 8; ++i) { const int row = 4 * i + l4, ch = i16 ^ ((l4 << 2) | (i & 3));
                  __builtin_amdgcn_global_load_lds((const unsigned*)(Vb + (size_t)(32 * jt + row) * D + 8 * ch), (LAS unsigned*)(vn + i * 1024), 16, 0, 0); } }
        }
        asm volatile("s_waitcnt vmcnt(0) lgkmcnt(0)" ::: "memory");
        bf16* Op = O + (rowbase + q0 + r32) * D + hd * HD;
#pragma unroll
        for (int db = 0; db < 4; ++db)
#pragma unroll
            for (int g = 0; g < 4; g += 2) {
                const unsigned ax = cvt_pk_bf16(oacc[db][4 * g], oacc[db][4 * g + 1]), ay = cvt_pk_bf16(oacc[db][4 * g + 2], oacc[db][4 * g + 3]);
                const unsigned bx = cvt_pk_bf16(oacc[db][4 * g + 4], oacc[db][4 * g + 5]), by = cvt_pk_bf16(oacc[db][4 * g + 6], oacc[db][4 * g + 7]);
                const auto sx = __builtin_amdgcn_permlane32_swap(ax, bx, false, false), sy = __builtin_amdgcn_permlane32_swap(ay, by, false, false);
                u32x4 w; w.x = sx[0]; w.y = sy[0]; w.z = sx[1]; w.w = sy[1];
                *(u32x4*)(Op + 32 * db + 8 * (g + h)) = w; }
    }
}

__device__ __forceinline__ void gm_spatial_fast(const ArgsP& a, const Ctx& c, int j) {
    const bf16* z = (const bf16*)(a.ws + WS_Z); bf16* gt = (bf16*)(a.ws + WS_GATED);
    const bf16* wsb = (const bf16*)(a.ws + WS_WSPB) + (size_t)j * GG * CH * CH; const float* bsp = a.in[I_BSP] + j * GG * CH;
    const float* lg = a.in[I_VLNG] + j * GH; const float* lb = a.in[I_VLNB] + j * GH;
    LAS unsigned char* img = c.lds + RING_OFF;
    LAS unsigned char* uo = c.lds + RING_OFF + 65536;
    LAS f32x2* srow = (LAS f32x2*)(c.lds + TOFF_OFF);
    const int lane = c.lane, r32 = lane & 31, h = lane >> 5, l4 = lane >> 4, i16 = lane & 15, q4 = i16 >> 2, p4 = i16 & 3, colhalf = l4 & 1, w = c.wave;
    const int NU = NB * (SEQ / CH) * GG, per = (NU + gridDim.x - 1) / gridDim.x;
    const int u0 = blockIdx.x * per, u1 = min(NU, u0 + per), nstep = 3 * (u1 - u0);
    if (nstep <= 0) return;
    const int tbA = w & 3, dqA = w >> 2, tbB = 3 - tbA, dqB = 2 + (w >> 2), nA = 2 * (tbA + 1), nB = 2 * (tbB + 1);
    const int scc = c.tid & 15, srow0 = c.tid >> 4;
    int last_bc = -1;
#define SP_LOADHV(HV, st_) do { const int un_ = u0 + (st_) / 3, pn_ = (st_) % 3, gn_ = un_ % GG; const size_t rown_ = (size_t)(un_ / GG) * CH; \
        _Pragma("unroll") for (int it = 0; it < 4; ++it) HV[it] = *(const u32x4*)(z + (rown_ + srow0 + 32 * it) * GF + GH + gn_ * GD + 128 * pn_ + 8 * scc); } while (0)
#define SP_LOADU(HU, st_) do { const int un_ = u0 + (st_) / 3, pn_ = (st_) % 3, gn_ = un_ % GG; const size_t rown_ = (size_t)(un_ / GG) * CH; \
        _Pragma("unroll") for (int it = 0; it < 4; ++it) HU[it] = *(const u32x4*)(z + (rown_ + srow0 + 32 * it) * GF + gn_ * GD + 128 * pn_ + 8 * scc); } while (0)
    u32x4 hv0[4], hv1[4], hu[4];
    SP_LOADHV(hv0, 0); if (nstep > 1) SP_LOADHV(hv1, 1);
    SP_LOADU(hu, 0);
    bf16x8 wf[10];
    for (int step2 = 0; step2 < nstep; step2 += 2) {
#pragma unroll
      for (int par = 0; par < 2; ++par) {
        const int step = step2 + par; if (step >= nstep) break;
        const int u = u0 + step / 3, p = step % 3, g = u % GG, bc = u / GG; const size_t row0 = (size_t)bc * CH;
        LAS unsigned char* pb = img + (step & 1) * 32768; LAS unsigned char* ub = uo + (step & 1) * 32768;
        if (bc != last_bc) {
            last_bc = bc;
            {
                const int rw = c.tid >> 2, qd = c.tid & 3; const f32x4* pp = (const f32x4*)((const f32x2*)(a.ws + WS_PART) + (row0 + rw) * 96 + 24 * qd);
                f32x4 t[12];
#pragma unroll
                for (int i = 0; i < 12; ++i) t[i] = pp[i];
                float s1 = 0.f, s2 = 0.f;
#pragma unroll
                for (int i = 0; i < 12; ++i) { s1 += t[i].x + t[i].z; s2 += t[i].y + t[i].w; }
                s1 += __shfl_xor(s1, 1); s2 += __shfl_xor(s2, 1); s1 += __shfl_xor(s1, 2); s2 += __shfl_xor(s2, 2);
                const float mean = s1 * (1.f / GH), var = fmaxf(s2 * (1.f / GH) - mean * mean, 0.f);
                if (qd == 0) srow[rw] = (f32x2){mean, 1.f / sqrtf(var + LN_EPS)}; }
            __syncthreads();
        }
        { const int ch0 = g * GD + 128 * p + 8 * scc;
          const f32x4 g0 = *(const f32x4*)(lg + ch0), g1 = *(const f32x4*)(lg + ch0 + 4), b0 = *(const f32x4*)(lb + ch0), b1 = *(const f32x4*)(lb + ch0 + 4);
#pragma unroll
          for (int it = 0; it < 4; ++it) {
              const int row = srow0 + 32 * it; const f32x2 ms = srow[row]; const u32x4 h_ = par == 0 ? hv0[it] : hv1[it]; u32x4 o;
              o.x = cvt_pk_bf16((bf_lo(h_.x) - ms.x) * ms.y * g0.x + b0.x, (bf_hi(h_.x) - ms.x) * ms.y * g0.y + b0.y);
              o.y = cvt_pk_bf16((bf_lo(h_.y) - ms.x) * ms.y * g0.z + b0.z, (bf_hi(h_.y) - ms.x) * ms.y * g0.w + b0.w);
              o.z = cvt_pk_bf16((bf_lo(h_.z) - ms.x) * ms.y * g1.x + b1.x, (bf_hi(h_.z) - ms.x) * ms.y * g1.y + b1.y);
              o.w = cvt_pk_bf16((bf_lo(h_.w) - ms.x) * ms.y * g1.z + b1.z, (bf_hi(h_.w) - ms.x) * ms.y * g1.w + b1.w);
              *(LAS u32x4*)(pb + 256 * row + 16 * (scc ^ swz16(row))) = o;
              *(LAS u32x4*)(ub + 256 * row + 16 * (scc ^ swz16(row))) = hu[it];
          } }
        if (step + 2 < nstep) { if (par == 0) SP_LOADHV(hv0, step + 2); else SP_LOADHV(hv1, step + 2); }
        if (p == 0) {
            const bf16* wg = wsb + (size_t)g * CH * CH;
#define SP_WLOAD(TBA) do { _Pragma("unroll") for (int ks = 0; ks < 2 * ((TBA) + 1); ++ks) wf[ks] = *(const bf16x8*)(wg + (size_t)(32 * (TBA) + r32) * CH + 16 * ks + 8 * h); \
                           _Pragma("unroll") for (int ks = 0; ks < 2 * (4 - (TBA)); ++ks) wf[2 * ((TBA) + 1) + ks] = *(const bf16x8*)(wg + (size_t)(32 * (3 - (TBA)) + r32) * CH + 16 * ks + 8 * h); } while (0)
            if (tbA == 0) SP_WLOAD(0); else if (tbA == 1) SP_WLOAD(1); else if (tbA == 2) SP_WLOAD(2); else SP_WLOAD(3);
#undef SP_WLOAD
        }
        const int tA = 32 * tbA + r32, tB = 32 * tbB + r32;
        const float btA = bsp[g * CH + tA], btB = bsp[g * CH + tB];
        __syncthreads();
        f32x16 accA, accB;
#pragma unroll
        for (int i = 0; i < 16; ++i) { accA[i] = 0.f; accB[i] = 0.f; }
#define SP_BLOCKS(TBA) do { constexpr int NA_ = 2 * ((TBA) + 1), NB_ = 2 * (4 - (TBA)); s16x4 ta[NA_][2], tb[NB_][2]; \
            _Pragma("unroll") for (int ks = 0; ks < NA_; ++ks) _Pragma("unroll") for (int hh = 0; hh < 2; ++hh) { const int row = 16 * ks + 8 * h + 4 * hh + q4, ch = 4 * dqA + 2 * colhalf + (p4 >> 1); ta[ks][hh] = lds_tr_asm(pb + 256 * row + 16 * (ch ^ swz16(row)) + 8 * (p4 & 1)); } \
            _Pragma("unroll") for (int ks = 0; ks < NB_; ++ks) _Pragma("unroll") for (int hh = 0; hh < 2; ++hh) { const int row = 16 * ks + 8 * h + 4 * hh + q4, ch = 4 * dqB + 2 * colhalf + (p4 >> 1); tb[ks][hh] = lds_tr_asm(pb + 256 * row + 16 * (ch ^ swz16(row)) + 8 * (p4 & 1)); } \
            asm volatile("s_waitcnt lgkmcnt(0)" ::: "memory"); \
            _Pragma("unroll") for (int ks = 0; ks < NA_; ++ks) { asm volatile("" : "+v"(ta[ks][0]), "+v"(ta[ks][1])); accA = MFMA32(__builtin_shufflevector(ta[ks][0], ta[ks][1], 0, 1, 2, 3, 4, 5, 6, 7), wf[ks], accA); } \
            _Pragma("unroll") for (int ks = 0; ks < NB_; ++ks) { asm volatile("" : "+v"(tb[ks][0]), "+v"(tb[ks][1])); accB = MFMA32(__builtin_shufflevector(tb[ks][0], tb[ks][1], 0, 1, 2, 3, 4, 5, 6, 7), wf[NA_ + ks], accB); } } while (0)
        if (tbA == 0) SP_BLOCKS(0); else if (tbA == 1) SP_BLOCKS(1); else if (tbA == 2) SP_BLOCKS(2); else SP_BLOCKS(3);
#undef SP_BLOCKS
        if (step + 1 < nstep) SP_LOADU(hu, step + 1);
#pragma unroll
        for (int gq = 0; gq < 4; ++gq) {
            LAS u32x2* pa = (LAS u32x2*)(ub + 256 * tA + 16 * ((4 * dqA + gq) ^ swz16(tA)) + 8 * h); LAS u32x2* pq = (LAS u32x2*)(ub + 256 * tB + 16 * ((4 * dqB + gq) ^ swz16(tB)) + 8 * h);
            const u32x2 ua = *pa, ubv = *pq; u32x2 oa, ob;
            oa.x = cvt_pk_bf16(bf_lo(ua.x) * (accA[4 * gq] + btA), bf_hi(ua.x) * (accA[4 * gq + 1] + btA)); oa.y = cvt_pk_bf16(bf_lo(ua.y) * (accA[4 * gq + 2] + btA), bf_hi(ua.y) * (accA[4 * gq + 3] + btA));
            ob.x = cvt_pk_bf16(bf_lo(ubv.x) * (accB[4 * gq] + btB), bf_hi(ubv.x) * (accB[4 * gq + 1] + btB)); ob.y = cvt_pk_bf16(bf_lo(ubv.y) * (accB[4 * gq + 2] + btB), bf_hi(ubv.y) * (accB[4 * gq + 3] + btB));
            *pa = oa; *pq = ob;
        }
        __syncthreads();
#pragma unroll
        for (int it = 0; it < 4; ++it) { const int row = srow0 + 32 * it;
            *(u32x4*)(gt + (row0 + row) * GH + g * GD + 128 * p + 8 * scc) = *(const LAS u32x4*)(ub + 256 * row + 16 * (scc ^ swz16(row))); }
      }
    }
#undef SP_LOADHV
#undef SP_LOADU
    __syncthreads();
}

constexpr int NPHASE = 1 + 9 * DEPTH;
__global__ void __launch_bounds__(NTHREADS, 2) mk_fwd(Args a) {
    extern __shared__ __attribute__((aligned(16))) unsigned char lds_raw[];
    Ctx c0;
    const ArgsP ap{};
    c0.lds = (LAS unsigned char*)lds_raw; c0.ws = nullptr;
    c0.tid = threadIdx.x; c0.lane = c0.tid & 63; c0.wave = __builtin_amdgcn_readfirstlane(c0.tid >> 6);
    c0.gw = blockIdx.x * NWAVES + c0.wave; c0.NGW = gridDim.x * NWAVES;
    volatile LAS unsigned* MISC = (volatile LAS unsigned*)(c0.lds + MISC_OFF);
    for (int u = c0.tid; u < (LDS_BYTES - LDSCTL_OFF) / 4; u += NTHREADS) ((LAS unsigned*)(c0.lds + LDSCTL_OFF))[u] = 0u;
    __syncthreads();
    unsigned* barw = (unsigned*)((gu32*)(ap.ws + WS_CTL) + CW_BAR);
    XcdBarrier bar; bar.bar = barw; bar.x = 0; bar.st = nullptr;
    if (!MK_PER_PHASE) bar = xcd_barrier_post(barw, MISC + 8);
    const int lo = a.ph_lo, hi = a.ph_hi;
#define IN(k) (lo <= (k) && (k) < hi)
#define PC phase_ctx(c0)
#define SEAM(k) do { if (!MK_PER_PHASE && (k) + 1 < hi) xcd_barrier(bar); } while (0)

    if (IN(0)) { for (int rep = 0; rep < REP_PRO; ++rep) p0_prologue(ap, PC); SEAM(0); }
    for (int L = 0; L < DEPTH; ++L) {
        const int pb = 1 + 9 * L, j = L >> 1;
        if ((L & 1) == 0) {
            if (IN(pb + 0)) {
#if FAST_DENSE
                for (int rep = 0; rep < REP_DENSE; ++rep)
                dense_fast<0>(PC, (const bf16*)(ap.ws + WS_XB), (const bf16*)(ap.ws + WS_WQKV) + (size_t)j * 3 * D * D, 3 * D, D, (bf16*)(ap.ws + WS_Q), D, (WS_K - WS_Q) / 2);
#else
                sg_dense<1>(PC, (const bf16*)(ap.ws + WS_XB), (const bf16*)(ap.ws + WS_WQKV) + (size_t)j * 3 * D * D, M, 3 * D, D, (bf16*)(ap.ws + WS_Q));
#endif
                SEAM(pb + 0); }
#if FAST_ATTN
            if (IN(pb + 1)) { for (int rep = 0; rep < REP_MIX; ++rep) attn_fast(ap, PC); SEAM(pb + 2); }
#else
            if (IN(pb + 1)) { attn_simple(ap, PC); SEAM(pb + 2); }
#endif
            if (IN(pb + 3)) {
#if FAST_DENSE
                for (int rep = 0; rep < REP_DENSE; ++rep)
                dense_fast<0>(PC, (const bf16*)(ap.ws + WS_O), (const bf16*)(ap.ws + WS_WO) + (size_t)j * D * D, D, D, (bf16*)(ap.ws + WS_HMIX), 0, 0);
#else
                sg_dense<0>(PC, (const bf16*)(ap.ws + WS_O), (const bf16*)(ap.ws + WS_WO) + (size_t)j * D * D, M, D, D, (bf16*)(ap.ws + WS_HMIX));
#endif
                SEAM(pb + 3); }
        } else {
            if (IN(pb + 0)) {
#if FAST_DENSE
                for (int rep = 0; rep < REP_DENSE; ++rep)
                dense_fast<2>(PC, (const bf16*)(ap.ws + WS_XB), (const bf16*)(ap.ws + WS_WIN) + (size_t)j * GF * D, GF, D, (bf16*)(ap.ws + WS_Z), 0, 0, FUSE_STATS ? (f32x2*)(ap.ws + WS_PART) : (f32x2*)nullptr, GH / 256);
#else
                sg_dense<2>(PC, (const bf16*)(ap.ws + WS_XB), (const bf16*)(ap.ws + WS_WIN) + (size_t)j * GF * D, M, GF, D, (bf16*)(ap.ws + WS_Z));
#endif
                SEAM(pb + 0); }
#if !(FUSE_STATS && FAST_DENSE && FAST_SPATIAL)
            if (IN(pb + 1)) { for (int rep = 0; rep < REP_MIX; ++rep) gm_stats(ap, PC); SEAM(pb + 1); }
#endif
#if FAST_SPATIAL
            if (IN(pb + 2)) { for (int rep = 0; rep < REP_MIX; ++rep) gm_spatial_fast(ap, PC, j); SEAM(pb + 2); }
#else
            if (IN(pb + 2)) { gm_spatial_simple(ap, PC, j); SEAM(pb + 2); }
#endif
            if (IN(pb + 3)) {
#if FAST_DENSE
                for (int rep = 0; rep < REP_DENSE; ++rep)
                dense_fast<0>(PC, (const bf16*)(ap.ws + WS_GATED), (const bf16*)(ap.ws + WS_WOUT) + (size_t)j * D * GH, D, GH, (bf16*)(ap.ws + WS_HMIX), 0, 0);
#else
                sg_dense<0>(PC, (const bf16*)(ap.ws + WS_GATED), (const bf16*)(ap.ws + WS_WOUT) + (size_t)j * D * GH, M, D, GH, (bf16*)(ap.ws + WS_HMIX));
#endif
                SEAM(pb + 3); }
        }
#if FUSE_ROUTER
        if (IN(pb + 4)) { ln_mix_router(ap, PC, L); SEAM(pb + 5); }
#else
        if (IN(pb + 4)) { ln_mix(ap, PC, L); SEAM(pb + 4); }
        if (IN(pb + 5)) { router(ap, PC, L); SEAM(pb + 5); }
#endif
#if FAST_MOE && MOE_DIRECT
#ifndef DBG_GU_SIMPLE
#define DBG_GU_SIMPLE 0
#endif
#ifndef DBG_DN_SIMPLE
#define DBG_DN_SIMPLE 0
#endif
#if MOE_MERGE
#if MOE_PAIRS
        if (IN(pb + 6)) { moe_tables(ap, PC, L); mg3::moe_pairs<0>(ap, PC, L); mg3::moe_pairs<2>(ap, PC, L); mg3::moe_pairs<1>(ap, PC, L); SEAM(pb + 7); }
#else
        if (IN(pb + 6)) { moe_tables(ap, PC, L); mg::moe_direct<0, 0, true>(ap, PC, L); mg::moe_direct<1, 0, true>(ap, PC, L); SEAM(pb + 7); }
#endif
#else
        if (IN(pb + 6)) { moe_tables(ap, PC, L); if (DBG_GU_SIMPLE) sg_moe_gu(ap, PC, L); else for (int rep = 0; rep < REP_MOE; ++rep) mg::moe_direct<0>(ap, PC, L);
            if (PROBE_GU) mg::moe_direct<0, PROBE_GU>(ap, PC, L); SEAM(pb + 6); }
        if (IN(pb + 7)) { moe_tables(ap, PC, L); if (DBG_DN_SIMPLE) sg_moe_dn(ap, PC, L); else for (int rep = 0; rep < REP_MOE; ++rep) mg::moe_direct<1>(ap, PC, L);
            if (PROBE_DN) mg::moe_direct<1, PROBE_DN>(ap, PC, L); SEAM(pb + 7); }
#endif
#elif FAST_MOE
        if (IN(pb + 6)) { moe_tables(ap, PC, L); for (int rep = 0; rep < REP_MOE; ++rep) moe_gu_fast(ap, PC, L); SEAM(pb + 6); }
        if (IN(pb + 7)) { moe_tables(ap, PC, L); for (int rep = 0; rep < REP_MOE; ++rep) moe_dn_fast(ap, PC, L); SEAM(pb + 7); }
#else
        if (IN(pb + 6)) { moe_tables(ap, PC, L); sg_moe_gu(ap, PC, L); SEAM(pb + 6); }
        if (IN(pb + 7)) { moe_tables(ap, PC, L); sg_moe_dn(ap, PC, L); SEAM(pb + 7); }
#endif
        if (IN(pb + 8)) { moe_tables(ap, PC, L); ln_ffn(ap, PC, L); SEAM(pb + 8); }
    }
#undef IN
#undef SEAM
}

extern "C" void kernel_launch(void* const* d_in, const int* in_sizes, int n_in, void* d_out, int out_size, void* d_ws, size_t ws_size, hipStream_t stream) {
    static int grid = 0;
    if (grid == 0) {
        if (n_in != 20 || in_sizes[0] != M * D || out_size != M * D || ws_size < WS_END) { fprintf(stderr, "kernel_launch: unexpected problem shape / workspace (%d inputs, ws %zu)\n", n_in, ws_size); grid = -1; return; }
        int dev = 0, cus = 0, per_cu = 0;
        if (hipGetDevice(&dev) != hipSuccess || hipDeviceGetAttribute(&cus, hipDeviceAttributeMultiprocessorCount, dev) != hipSuccess) { grid = -1; return; }
        if (hipFuncSetAttribute((const void*)mk_fwd, hipFuncAttributeMaxDynamicSharedMemorySize, LDS_BYTES) != hipSuccess) { fprintf(stderr, "kernel_launch: hipFuncSetAttribute failed\n"); grid = -1; return; }
        if (hipOccupancyMaxActiveBlocksPerMultiprocessor(&per_cu, (const void*)mk_fwd, NTHREADS, LDS_BYTES) != hipSuccess || per_cu < 1) { fprintf(stderr, "kernel_launch: occupancy query reports %d\n", per_cu); }
        (void)hipGetLastError();
        grid = cus;
    }
    if (grid < 0) return;
    if (hipMemsetAsync((char*)d_ws + WS_CTL, 0, CTL_ZERO_BYTES, stream) != hipSuccess) return;
    Args a{};
    for (int i = 0; i < 20; ++i) a.in[i] = (const float*)d_in[i];
    a.out = (float*)d_out; a.ws = (unsigned char*)d_ws;
#if MK_PER_PHASE
    for (int p = 0; p < NPHASE; ++p) {
        if (p >= 1) { const int L = (p - 1) / 9, s = (p - 1) % 9; if ((L & 1) == 0 && s == 2) continue; if (FUSE_ROUTER && s == 5) continue; if (MOE_MERGE && FAST_MOE && MOE_DIRECT && s == 7) continue; if (FUSE_STATS && FAST_DENSE && FAST_SPATIAL && (L & 1) == 1 && s == 1) continue; }
        a.ph_lo = p; a.ph_hi = p + 1;
        hipLaunchKernelGGL(mk_fwd, dim3(grid), dim3(NTHREADS), LDS_BYTES, stream, a);
    }
#else
    a.ph_lo = 0; a.ph_hi = NPHASE;
    hipLaunchKernelGGL(mk_fwd, dim3(grid), dim3(NTHREADS), LDS_BYTES, stream, a);
#endif
}
```
